# Optimizing an MI355X kernel written in HIP

```python
import jax
import jax.numpy as jnp
from jax import lax
import numpy as np

D_MODEL = 1024
BATCH = 1
SEQ = 16384
DEPTH = 1

GRID_W = 64
CTX_LEN = 256
D_MIX = D_MODEL
D_CONV = D_MIX // 2
CONV_WIDTH = 3
D_RWKV = D_MIX - D_CONV
RWKV_HEAD_DIM = 64
RWKV_HEADS = D_RWKV // RWKV_HEAD_DIM
DECAY_RANK = 64
ICLR_RANK = 64
GATE_RANK = 128
P_RWKV = 3 * D_RWKV + 2 * DECAY_RANK + 2 * ICLR_RANK + GATE_RANK
P_IN = 3 * D_CONV + P_RWKV
N_EXPERTS = 256
TOP_K = 8
D_EXPERT = 256
ROUTED_SCALE = 2.5
MOE_BLOCK = 128
N_MOD = 6
RMS_EPS = 1e-6
GN_EPS = 64e-5
DECAY_SCALE = 0.6065306597126334
NORM_EPS = 1e-12

kernel_name = 'hybrid_conv_rwkv7_moe_dit_block'


def rmsnorm(x, g):
    xf = x.astype(jnp.float32)
    y = xf * lax.rsqrt(jnp.mean(xf * xf, axis=-1, keepdims=True) + RMS_EPS)
    return (y * g.astype(jnp.float32)).astype(x.dtype)


def modulate(h, shift, scale):
    return h * (1.0 + scale) + shift


def token_shift_bidir(p, mu):
    zero = jnp.zeros_like(p[:, :1])
    prev = jnp.concatenate([zero, p[:, :-1]], axis=1)
    nxt = jnp.concatenate([p[:, 1:], zero], axis=1)
    return p + mu[0] * (prev - p) + mu[1] * (nxt - p)


def dwconv_centred(z, w):
    half = CONV_WIDTH // 2
    n = z.shape[-2]
    zp = jnp.pad(z, [(0, 0)] * (z.ndim - 2) + [(half, half), (0, 0)])
    return sum(w[i] * zp[..., i:i + n, :] for i in range(CONV_WIDTH))


def short_conv_group(p_conv, conv_w, on_grid):
    b_gate, c_gate, v = jnp.split(p_conv, 3, axis=-1)
    z = c_gate * v
    if on_grid:
        bsz, n_tok, ch = z.shape
        rows = n_tok // GRID_W
        y = dwconv_centred(z.reshape(bsz, rows, GRID_W, ch), conv_w).reshape(bsz, n_tok, ch)
    else:
        y = dwconv_centred(z, conv_w)
    return b_gate * y


def rwkv_inputs(p_rw, lp):
    f32 = lambda t: t.astype(jnp.float32)
    p = f32(p_rw)
    bsz, n_tok, _ = p.shape
    hd = (RWKV_HEADS, RWKV_HEAD_DIM)
    r = p[..., :D_RWKV]
    k = p[..., D_RWKV:2 * D_RWKV]
    v = p[..., 2 * D_RWKV:3 * D_RWKV]
    o = 3 * D_RWKV
    w_lo = p[..., o:o + 2 * DECAY_RANK].reshape(bsz, n_tok, 2, DECAY_RANK)
    o += 2 * DECAY_RANK
    a_lo = p[..., o:o + 2 * ICLR_RANK].reshape(bsz, n_tok, 2, ICLR_RANK)
    o += 2 * ICLR_RANK
    g_lo = p[..., o:]
    d = f32(lp['decay_w0']) + jnp.einsum('bldr,drc->bldc', jnp.tanh(w_lo), f32(lp['decay_up']))
    w = jnp.exp(-DECAY_SCALE * jax.nn.sigmoid(d))
    a = jax.nn.sigmoid(f32(lp['iclr_a0']) + jnp.einsum('bldr,drc->bldc', a_lo, f32(lp['iclr_up'])))
    kap = (k[:, :, None, :] * f32(lp['key_xi'])).reshape(bsz, n_tok, 2, *hd)
    kh = kap * lax.rsqrt(jnp.sum(kap * kap, axis=-1, keepdims=True) + NORM_EPS)
    kt = k[:, :, None, :] * (1.0 + (a - 1.0) * f32(lp['key_alpha']))
    g = jax.nn.sigmoid(g_lo) @ f32(lp['gate_up'])
    heads = lambda t: t.reshape(bsz, n_tok, 2, *hd)
    return (r.reshape(bsz, n_tok, *hd), heads(w), heads(kt), kh, heads(a),
            v.reshape(bsz, n_tok, *hd), g)


def project(h, lp):
    p = h @ lp['w_in']
    p_conv = p[..., :3 * D_CONV]
    p_rw = token_shift_bidir(p[..., 3 * D_CONV:], lp['shift_mu'])
    return p_conv, rwkv_inputs(p_rw, lp)


def wkv_scan(s0, ins, direction, reverse):
    r, w, kt, kh, a, v, _ = ins
    xs = tuple(jnp.moveaxis(t, 1, 0) for t in (r, w[:, :, direction], kt[:, :, direction],
                                                  kh[:, :, direction], a[:, :, direction], v))

    def step(s, inp):
        r_t, w_t, kt_t, kh_t, a_t, v_t = inp
        s_kh = jnp.einsum('bhvk,bhk->bhv', s, kh_t)
        s = (s * w_t[:, :, None, :]
             - s_kh[..., None] * (kh_t * a_t)[:, :, None, :]
             + v_t[..., None] * kt_t[:, :, None, :])
        return s, jnp.einsum('bhvk,bhk->bhv', s, r_t)

    s_final, ys = lax.scan(step, s0, xs, reverse=reverse)
    return jnp.moveaxis(ys, 0, 1), s_final


def rwkv_readout(ins, y_f, y_b, lp):
    r, _, kt, _, _, v, g = ins
    bsz, n_tok = r.shape[:2]
    hd = (RWKV_HEADS, RWKV_HEAD_DIM)
    y = y_f + y_b
    mu = jnp.mean(y, axis=-1, keepdims=True)
    var = jnp.mean(jnp.square(y - mu), axis=-1, keepdims=True)
    yn = ((y - mu) * lax.rsqrt(var + GN_EPS) * lp['gn_w'].astype(jnp.float32).reshape(hd)
          + lp['gn_b'].astype(jnp.float32).reshape(hd))
    rho = lp['bonus_rho'].astype(jnp.float32).reshape(hd)
    bonus = jnp.einsum('blhn,bldhn->blh', r * rho, kt)[..., None] * v
    return (yn + bonus).reshape(bsz, n_tok, D_RWKV) * g


def mix_out(p_conv, ins, y_f, y_b, lp, on_grid):
    y_conv = short_conv_group(p_conv, lp['conv_w'], on_grid)
    y_rw = rwkv_readout(ins, y_f, y_b, lp).astype(y_conv.dtype)
    return jnp.concatenate([y_conv, y_rw], axis=-1) @ lp['w_out']


def swiglu(h, w1, w3, w2):
    return (jax.nn.silu(h @ w1) * (h @ w3)) @ w2


def routed_experts(h, router_w, router_bias, w1, w3, w2):
    n_tok, dm = h.shape
    scores = jax.nn.sigmoid((h @ router_w).astype(jnp.float32))
    _, idx = lax.top_k(scores + router_bias.astype(jnp.float32), TOP_K)
    gate = jnp.take_along_axis(scores, idx, axis=-1)
    gate = gate / jnp.sum(gate, axis=-1, keepdims=True) * ROUTED_SCALE
    n_assign = n_tok * TOP_K
    flat_e = idx.reshape(-1)
    flat_tok = jnp.arange(n_assign, dtype=jnp.int32) // TOP_K
    order = jnp.argsort(flat_e)
    e_sorted = flat_e[order]
    counts = jnp.zeros((N_EXPERTS,), jnp.int32).at[flat_e].add(1)
    padded = (counts + MOE_BLOCK - 1) // MOE_BLOCK * MOE_BLOCK
    pad_end = jnp.cumsum(padded)
    pad_start = pad_end - padded
    start = jnp.cumsum(counts) - counts
    rank = jnp.arange(n_assign, dtype=jnp.int32) - start[e_sorted]
    dest = pad_start[e_sorted] + rank
    n_blocks = -(-n_assign // MOE_BLOCK) + N_EXPERTS
    slot_tok = jnp.full((n_blocks * MOE_BLOCK,), n_tok, jnp.int32).at[dest].set(flat_tok[order])
    slot_gate = jnp.zeros((n_blocks * MOE_BLOCK,), jnp.float32).at[dest].set(gate.reshape(-1)[order])
    block_e = jnp.minimum(jnp.searchsorted(pad_end, jnp.arange(n_blocks, dtype=jnp.int32) * MOE_BLOCK,
                                           side='right'), N_EXPERTS - 1)
    h_pad = jnp.concatenate([h, jnp.zeros((1, dm), h.dtype)], axis=0)

    def body(acc, blk):
        tok, gt, e = blk
        yb = swiglu(h_pad[tok], w1[e], w3[e], w2[e])
        return acc.at[tok].add(yb * gt[:, None].astype(yb.dtype)), None

    acc, _ = lax.scan(body, jnp.zeros((n_tok + 1, dm), h.dtype),
                      (slot_tok.reshape(n_blocks, MOE_BLOCK), slot_gate.reshape(n_blocks, MOE_BLOCK), block_e))
    return acc[:n_tok]


def channel_mixer(h, lp):
    bsz, n_tok, dm = h.shape
    hf = h.reshape(bsz * n_tok, dm)
    y = (routed_experts(hf, lp['router_w'], lp['router_bias'], lp['exp_w1'], lp['exp_w3'], lp['exp_w2'])
         + swiglu(hf, lp['sh_w1'], lp['sh_w3'], lp['sh_w2']))
    return y.reshape(bsz, n_tok, dm)


def layer(x, ctx, c, c_ctx, lp, update_ctx):
    bsz = x.shape[0]
    mod = (jax.nn.silu(c) @ lp['ada_w'] + lp['ada_b'])[:, None, :]
    mod_c = (jax.nn.silu(c_ctx) @ lp['ada_w'] + lp['ada_b'])[None, None, :]
    sh1, sc1, g1, sh2, sc2, g2 = jnp.split(mod, N_MOD, axis=-1)
    csh1, csc1, cg1, csh2, csc2, cg2 = jnp.split(mod_c, N_MOD, axis=-1)

    hc = modulate(rmsnorm(ctx, lp['norm1_g']), csh1, csc1)
    pc_conv, ins_c = project(hc, lp)
    s0 = jnp.zeros((bsz, RWKV_HEADS, RWKV_HEAD_DIM, RWKV_HEAD_DIM), jnp.float32)
    yc_f, s_f = wkv_scan(s0, ins_c, 0, reverse=False)
    yc_b, s_b = wkv_scan(s0, ins_c, 1, reverse=True)

    hx = modulate(rmsnorm(x, lp['norm1_g']), sh1, sc1)
    px_conv, ins_x = project(hx, lp)
    yx_f, _ = wkv_scan(s_f, ins_x, 0, reverse=False)
    yx_b, _ = wkv_scan(s_b, ins_x, 1, reverse=True)
    x = x + g1 * mix_out(px_conv, ins_x, yx_f, yx_b, lp, on_grid=True)
    x = x + g2 * channel_mixer(modulate(rmsnorm(x, lp['norm2_g']), sh2, sc2), lp)

    if update_ctx:
        ctx = ctx + cg1 * mix_out(pc_conv, ins_c, yc_f, yc_b, lp, on_grid=False)
        ctx = ctx + cg2 * channel_mixer(modulate(rmsnorm(ctx, lp['norm2_g']), csh2, csc2), lp)
    return x, ctx


def setup_inputs(seed: int = 0) -> dict:
    key = jax.random.key(seed)
    ks = jax.random.split(key, 32)

    def nrm(k, shape, scale):
        return scale * jax.random.normal(k, shape, jnp.float32)

    L = DEPTH
    return {
        'x': nrm(ks[0], (BATCH, SEQ, D_MODEL), 1.0),
        'c': nrm(ks[1], (BATCH, D_MODEL), 1.0),
        'ctx': nrm(ks[2], (BATCH, CTX_LEN, D_MODEL), 1.0),
        'c_ctx': nrm(ks[3], (D_MODEL,), 1.0),
        'ada_w': nrm(ks[4], (L, D_MODEL, N_MOD * D_MODEL), 0.5 * D_MODEL ** -0.5),
        'ada_b': nrm(ks[5], (L, N_MOD * D_MODEL), 0.02),
        'norm1_g': 1.0 + nrm(ks[6], (L, D_MODEL), 0.02),
        'norm2_g': 1.0 + nrm(ks[7], (L, D_MODEL), 0.02),
        'w_in': nrm(ks[8], (L, D_MODEL, P_IN), D_MODEL ** -0.5),
        'conv_w': nrm(ks[9], (L, CONV_WIDTH, D_CONV), CONV_WIDTH ** -0.5),
        'shift_mu': jax.random.uniform(ks[10], (L, 2, P_RWKV), jnp.float32, 0.0, 0.5),
        'decay_w0': nrm(ks[11], (L, 2, D_RWKV), 1.0) - 1.0,
        'decay_up': nrm(ks[12], (L, 2, DECAY_RANK, D_RWKV), DECAY_RANK ** -0.5),
        'iclr_a0': nrm(ks[13], (L, 2, D_RWKV), 0.5),
        'iclr_up': nrm(ks[14], (L, 2, ICLR_RANK, D_RWKV), ICLR_RANK ** -0.5),
        'key_xi': 0.85 + nrm(ks[15], (L, 2, D_RWKV), 0.05),
        'key_alpha': 1.0 + nrm(ks[16], (L, 2, D_RWKV), 0.05),
        'bonus_rho': nrm(ks[17], (L, D_RWKV), 0.1),
        'gate_up': nrm(ks[18], (L, GATE_RANK, D_RWKV), GATE_RANK ** -0.5),
        'gn_w': 1.0 + nrm(ks[19], (L, D_RWKV), 0.02),
        'gn_b': nrm(ks[20], (L, D_RWKV), 0.02),
        'w_out': nrm(ks[21], (L, D_MIX, D_MODEL), D_MIX ** -0.5),
        'router_w': nrm(ks[22], (L, D_MODEL, N_EXPERTS), D_MODEL ** -0.5),
        'router_bias': nrm(ks[23], (L, N_EXPERTS), 0.01),
        'exp_w1': nrm(ks[24], (L, N_EXPERTS, D_MODEL, D_EXPERT), D_MODEL ** -0.5),
        'exp_w3': nrm(ks[25], (L, N_EXPERTS, D_MODEL, D_EXPERT), D_MODEL ** -0.5),
        'exp_w2': nrm(ks[26], (L, N_EXPERTS, D_EXPERT, D_MODEL), D_EXPERT ** -0.5),
        'sh_w1': nrm(ks[27], (L, D_MODEL, D_EXPERT), D_MODEL ** -0.5),
        'sh_w3': nrm(ks[28], (L, D_MODEL, D_EXPERT), D_MODEL ** -0.5),
        'sh_w2': nrm(ks[29], (L, D_EXPERT, D_MODEL), D_EXPERT ** -0.5),
        'final_g': 1.0 + nrm(ks[30], (D_MODEL,), 0.02),
    }


def reference(x, c, ctx, c_ctx, ada_w, ada_b, norm1_g, norm2_g, w_in, conv_w, shift_mu,
              decay_w0, decay_up, iclr_a0, iclr_up, key_xi, key_alpha, bonus_rho, gate_up,
              gn_w, gn_b, w_out, router_w, router_bias, exp_w1, exp_w3, exp_w2,
              sh_w1, sh_w3, sh_w2, final_g):
    for l in range(DEPTH):
        lp = dict(ada_w=ada_w[l], ada_b=ada_b[l], norm1_g=norm1_g[l], norm2_g=norm2_g[l],
                  w_in=w_in[l], conv_w=conv_w[l], shift_mu=shift_mu[l],
                  decay_w0=decay_w0[l], decay_up=decay_up[l], iclr_a0=iclr_a0[l], iclr_up=iclr_up[l],
                  key_xi=key_xi[l], key_alpha=key_alpha[l], bonus_rho=bonus_rho[l], gate_up=gate_up[l],
                  gn_w=gn_w[l], gn_b=gn_b[l], w_out=w_out[l],
                  router_w=router_w[l], router_bias=router_bias[l],
                  exp_w1=exp_w1[l], exp_w3=exp_w3[l], exp_w2=exp_w2[l],
                  sh_w1=sh_w1[l], sh_w3=sh_w3[l], sh_w2=sh_w2[l])
        x, ctx = layer(x, ctx, c, c_ctx, lp, update_ctx=(l < DEPTH - 1))
    return rmsnorm(x, final_g)
```

```cpp
#include <hip/hip_runtime.h>
#include <hip/hip_cooperative_groups.h>
#include <cstdio>
#include <cstdint>
namespace cg = cooperative_groups;

#define DI __device__ __forceinline__
__device__ __forceinline__ int fresh_tid() { int t = threadIdx.x; asm volatile("" : "+v"(t)); return t; }
typedef unsigned short bf16_t;
typedef short bf16x8 __attribute__((ext_vector_type(8)));
typedef float f32x4 __attribute__((ext_vector_type(4)));
typedef float f32x16 __attribute__((ext_vector_type(16)));
typedef unsigned u32x4 __attribute__((ext_vector_type(4)));
typedef unsigned u32x2 __attribute__((ext_vector_type(2)));

constexpr int D = 1024, L = 16384, LC = 256, LT = L + LC;
constexpr int PINW = 3456;
constexpr int PIN = 3584, PRW0 = 1536;
constexpr int NE = 256, TOPK = 8, DE = 256;
constexpr int NCH = LT / 64;
constexpr int NTASK = NCH * 16;
constexpr int NSLOT = 9;
constexpr int NTHR = 512;
constexpr size_t kDynLds = 152 * 1024;
constexpr float SLAB_SCALE = 8.f;


struct Params {
  const float *x, *c, *ctx, *c_ctx, *ada_w, *ada_b, *norm1_g, *norm2_g, *w_in, *conv_w, *shift_mu, *decay_w0, *decay_up,
      *iclr_a0, *iclr_up, *key_xi, *key_alpha, *bonus_rho, *gate_up, *gn_w, *gn_b, *w_out, *router_w, *router_bias, *exp_w1,
      *exp_w3, *exp_w2, *sh_w1, *sh_w3, *sh_w2, *final_g;
  float* out;
  float *mod, *modc;
  int* cnt;
  int coop_probe, pad0;
  int* ident; float* ones;
  unsigned* bar;
  bf16_t* hx;
  bf16_t *winT, *woutT, *rsT, *w13T, *w2T, *gateT;
  bf16_t* p;
  bf16_t* rpp;
  float* yl;
  bf16_t* gt;
  float* ht;
  bf16_t* s0;
  float* bon;
  bf16_t* mixin;
  float* x1;
  bf16_t* h2;
  float* logits;
  int* lid;
  float* lgate;
  bf16_t* act;
  unsigned char* slab;
};

DI float bf2f(bf16_t h) { return __uint_as_float(((unsigned)h) << 16); }
typedef float f32x2v __attribute__((ext_vector_type(2)));
typedef __bf16 bf16x2v __attribute__((ext_vector_type(2)));
DI bf16_t f2bf(float f) { return __builtin_bit_cast(unsigned short, (__bf16)f); }
DI unsigned pack2(float lo, float hi) {
  f32x2v v = {lo, hi};
  return __builtin_bit_cast(unsigned, __builtin_convertvector(v, bf16x2v));
}
DI float sigm(float x) { return __builtin_amdgcn_rcpf(1.f + __expf(-x)); }
DI float siluf(float x) { return x * sigm(x); }
DI float tanh_(float x) { return 1.f - 2.f * __builtin_amdgcn_rcpf(1.f + __expf(2.f * x)); }
DI float wave_sum(float v) {
#pragma unroll
  for (int o = 32; o > 0; o >>= 1) v += __shfl_xor(v, o);
  return v;
}


#define XB_TMO      128
#define XB_XCNT(j)  (256  + 64 * (j))
#define XB_XSUB(j)  (1280 + 64 * (j))
#define XB_XGEN(j)  (2304 + 64 * (j))
#define XB_TOP      3328
#define XB_TOPGEN   3392
#define XCD_BAR_WORDS 3456
#define XB_SPIN_CAP (1u << 22)
#define LAS __attribute__((address_space(3)))
DI unsigned xb_ld(unsigned* p) { return __hip_atomic_load(p, __ATOMIC_RELAXED, __HIP_MEMORY_SCOPE_AGENT); }
DI unsigned xb_add(unsigned* p, unsigned v) { return __hip_atomic_fetch_add(p, v, __ATOMIC_RELAXED, __HIP_MEMORY_SCOPE_AGENT); }
DI unsigned xb_xcc_id() { return (unsigned)__builtin_amdgcn_s_getreg((3 << 11) | 20) & 0xFu; }
#define XB_SPIN(cond, bar) do { unsigned _sp = 0; while (cond) { __builtin_amdgcn_s_sleep(1); \
    if ((++_sp & 255u) == 0u) { if (xb_ld(&(bar)[XB_TMO])) break; if (_sp > XB_SPIN_CAP) { atomicAdd(&(bar)[XB_TMO], 1u); break; } } } } while (0)
struct XcdBarrier { unsigned* bar; unsigned x; volatile LAS unsigned* st; };
DI XcdBarrier xcd_barrier_post(unsigned* bar, volatile LAS unsigned* st) {
  XcdBarrier b; b.bar = bar; b.x = xb_xcc_id(); b.st = st;
  if (threadIdx.x == 0) (void)xb_add(&bar[XB_XCNT(b.x)], 1u);
  return b;
}
DI void xcd_barrier_complete(unsigned* bar, unsigned x, unsigned& nloc, unsigned& nx) {
  const unsigned G = gridDim.x * gridDim.y * gridDim.z;
  unsigned sum, cnt, mine, sp = 0u;
  for (;;) {
    sum = 0u; cnt = 0u; mine = 0u;
#pragma unroll
    for (unsigned j = 0; j < 16; ++j) { const unsigned c = xb_ld(&bar[XB_XCNT(j)]); sum += c; cnt += (c > 0u) ? 1u : 0u; mine = (j == x) ? c : mine; }
    if (sum == G) break;
    __builtin_amdgcn_s_sleep(1);
    if ((++sp & 255u) == 0u) { if (xb_ld(&bar[XB_TMO])) break; if (sp > XB_SPIN_CAP) { atomicAdd(&bar[XB_TMO], 1u); break; } }
  }
  nloc = mine > 0u ? mine : 1u; nx = cnt > 0u ? cnt : 1u;
}
DI void xcd_barrier(const XcdBarrier& b) {
  asm volatile("s_waitcnt vmcnt(0)" ::: "memory");
  __syncthreads();
  if (threadIdx.x == 0) {
    unsigned* bar = b.bar;
    __builtin_amdgcn_s_waitcnt(0);
    unsigned nloc = b.st[0], nx = b.st[1];
    if (nloc == 0u) { xcd_barrier_complete(bar, b.x, nloc, nx); b.st[0] = nloc; b.st[1] = nx; }
    const unsigned old = xb_add(&bar[XB_XSUB(b.x)], 1u);
    const unsigned gen = old / nloc;
    if (old + 1u == (gen + 1u) * nloc) {
      __builtin_amdgcn_fence(__ATOMIC_RELEASE, "agent");
      asm volatile("s_waitcnt vmcnt(0)" ::: "memory");
      const unsigned og = xb_add(&bar[XB_TOP], 1u);
      const unsigned tg = og / nx;
      if (og + 1u == (tg + 1u) * nx) xb_add(&bar[XB_TOPGEN], 1u);
      else XB_SPIN(xb_ld(&bar[XB_TOPGEN]) == tg, bar);
      __builtin_amdgcn_fence(__ATOMIC_ACQUIRE, "agent");
      xb_add(&bar[XB_XGEN(b.x)], 1u);
      asm volatile("s_waitcnt vmcnt(0)" ::: "memory");
    } else {
      XB_SPIN(xb_ld(&bar[XB_XGEN(b.x)]) == gen, bar);
      __builtin_amdgcn_fence(__ATOMIC_ACQUIRE, "agent");
      asm volatile("s_waitcnt vmcnt(0)" ::: "memory");
    }
  }
  __syncthreads();
}

struct GemmAcc { f32x4 a[4][4]; };

struct GStage { u32x4 a0, a1; f32x4 b0, b1; };
DI void g_load(GStage& S, const bf16_t* ap0, const bf16_t* ap1, const float* bp, int ldb, int t, int nt) {
  if (t < nt) {
    S.a0 = *(const u32x4*)(ap0 + t * 32);
    S.a1 = *(const u32x4*)(ap1 + t * 32);
    const float* bn = bp + (size_t)t * 32 * ldb;
    S.b0 = *(const f32x4*)(bn);
    S.b1 = *(const f32x4*)(bn + ldb);
  }
}
DI int swz4(int row) { return (0x78 >> (((row >> 2) & 3) * 2)) & 3; }
DI void g_write(const GStage& S, char* st, int tid, int kq, int ng) {
  {
    const int row = tid >> 2, ch = (tid & 3) ^ swz4(row);
    *(u32x4*)(st + row * 64 + ch * 16) = S.a0;
    *(u32x4*)(st + 8192 + row * 64 + ch * 16) = S.a1;
  }
  const int pc = ((kq >> 2) ^ swz4(4 * ng)) * 4 + (kq & 3);
  unsigned* dst = (unsigned*)(st + 16384) + (4 * ng) * 16 + pc;
  dst[0] = pack2(S.b0[0], S.b1[0]);
  dst[16] = pack2(S.b0[1], S.b1[1]);
  dst[32] = pack2(S.b0[2], S.b1[2]);
  dst[48] = pack2(S.b0[3], S.b1[3]);
}
DI void g_compute(GemmAcc& acc, const char* st, int wr, int wc, int fr, int fq) {
  bf16x8 At[4], Bt[4];
  const int pch = (fq ^ swz4(fr)) * 16;
#pragma unroll
  for (int m = 0; m < 4; ++m) At[m] = *(const bf16x8*)(st + (wr * 64 + m * 16 + fr) * 64 + pch);
#pragma unroll
  for (int n = 0; n < 4; ++n) Bt[n] = *(const bf16x8*)(st + 16384 + (wc * 64 + n * 16 + fr) * 64 + pch);
#pragma unroll
  for (int m = 0; m < 4; ++m)
#pragma unroll
    for (int n = 0; n < 4; ++n) acc.a[m][n] = __builtin_amdgcn_mfma_f32_16x16x32_bf16(At[m], Bt[n], acc.a[m][n], 0, 0, 0);
}
template <class ARow, class BCol, class Epi>
DI void gemm_tile(char* smem, const ARow& arow, const BCol& bcol, int ldb, int K, const Epi& epi) {
  const int tid = fresh_tid(), wid = tid >> 6, lane = tid & 63, wr = wid >> 1, wc = wid & 1, fr = lane & 15, fq = lane >> 4;
  const int ar0 = tid >> 2, ac0 = (tid & 3) * 8;
  const bf16_t* ap0 = arow(ar0) + ac0;
  const bf16_t* ap1 = arow(ar0 + 128) + ac0;
  const int kq = tid & 15, ng = tid >> 4;
  const float* bp = bcol(ng) + (size_t)(2 * kq) * ldb;
  GemmAcc acc;
#pragma unroll
  for (int m = 0; m < 4; ++m)
#pragma unroll
    for (int n = 0; n < 4; ++n) acc.a[m][n] = (f32x4){0.f, 0.f, 0.f, 0.f};
  const int nt = K / 32;
  char* st0 = smem;
  char* st1 = smem + 24576;
  GStage S0, S1, S2;
  g_load(S0, ap0, ap1, bp, ldb, 0, nt);
  g_load(S1, ap0, ap1, bp, ldb, 1, nt);
  g_load(S2, ap0, ap1, bp, ldb, 2, nt);
  g_write(S0, st0, tid, kq, ng);
  g_load(S0, ap0, ap1, bp, ldb, 3, nt);
  __syncthreads();
  for (int t = 0; t < nt; t += 3) {
    {
      char* cur = (t & 1) ? st1 : st0; char* nxt = (t & 1) ? st0 : st1;
      g_compute(acc, cur, wr, wc, fr, fq);
      if (t + 1 < nt) g_write(S1, nxt, tid, kq, ng);
      g_load(S1, ap0, ap1, bp, ldb, t + 4, nt);
      __syncthreads();
    }
    if (t + 1 < nt) {
      char* cur = ((t + 1) & 1) ? st1 : st0; char* nxt = ((t + 1) & 1) ? st0 : st1;
      g_compute(acc, cur, wr, wc, fr, fq);
      if (t + 2 < nt) g_write(S2, nxt, tid, kq, ng);
      g_load(S2, ap0, ap1, bp, ldb, t + 5, nt);
      __syncthreads();
    }
    if (t + 2 < nt) {
      char* cur = ((t + 2) & 1) ? st1 : st0; char* nxt = ((t + 2) & 1) ? st0 : st1;
      g_compute(acc, cur, wr, wc, fr, fq);
      if (t + 3 < nt) g_write(S0, nxt, tid, kq, ng);
      g_load(S0, ap0, ap1, bp, ldb, t + 6, nt);
      __syncthreads();
    }
  }
  epi(acc, wr, wc, fr, fq);
}


template <int NC, class Val, class RowPtr>
DI void epi_bf16_lds(char* smem, int wr, int wc, int fr, int fq, const Val& val, const RowPtr& rowptr) {
  constexpr int LDC = NC + 8;
  bf16_t* T = (bf16_t*)smem;
#pragma unroll
  for (int m = 0; m < 4; ++m)
#pragma unroll
    for (int n = 0; n < NC / 32; ++n)
#pragma unroll
      for (int j = 0; j < 4; ++j) T[(wr * 64 + m * 16 + fq * 4 + j) * LDC + wc * (NC / 2) + n * 16 + fr] = f2bf(val(m, n, j));
  __syncthreads();
  constexpr int CPR = NC / 8;
  constexpr int RPI = NTHR / CPR;
  const int tid = fresh_tid(), ch = tid % CPR, r0 = tid / CPR;
#pragma unroll 4
  for (int it = 0; it < 256 / RPI; ++it) {
    const int r = it * RPI + r0;
    bf16_t* dst = rowptr(r);
    if (dst) *(u32x4*)(dst + ch * 8) = *(const u32x4*)(T + r * LDC + ch * 8);
  }
  __syncthreads();
}


struct Acc256 { f32x4 a[8][4]; };
struct GStage2 { u32x4 a0, a1; f32x4 b00, b01, b10, b11; };
template <class BP>
DI void g2_load(GStage2& S, const bf16_t* ap0, const bf16_t* ap1, const BP& bp0, const BP& bp1, int ldb, int t, int nt) {
  if (t < nt) {
    S.a0 = *(const u32x4*)(ap0 + t * 32);
    S.a1 = *(const u32x4*)(ap1 + t * 32);
    const size_t o = (size_t)t * 32 * ldb;
    S.b00 = *(const f32x4*)(bp0 + o);
    S.b01 = *(const f32x4*)(bp0 + o + ldb);
    S.b10 = *(const f32x4*)(bp1 + o);
    S.b11 = *(const f32x4*)(bp1 + o + ldb);
  }
}
DI void g2_write(const GStage2& S, char* st, int tid, int kq, int ng) {
  {
    const int row = tid >> 2, ch = (tid & 3) ^ swz4(row);
    *(u32x4*)(st + row * 64 + ch * 16) = S.a0;
    *(u32x4*)(st + 8192 + row * 64 + ch * 16) = S.a1;
  }
  const int pc = ((kq >> 2) ^ swz4(4 * ng)) * 4 + (kq & 3);
  unsigned* dst = (unsigned*)(st + 16384) + (4 * ng) * 16 + pc;
  dst[0] = pack2(S.b00[0], S.b01[0]);
  dst[16] = pack2(S.b00[1], S.b01[1]);
  dst[32] = pack2(S.b00[2], S.b01[2]);
  dst[48] = pack2(S.b00[3], S.b01[3]);
  dst[2048 + 0] = pack2(S.b10[0], S.b11[0]);
  dst[2048 + 16] = pack2(S.b10[1], S.b11[1]);
  dst[2048 + 32] = pack2(S.b10[2], S.b11[2]);
  dst[2048 + 48] = pack2(S.b10[3], S.b11[3]);
}
DI void g2_compute(Acc256& acc, const char* st, int wr, int wc, int fr, int fq) {
  bf16x8 Bt[4];
  const int pch = (fq ^ swz4(fr)) * 16;
#pragma unroll
  for (int n = 0; n < 4; ++n) Bt[n] = *(const bf16x8*)(st + 16384 + (wc * 64 + n * 16 + fr) * 64 + pch);
#pragma unroll
  for (int m = 0; m < 8; ++m) {
    const bf16x8 At = *(const bf16x8*)(st + (wr * 128 + m * 16 + fr) * 64 + pch);
#pragma unroll
    for (int n = 0; n < 4; ++n) acc.a[m][n] = __builtin_amdgcn_mfma_f32_16x16x32_bf16(At, Bt[n], acc.a[m][n], 0, 0, 0);
  }
}
template <class ARow, class BCol, class Epi>
DI void gemm256(char* smem, const ARow& arow, const BCol& bcol, int ldb, int K, const Epi& epi) {
  const int tid = fresh_tid(), wid = tid >> 6, lane = tid & 63, wr = wid >> 2, wc = wid & 3, fr = lane & 15, fq = lane >> 4;
  const int ar0 = tid >> 2, ac0 = (tid & 3) * 8;
  const bf16_t* ap0 = arow(ar0) + ac0;
  const bf16_t* ap1 = arow(ar0 + 128) + ac0;
  const int kq = tid & 15, ng = tid >> 4;
  const float* bp0 = bcol(ng) + (size_t)(2 * kq) * ldb;
  const float* bp1 = bcol(ng + 32) + (size_t)(2 * kq) * ldb;
  Acc256 acc;
#pragma unroll
  for (int m = 0; m < 8; ++m)
#pragma unroll
    for (int n = 0; n < 4; ++n) acc.a[m][n] = (f32x4){0.f, 0.f, 0.f, 0.f};
  const int nt = K / 32;
  char* st0 = smem;
  char* st1 = smem + 32768;
  GStage2 S0, S1;
  g2_load(S0, ap0, ap1, bp0, bp1, ldb, 0, nt);
  g2_load(S1, ap0, ap1, bp0, bp1, ldb, 1, nt);
  g2_write(S0, st0, tid, kq, ng);
  g2_load(S0, ap0, ap1, bp0, bp1, ldb, 2, nt);
  __syncthreads();
  for (int t = 0; t < nt; t += 2) {
    g2_compute(acc, st0, wr, wc, fr, fq);
    g2_write(S1, st1, tid, kq, ng);
    g2_load(S1, ap0, ap1, bp0, bp1, ldb, t + 3, nt);
    __syncthreads();
    g2_compute(acc, st1, wr, wc, fr, fq);
    if (t + 2 < nt) g2_write(S0, st0, tid, kq, ng);
    g2_load(S0, ap0, ap1, bp0, bp1, ldb, t + 4, nt);
    __syncthreads();
  }
  epi(acc, wr, wc, fr, fq);
}
template <int NC, class Val, class RowPtr>
DI void epi256_bf16(char* smem, int wr, int wc, int fr, int fq, const Val& val, const RowPtr& rowptr, int ncv = 1 << 30) {
  constexpr int LDC = NC + 8;
  bf16_t* T = (bf16_t*)smem;
#pragma unroll
  for (int m = 0; m < 8; ++m)
#pragma unroll
    for (int n = 0; n < NC / 64; ++n)
#pragma unroll
      for (int j = 0; j < 4; ++j) T[(wr * 128 + m * 16 + fq * 4 + j) * LDC + wc * (NC / 4) + n * 16 + fr] = f2bf(val(m, n, j));
  __syncthreads();
  constexpr int CPR = NC / 8, RPI = NTHR / CPR;
  const int tid = fresh_tid(), ch = tid % CPR, r0 = tid / CPR;
#pragma unroll 4
  for (int it = 0; it < 256 / RPI; ++it) {
    const int r = it * RPI + r0;
    bf16_t* dst = rowptr(r);
    if (dst && ch * 8 < ncv) *(u32x4*)(dst + ch * 8) = *(const u32x4*)(T + r * LDC + ch * 8);
  }
  __syncthreads();
}


namespace g8 {
constexpr int BK = 64, HALF = 128, HTB = HALF * BK * 2;
DI int lds_byte(int r, int c) { const int st = (r >> 4) * 2 + (c >> 5), rr = r & 15, cc = c & 31, ob = rr * 64 + cc * 2; return st * 1024 + (ob ^ (((ob >> 9) & 1) << 5)); }
DI void stage_rc(int b, int& R, int& C) { const int st = b / 1024, sb = b % 1024, swz = sb ^ (((sb >> 9) & 1) << 5); R = (st >> 1) * 16 + swz / 64; C = (st & 1) * 32 + (swz % 64) / 2; }
typedef f32x4 Acc[2][2][4][2];
template <class Unit, class Sched, class Epi>
DI void gemm(LAS unsigned char* lds, const Sched& S, const Epi& E, int K) {
  asm volatile("" : "+s"(K));
  const int tid = fresh_tid(), wid = __builtin_amdgcn_readfirstlane(tid >> 6), lane = tid & 63, wr = wid >> 2, wc = wid & 3, fr = lane & 15, fq = lane >> 4;
  const int nt = K / BK;
  int R[2], C[2];
  unsigned voffB[2];
#pragma unroll
  for (int i = 0; i < 2; ++i) { stage_rc(tid * 16 + i * 8192, R[i], C[i]); voffB[i] = (unsigned)(R[i] * K + C[i]) * 2u; }
  const size_t kstep = (size_t)(BK * 2);
  const size_t hstep = (size_t)HALF * K * 2;
  const unsigned ldsw = (unsigned)wid * 1024u;
  const int aoff = lds_byte(wr * 64 + fr, fq * 8), boff = lds_byte(wc * 32 + fr, fq * 8);
#define G8_SA(b, h) (((b) * 2 + (h)) * HTB)
#define G8_SB(b, h) ((4 + (b) * 2 + (h)) * HTB)
#define G8_STAGEB(bufoff, gbase) do { _Pragma("unroll") for (int _i = 0; _i < 2; ++_i) \
    __builtin_amdgcn_global_load_lds((const unsigned*)((const char*)(gbase) + voffB[_i]), (LAS unsigned*)(lds + (bufoff) + ldsw + _i * 8192), 16, 0, 0); } while (0)
#define G8_STAGEA(bufoff, offs, h, kb) do { _Pragma("unroll") for (int _i = 0; _i < 2; ++_i) \
    __builtin_amdgcn_global_load_lds((const unsigned*)(abase + (size_t)(offs)[h][_i] + (kb)), (LAS unsigned*)(lds + (bufoff) + ldsw + _i * 8192), 16, 0, 0); } while (0)
#define G8_LDA(dst, b, h) do { _Pragma("unroll") for (int m = 0; m < 4; ++m) _Pragma("unroll") for (int k = 0; k < 2; ++k) dst[m][k] = *(const LAS bf16x8*)(lds + G8_SA(b, h) + aoff + m * 2048 + k * 1024); } while (0)
#define G8_LDB(dst, b, h) do { _Pragma("unroll") for (int n = 0; n < 2; ++n) _Pragma("unroll") for (int k = 0; k < 2; ++k) dst[n][k] = *(const LAS bf16x8*)(lds + G8_SB(b, h) + boff + n * 2048 + k * 1024); } while (0)
#define G8_MMA(ai, bj, At, Bt) do { __builtin_amdgcn_s_setprio(1); _Pragma("unroll") for (int m = 0; m < 4; ++m) _Pragma("unroll") for (int n = 0; n < 2; ++n) _Pragma("unroll") for (int k = 0; k < 2; ++k) \
    acc[ai][bj][m][n] = __builtin_amdgcn_mfma_f32_16x16x32_bf16(Bt[n][k], At[m][k], acc[ai][bj][m][n], 0, 0, 0); __builtin_amdgcn_s_setprio(0); } while (0)
#define G8_WAIT_V(n) asm volatile("s_waitcnt vmcnt(" #n ")" ::: "memory")
#define G8_WAIT_L(n) asm volatile("s_waitcnt lgkmcnt(" #n ")" ::: "memory")
#define G8_BAR __builtin_amdgcn_s_barrier()
#define G8_SCHED __builtin_amdgcn_sched_barrier(0)
  Unit cur, nxt; int ui = 0;
  if (!S.next(0, cur)) return;
  const char* abase = S.abase();
  Acc acc;
#pragma unroll
  for (int a = 0; a < 2; ++a)
#pragma unroll
    for (int b = 0; b < 2; ++b)
#pragma unroll
      for (int m = 0; m < 4; ++m)
#pragma unroll
        for (int n = 0; n < 2; ++n) acc[a][b][m][n] = (f32x4){0.f, 0.f, 0.f, 0.f};
  bf16x8 At[4][2], B0[2][2], B1[2][2];
  unsigned co[2][2], no[2][2];
  S.pf(cur, lds, 0);
  S.aoffs(cur, R[0], R[1], C[0], C[1], co);
  const char* cB = S.bbase(cur);
  G8_STAGEB(G8_SB(0, 0), cB); G8_STAGEA(G8_SA(0, 0), co, 0, 0); G8_STAGEB(G8_SB(0, 1), cB + hstep); G8_STAGEA(G8_SA(0, 1), co, 1, 0);
  if (wr == 1) G8_BAR;
  G8_WAIT_V(4); G8_BAR;
  G8_STAGEB(G8_SB(1, 0), cB + kstep); G8_STAGEA(G8_SA(1, 0), co, 0, kstep); G8_STAGEB(G8_SB(1, 1), cB + hstep + kstep);
  G8_WAIT_V(6); G8_BAR;
  for (;;) {
    const bool has_next = S.next(ui + 1, nxt);
    const char* nB = cB;
    if (has_next) { nB = S.bbase(nxt); S.pf(nxt, lds, (ui + 1) % 3); }
    for (int t = 0; t < nt; t += 2) {
      const bool last = (t == nt - 2);
      const size_t k1 = (size_t)(t + 1) * kstep;
      const size_t k2 = last ? 0 : (size_t)(t + 2) * kstep;
      const size_t k3 = k2 + kstep;
      const char* b2 = (last ? nB : cB) + k2;
      const char* b3 = b2 + kstep;
      if (last) {
        if (has_next) S.aoffs_late(nxt, lds, (ui + 1) % 3, R[0], R[1], C[0], C[1], no);
        else {
#pragma unroll
          for (int h = 0; h < 2; ++h)
#pragma unroll
            for (int i = 0; i < 2; ++i) no[h][i] = co[h][i];
        }
      }
      G8_LDB(B0, 0, 0); G8_SCHED; G8_LDA(At, 0, 0); G8_STAGEA(G8_SA(1, 1), co, 1, k1);
      G8_WAIT_L(8); G8_BAR; G8_WAIT_L(0); G8_MMA(0, 0, At, B0); G8_BAR; G8_SCHED;
      G8_LDB(B1, 0, 1); G8_STAGEB(G8_SB(0, 0), b2);
      G8_BAR; G8_WAIT_L(0); G8_MMA(0, 1, At, B1); G8_BAR;
      G8_LDA(At, 0, 1);
      if (last) { G8_STAGEA(G8_SA(0, 0), no, 0, k2); } else { G8_STAGEA(G8_SA(0, 0), co, 0, k2); }
      G8_BAR; G8_WAIT_L(0); G8_MMA(1, 0, At, B0); G8_BAR; G8_SCHED;
      G8_STAGEB(G8_SB(0, 1), b2 + hstep);
      G8_WAIT_V(6); G8_BAR; G8_MMA(1, 1, At, B1); G8_BAR;
      G8_LDB(B0, 1, 0); G8_SCHED; G8_LDA(At, 1, 0);
      if (last) { G8_STAGEA(G8_SA(0, 1), no, 1, k2); } else { G8_STAGEA(G8_SA(0, 1), co, 1, k2); }
      G8_WAIT_L(8); G8_BAR; G8_WAIT_L(0); G8_MMA(0, 0, At, B0); G8_BAR; G8_SCHED;
      G8_LDB(B1, 1, 1); G8_STAGEB(G8_SB(1, 0), b3);
      G8_BAR; G8_WAIT_L(0); G8_MMA(0, 1, At, B1); G8_BAR;
      G8_LDA(At, 1, 1);
      if (last) { G8_STAGEA(G8_SA(1, 0), no, 0, k3); } else { G8_STAGEA(G8_SA(1, 0), co, 0, k3); }
      G8_BAR; G8_WAIT_L(0); G8_MMA(1, 0, At, B0); G8_BAR; G8_SCHED;
      G8_STAGEB(G8_SB(1, 1), b3 + hstep);
      G8_WAIT_V(6); G8_BAR; G8_MMA(1, 1, At, B1); G8_BAR;
    }
    E(acc, cur, wr, wc, fr, fq, ui % 3);
    if (!has_next) break;
#pragma unroll
    for (int a = 0; a < 2; ++a)
#pragma unroll
      for (int b = 0; b < 2; ++b)
#pragma unroll
        for (int m = 0; m < 4; ++m)
#pragma unroll
          for (int n = 0; n < 2; ++n) acc[a][b][m][n] = (f32x4){0.f, 0.f, 0.f, 0.f};
    cur = nxt; cB = nB; ++ui;
#pragma unroll
    for (int h = 0; h < 2; ++h)
#pragma unroll
      for (int i = 0; i < 2; ++i) co[h][i] = no[h][i];
  }
  G8_WAIT_V(0);
  if (wr == 0) G8_BAR;
  G8_BAR;
#undef G8_SA
#undef G8_SB
#undef G8_STAGEA
#undef G8_STAGEB
#undef G8_LDA
#undef G8_LDB
#undef G8_MMA
#undef G8_WAIT_V
#undef G8_WAIT_L
#undef G8_BAR
#undef G8_SCHED
}
struct Unit2 { int pm, pn; };
struct DenseOrder {
  int nM, nN, nwg, G, c;
  DI void init(int nM_, int nN_, int G_, int c_) { nM = nM_; nN = nN_; nwg = nM * nN; G = G_; c = c_; }
  DI bool next(int i, Unit2& u) const {
    const long Lx = (long)i * G + c; if (Lx >= nwg) return false;
    int wgid = (int)Lx; { const int q = nwg / 8, r = nwg % 8, xcd = wgid % 8, off = wgid / 8; wgid = (xcd < r ? xcd * (q + 1) : r * (q + 1) + (xcd - r) * q) + off; }
    const int nig = 8 * nN, gid = wgid / nig, fm = gid * 8, gsz = (nM - fm) < 8 ? (nM - fm) : 8;
    u.pm = fm + ((wgid % nig) % gsz); u.pn = (wgid % nig) / gsz; return true;
  }
};
}

template <class ColPtr>
DI void transpose_tile(char* smem, int ld, bf16_t* dst, int Kdim, int k0, int rho0, const ColPtr& colptr) {
  bf16_t* T = (bf16_t*)smem;
  const int tid = fresh_tid();
  {
    const int kk = tid >> 3, g = tid & 7;
    const int rho = rho0 + g * 8;
    const float* cp = colptr(rho);
    const float* cp2 = colptr(rho + 4);
    f32x4 v0, v1;
    if (cp) { v0 = *(const f32x4*)(cp + (size_t)(k0 + kk) * ld); v1 = *(const f32x4*)(cp2 + (size_t)(k0 + kk) * ld); }
    else { v0 = (f32x4){0.f, 0.f, 0.f, 0.f}; v1 = v0; }
#pragma unroll
    for (int j = 0; j < 4; ++j) { T[(g * 8 + j) * 72 + kk] = f2bf(v0[j]); T[(g * 8 + 4 + j) * 72 + kk] = f2bf(v1[j]); }
  }
  __syncthreads();
  {
    const int r = tid >> 3, ch = tid & 7;
    *(u32x4*)(dst + (size_t)(rho0 + r) * Kdim + k0 + ch * 8) = *(const u32x4*)(T + r * 72 + ch * 8);
  }
  __syncthreads();
}

DI int swiglu_col(int rho, int& z);
struct PrepTile { const float* src[4]; const float* src2[4]; bf16_t* dst; int ld, Kdim, perm; };
DI int w2_row(int c) { const int wc = c >> 6, fq = (c >> 4) & 3, bj = (c >> 3) & 1, n = (c >> 2) & 1, e = c & 3; return 128 * bj + 32 * wc + 16 * n + 4 * fq + e; }
DI int w2_col(int rho) { const int bj = rho >> 7, wc = (rho >> 5) & 3, n = (rho >> 4) & 1, fq = (rho >> 2) & 3, e = rho & 3; return 64 * wc + 16 * fq + 8 * bj + 4 * n + e; }
DI int perm32(int rho) { const int n = rho >> 4, i = rho & 15; return 8 * (i >> 2) + 4 * n + (i & 3); }
DI void prep_tile_desc(const Params& P, int u, int g, int kk, PrepTile& t) {
  constexpr int PER_E = 32 + 16;
  const int e = u / PER_E, v = u % PER_E;
  if (e < 256 && v < 32) {
    const int pn = v >> 4, kt = v & 15;
    const float* W1 = P.exp_w1 + (size_t)e * D * DE;
    const float* W3 = P.exp_w3 + (size_t)e * D * DE;
    t.ld = DE; t.Kdim = D; t.perm = 0;
    t.dst = P.w13T + ((size_t)e * 512 + pn * 256) * D + kt * 64;
#pragma unroll
    for (int sb = 0; sb < 4; ++sb) {
      int z; const int col = swiglu_col(pn * 256 + sb * 64 + g * 8, z);
      t.src[sb] = (z ? W3 : W1) + col + (size_t)(kt * 64 + kk) * DE;
      t.src2[sb] = t.src[sb] + 4;
    }
  } else {
    const int w = (e < 256) ? v - 32 : v;
    const int pn = w >> 2, kt = w & 3;
    const float* W2 = (e < 256) ? P.exp_w2 + (size_t)e * DE * D : P.sh_w2;
    t.ld = D; t.Kdim = DE;
    t.dst = P.w2T + ((size_t)e * D + pn * 256) * DE + kt * 64;
    t.perm = 1;
#pragma unroll
    for (int sb = 0; sb < 4; ++sb) {
      t.src[sb] = W2 + pn * 256 + sb * 64 + g * 8 + (size_t)(kt * 64 + kk) * D;
      t.src2[sb] = t.src[sb] + 4;
    }
  }
}
constexpr int PREP_TOTAL = 256 * 48 + 16;
constexpr int P2_FULL = (LT / 256) * (PIN / 256) % 256;
constexpr int PREP_E0 = (256 - P2_FULL) * 3;
constexpr int PREP_E1 = PREP_E0 + 224 * 5;
constexpr int PREP_E2 = PREP_E1 + 64 * 7;
DI void prep_experts(const Params& P, char* smem, int worker, int nworkers, int u_begin, int total) {
  bf16_t* T = (bf16_t*)smem;
  const int tid = fresh_tid();
  const int kk = tid >> 3, g = tid & 7;
  f32x4 v[4][2];
  PrepTile cur;
  int u = u_begin + worker;
  if (u < total) {
    prep_tile_desc(P, u, g, kk, cur);
#pragma unroll
    for (int sb = 0; sb < 4; ++sb) { v[sb][0] = __builtin_nontemporal_load((const f32x4*)cur.src[sb]); v[sb][1] = __builtin_nontemporal_load((const f32x4*)cur.src2[sb]); }
  }
  for (; u < total; u += nworkers) {
#pragma unroll
    for (int sb = 0; sb < 4; ++sb)
#pragma unroll
      for (int j = 0; j < 4; ++j) {
        const int c0 = sb * 64 + g * 8 + j, c1 = c0 + 4;
        T[(cur.perm ? w2_row(c0) : c0) * 66 + kk] = f2bf(v[sb][0][j]);
        T[(cur.perm ? w2_row(c1) : c1) * 66 + kk] = f2bf(v[sb][1][j]);
      }
    bf16_t* dst = cur.dst; const int Kdim = cur.Kdim;
    if (u + nworkers < total) {
      prep_tile_desc(P, u + nworkers, g, kk, cur);
#pragma unroll
      for (int sb = 0; sb < 4; ++sb) { v[sb][0] = __builtin_nontemporal_load((const f32x4*)cur.src[sb]); v[sb][1] = __builtin_nontemporal_load((const f32x4*)cur.src2[sb]); }
    }
    __syncthreads();
#pragma unroll
    for (int it = 0; it < 4; ++it) {
      const int r = it * 64 + (tid >> 3), ch = tid & 7;
      const unsigned* tp = (const unsigned*)(T + r * 66 + ch * 8);
      u32x4 o; o[0] = tp[0]; o[1] = tp[1]; o[2] = tp[2]; o[3] = tp[3];
      __builtin_nontemporal_store(o, (u32x4*)(dst + (size_t)r * Kdim + ch * 8));
    }
    __syncthreads();
  }
}

DI int swiglu_col(int rho, int& z) { const int kap = rho & 255, pn = rho >> 8; z = (kap >> 4) & 1; return pn * 128 + (kap >> 5) * 16 + (kap & 15); }

constexpr int LD = 72;
constexpr int SLOT = 64 * LD * 2;
DI f32x16 mfma32(bf16x8 a, bf16x8 b, f32x16 c) { return __builtin_amdgcn_mfma_f32_32x32x16_bf16(a, b, c, 0, 0, 0); }
DI f32x16 zero16() {
  f32x16 z;
#pragma unroll
  for (int i = 0; i < 16; ++i) z[i] = 0.f;
  return z;
}
DI bf16x8 frag_c(const bf16_t* M, int row, int k, int ld = LD) { return *(const bf16x8*)(M + row * ld + k); }
DI bf16x8 frag_s(const bf16_t* M, int k, int col, int ld = LD) {
  bf16x8 v;
#pragma unroll
  for (int j = 0; j < 8; ++j) v[j] = (short)M[(k + j) * ld + col];
  return v;
}
DI int crow(int reg, int half) { return (reg & 3) + 8 * (reg >> 2) + 4 * half; }
template <bool AC, bool BC>
DI f32x16 mm_tile(const bf16_t* A, const bf16_t* B, int ti, int tj, int lane, f32x16 acc) {
  const int r = lane & 31, h = lane >> 5;
#pragma unroll
  for (int ks = 0; ks < 4; ++ks) {
    const int k = ks * 16 + 8 * h;
    bf16x8 a = AC ? frag_c(A, ti * 32 + r, k) : frag_s(A, k, ti * 32 + r);
    bf16x8 b = BC ? frag_c(B, tj * 32 + r, k) : frag_s(B, k, tj * 32 + r);
    acc = mfma32(a, b, acc);
    __builtin_amdgcn_sched_barrier(0);
  }
  return acc;
}
DI void store_rm_bf16(bf16_t* M, const f32x16& acc, int ti, int tj, int lane) {
  const int c = tj * 32 + (lane & 31), h = lane >> 5;
#pragma unroll
  for (int g = 0; g < 16; ++g) M[(ti * 32 + crow(g, h)) * LD + c] = f2bf(acc[g]);
}
DI void store_tr_bf16(bf16_t* Mt, const f32x16& acc, int ti, int tj, int lane, int ld = LD) {
  const int c = tj * 32 + (lane & 31), h = lane >> 5;
#pragma unroll
  for (int g = 0; g < 4; ++g) {
    u32x2 v;
    v[0] = pack2(acc[4 * g], acc[4 * g + 1]);
    v[1] = pack2(acc[4 * g + 2], acc[4 * g + 3]);
    *(u32x2*)(Mt + c * ld + ti * 32 + 8 * g + 4 * h) = v;
  }
}

DI void phase0(const Params& P, char* smem) {
  const int tid = fresh_tid();
  if (blockIdx.x == 0 && tid < 272) P.cnt[tid] = 0;
  if (blockIdx.x == 1 && tid < 256) P.ones[tid] = 1.f;
  for (int i = blockIdx.x * NTHR + tid; i < L; i += gridDim.x * NTHR) P.ident[i] = i * NSLOT + 8;
  float* red = (float*)smem;
  for (int cb = blockIdx.x; cb < 6144 / 24; cb += gridDim.x) {
    const int n0 = cb * 24;
    if (tid < 504) {
      const int col = tid % 24, ks = tid / 24;
      const int k0 = ks * 49, k1 = (k0 + 49 < 1024) ? k0 + 49 : 1024;
      float s0 = 0.f, s1 = 0.f;
      for (int k = k0; k < k1; ++k) {
        const float w = P.ada_w[(size_t)k * 6144 + n0 + col];
        s0 += siluf(P.c[k]) * w;
        s1 += siluf(P.c_ctx[k]) * w;
      }
      red[(ks * 24 + col) * 2] = s0;
      red[(ks * 24 + col) * 2 + 1] = s1;
    }
    __syncthreads();
    if (tid < 48) {
      const int col = tid >> 1, z = tid & 1;
      float s = 0.f;
      for (int ks = 0; ks < 21; ++ks) s += red[(ks * 24 + col) * 2 + z];
      s += P.ada_b[n0 + col];
      (z ? P.modc : P.mod)[n0 + col] = s;
    }
    __syncthreads();
  }
}

DI void norm_mod_row(const float* src, const float* g, const float* shift, const float* scale, bf16_t* dst, int lane) {
  f32x4 v[4];
  float ss = 0.f;
#pragma unroll
  for (int i = 0; i < 4; ++i) {
    v[i] = *(const f32x4*)(src + i * 256 + lane * 4);
    ss += v[i][0] * v[i][0] + v[i][1] * v[i][1] + v[i][2] * v[i][2] + v[i][3] * v[i][3];
  }
  ss = wave_sum(ss);
  const float rs = __builtin_amdgcn_rsqf(ss * (1.f / 1024.f) + 1e-6f);
#pragma unroll
  for (int i = 0; i < 4; ++i) {
    const int c = i * 256 + lane * 4;
    const f32x4 gg = *(const f32x4*)(g + c), sh = *(const f32x4*)(shift + c), sc = *(const f32x4*)(scale + c);
    float o[4];
#pragma unroll
    for (int j = 0; j < 4; ++j) o[j] = v[i][j] * rs * gg[j] * (1.f + sc[j]) + sh[j];
    u32x2 w;
    w[0] = pack2(o[0], o[1]);
    w[1] = pack2(o[2], o[3]);
    *(u32x2*)(dst + c) = w;
  }
}
DI void phase1(const Params& P) {
  const int tid_ = fresh_tid();
  const int wid = tid_ >> 6, lane = tid_ & 63;
  for (int row = blockIdx.x * 8 + wid; row < LT; row += gridDim.x * 8) {
    if (row < L) norm_mod_row(P.x + (size_t)row * D, P.norm1_g, P.mod, P.mod + 1024, P.hx + (size_t)row * D, lane);
    else norm_mod_row(P.ctx + (size_t)(row - L) * D, P.norm1_g, P.modc, P.modc + 1024, P.hx + (size_t)row * D, lane);
  }
}
DI void phase7(const Params& P) {
  const int tid_ = fresh_tid();
  const int wid = tid_ >> 6, lane = tid_ & 63;
  for (int row = blockIdx.x * 8 + wid; row < L; row += gridDim.x * 8)
    norm_mod_row(P.x1 + (size_t)row * D, P.norm2_g, P.mod + 3072, P.mod + 4096, P.h2 + (size_t)row * D, lane);
}


DI void prep_dense_win(const Params& P, char* smem) {
  constexpr int T_WIN = (PIN / 64) * 16;
  for (int u = blockIdx.x; u < T_WIN; u += gridDim.x) {
    const int rt = u >> 4, kt = u & 15;
    transpose_tile(smem, PINW, P.winT, D, kt * 64, rt * 64, [&](int rho) -> const float* { return rho < PINW ? P.w_in + (rho & ~31) + perm32(rho & 31) : nullptr; });
  }
}
DI void prep_dense_rest(const Params& P, char* smem, int worker, int nworkers) {
  constexpr int T_WOUT = 16 * 16, T_RS = 12 * 16, T_G = 16;
  for (int u = worker; u < T_WOUT + T_RS + T_G; u += nworkers) {
    if (u < T_WOUT) {
      const int rt = u >> 4, kt = u & 15;
      transpose_tile(smem, D, P.woutT, D, kt * 64, rt * 64, [&](int rho) -> const float* { return P.w_out + rho; });
    } else if (u >= T_WOUT + T_RS) {
      const int v = u - T_WOUT - T_RS, rt = v >> 1, kt = v & 1;
      transpose_tile(smem, 512, P.gateT, 128, kt * 64, rt * 64, [&](int rho) -> const float* { return P.gate_up + rho; });
    } else {
      const int v = u - T_WOUT, rt = v >> 4, kt = v & 15;
      transpose_tile(smem, 256, P.rsT, D, kt * 64, rt * 64, [&](int rho) -> const float* {
        if (rho < 256) return P.router_w + rho;
        int z; const int col = swiglu_col(rho - 256, z);
        return (z ? P.sh_w3 : P.sh_w1) + col;
      });
    }
  }
}

struct SchedP2 : g8::DenseOrder {
  static constexpr int PF_LINES = 0;
  DI void pf(const g8::Unit2&, LAS unsigned char*, int) const {}
  DI void aoffs_late(const g8::Unit2& u, LAS unsigned char*, int, int R0, int R1, int C0, int C1, unsigned (&o)[2][2]) const { aoffs(u, R0, R1, C0, C1, o); }
  const Params* P;
  DI const char* abase() const { return (const char*)P->hx; }
  DI const char* bbase(const g8::Unit2& u) const { return (const char*)(P->winT + (size_t)u.pn * 256 * D); }
  DI void aoffs(const g8::Unit2& u, int R0, int R1, int C0, int C1, unsigned (&o)[2][2]) const {
#pragma unroll
    for (int h = 0; h < 2; ++h) {
      o[h][0] = (unsigned)(((u.pm * 256 + h * 128 + R0) * D + C0) * 2);
      o[h][1] = (unsigned)(((u.pm * 256 + h * 128 + R1) * D + C1) * 2);
    }
  }
};
DI void phase2(const Params& P, char* smem) {
  SchedP2 S; S.init(LT / 256, PIN / 256, gridDim.x, blockIdx.x); S.P = &P;
  g8::gemm<g8::Unit2>((LAS unsigned char*)smem, S,
      [&](const g8::Acc& acc, const g8::Unit2& u, int wr, int wc, int fr, int fq, int) {
#pragma unroll
        for (int ai = 0; ai < 2; ++ai)
#pragma unroll
          for (int m = 0; m < 4; ++m) {
            bf16_t* rowp = P.p + (size_t)(u.pm * 256 + ai * 128 + wr * 64 + m * 16 + fr) * PIN + u.pn * 256 + wc * 32 + 8 * fq;
#pragma unroll
            for (int bj = 0; bj < 2; ++bj) {
              const f32x4 v0 = acc[ai][bj][m][0], v1 = acc[ai][bj][m][1];
              u32x4 w;
              w[0] = pack2(v0[0], v0[1]); w[1] = pack2(v0[2], v0[3]); w[2] = pack2(v1[0], v1[1]); w[3] = pack2(v1[2], v1[3]);
              *(u32x4*)(rowp + bj * 128) = w;
            }
          }
      }, D);
  if ((int)gridDim.x == 256 && (int)blockIdx.x >= P2_FULL) {
    prep_dense_rest(P, smem, blockIdx.x - P2_FULL, 256 - P2_FULL);
    prep_experts(P, smem, blockIdx.x - P2_FULL, 256 - P2_FULL, 0, PREP_E0);
  } else if ((int)gridDim.x != 256) {
    prep_dense_rest(P, smem, blockIdx.x, gridDim.x);
    prep_experts(P, smem, blockIdx.x, gridDim.x, 0, PREP_E0);
  }
}

DI void load_shift16(const Params& P, int t, int lo, int hi, int col, float* o) {
  const bf16_t* pc = P.p + (size_t)t * PIN + col;
  u32x4 c0 = *(const u32x4*)pc, c1 = *(const u32x4*)(pc + 8);
  u32x4 p0 = (u32x4){0, 0, 0, 0}, p1 = p0, n0 = p0, n1 = p0;
  if (t - 1 >= lo) { p0 = *(const u32x4*)(pc - PIN); p1 = *(const u32x4*)(pc - PIN + 8); }
  if (t + 1 < hi) { n0 = *(const u32x4*)(pc + PIN); n1 = *(const u32x4*)(pc + PIN + 8); }
  const float* mu0 = P.shift_mu + (col - PRW0);
  const float* mu1 = P.shift_mu + 1920 + (col - PRW0);
#pragma unroll
  for (int i = 0; i < 16; ++i) {
    const unsigned cw = (i < 8) ? c0[(i & 7) >> 1] : c1[(i & 7) >> 1];
    const unsigned pw = (i < 8) ? p0[(i & 7) >> 1] : p1[(i & 7) >> 1];
    const unsigned nw = (i < 8) ? n0[(i & 7) >> 1] : n1[(i & 7) >> 1];
    const float cv = (i & 1) ? __uint_as_float(cw & 0xFFFF0000u) : __uint_as_float(cw << 16);
    const float pv = (i & 1) ? __uint_as_float(pw & 0xFFFF0000u) : __uint_as_float(pw << 16);
    const float nv = (i & 1) ? __uint_as_float(nw & 0xFFFF0000u) : __uint_as_float(nw << 16);
    o[i] = cv + mu0[i] * (pv - cv) + mu1[i] * (nv - cv);
  }
}


DI void st16_bf16(bf16_t* dst, const float* v) {
  u32x4 a, b;
#pragma unroll
  for (int i = 0; i < 4; ++i) { a[i] = pack2(v[2 * i], v[2 * i + 1]); b[i] = pack2(v[8 + 2 * i], v[8 + 2 * i + 1]); }
  *(u32x4*)dst = a;
  *(u32x4*)(dst + 8) = b;
}

struct ShiftRaw { u32x4 c0, c1, p0, p1, n0, n1; };
DI void shift_raw(const Params& P, int t, int lo, int hi, int col, ShiftRaw& R) {
  const bf16_t* pc = P.p + (size_t)t * PIN + col;
  R.c0 = *(const u32x4*)pc; R.c1 = *(const u32x4*)(pc + 8);
  R.p0 = (u32x4){0, 0, 0, 0}; R.p1 = R.p0; R.n0 = R.p0; R.n1 = R.p0;
  if (t - 1 >= lo) { R.p0 = *(const u32x4*)(pc - PIN); R.p1 = *(const u32x4*)(pc - PIN + 8); }
  if (t + 1 < hi) { R.n0 = *(const u32x4*)(pc + PIN); R.n1 = *(const u32x4*)(pc + PIN + 8); }
}
DI void shift_finish(const Params& P, const ShiftRaw& R, int col, float* o) {
  const float* mu0 = P.shift_mu + (col - PRW0);
  const float* mu1 = P.shift_mu + 1920 + (col - PRW0);
#pragma unroll
  for (int i = 0; i < 16; ++i) {
    const unsigned cw = (i < 8) ? R.c0[(i & 7) >> 1] : R.c1[(i & 7) >> 1];
    const unsigned pw = (i < 8) ? R.p0[(i & 7) >> 1] : R.p1[(i & 7) >> 1];
    const unsigned nw = (i < 8) ? R.n0[(i & 7) >> 1] : R.n1[(i & 7) >> 1];
    const float cv = (i & 1) ? __uint_as_float(cw & 0xFFFF0000u) : __uint_as_float(cw << 16);
    const float pv = (i & 1) ? __uint_as_float(pw & 0xFFFF0000u) : __uint_as_float(pw << 16);
    const float nv = (i & 1) ? __uint_as_float(nw & 0xFFFF0000u) : __uint_as_float(nw << 16);
    o[i] = cv + mu0[i] * (pv - cv) + mu1[i] * (nv - cv);
  }
}


DI void half_barrier(LAS unsigned* ctr, unsigned& gen, int lt) {
  ++gen;
  asm volatile("s_waitcnt lgkmcnt(0)" ::: "memory");
  if ((lt & 63) == 0) (void)__hip_atomic_fetch_add(ctr, 1u, __ATOMIC_RELAXED, __HIP_MEMORY_SCOPE_WORKGROUP);
  const unsigned want = 4u * gen;
  while (__hip_atomic_load(ctr, __ATOMIC_RELAXED, __HIP_MEMORY_SCOPE_WORKGROUP) < want) __builtin_amdgcn_s_sleep(1);
  asm volatile("" ::: "memory");
}
DI void phase3_task(const Params& P, char* hs, int task, int lt, LAS unsigned* hctr, unsigned& hgen) {
#define HALF_BARRIER() half_barrier(hctr, hgen, lt)
  asm volatile("" : "+v"(lt));
  const int lw = lt >> 6, lane = lt & 63;
  const int cc = task >> 4, dir = (task >> 3) & 1, hd = task & 7;
  const int rb = cc * 64;
  const int lo = (rb < L) ? 0 : L, hi = (rb < L) ? L : LT;
  const int sr = lt >> 2, q4 = lt & 3, cseg = q4 * 16;
  const int trow = rb + (dir ? 63 - sr : sr);
  const int ti = lw >> 1, tj = lw & 1;
  bf16_t* slot[8];
#pragma unroll
  for (int i = 0; i < 8; ++i) slot[i] = (bf16_t*)(hs + i * SLOT);
  float* gC = (float*)(hs + 8 * SLOT);
  float* Dout = (float*)(hs + 4 * SLOT);
  float* Aout = (float*)(hs + 6 * SLOT);
  float* Wl = (float*)(hs);

  {
    ShiftRaw rw, ra;
    shift_raw(P, trow, lo, hi, 3072 + 64 * dir + cseg, rw);
    shift_raw(P, trow, lo, hi, 3200 + 64 * dir + cseg, ra);
    const float* du = P.decay_up + ((size_t)(dir * 64 + sr)) * 512 + 64 * hd + cseg;
    const float* iu = P.iclr_up + ((size_t)(dir * 64 + sr)) * 512 + 64 * hd + cseg;
    f32x4 dq[4], iq[4];
#pragma unroll
    for (int i = 0; i < 4; ++i) { dq[i] = *(const f32x4*)(du + 4 * i); iq[i] = *(const f32x4*)(iu + 4 * i); }
    float tmp[16];
    shift_finish(P, rw, 3072 + 64 * dir + cseg, tmp);
#pragma unroll
    for (int i = 0; i < 16; ++i) tmp[i] = tanh_(tmp[i]);
    st16_bf16(slot[0] + sr * LD + cseg, tmp);
    shift_finish(P, ra, 3200 + 64 * dir + cseg, tmp);
    st16_bf16(slot[1] + sr * LD + cseg, tmp);
#pragma unroll
    for (int i = 0; i < 4; ++i) { tmp[4 * i] = dq[i][0]; tmp[4 * i + 1] = dq[i][1]; tmp[4 * i + 2] = dq[i][2]; tmp[4 * i + 3] = dq[i][3]; }
    st16_bf16(slot[2] + sr * LD + cseg, tmp);
#pragma unroll
    for (int i = 0; i < 4; ++i) { tmp[4 * i] = iq[i][0]; tmp[4 * i + 1] = iq[i][1]; tmp[4 * i + 2] = iq[i][2]; tmp[4 * i + 3] = iq[i][3]; }
    st16_bf16(slot[3] + sr * LD + cseg, tmp);
  }
  HALF_BARRIER();
  {
    f32x16 a1 = mm_tile<true, false>(slot[0], slot[2], ti, tj, lane, zero16());
    f32x16 a2 = mm_tile<true, false>(slot[1], slot[3], ti, tj, lane, zero16());
    const int c = tj * 32 + (lane & 31), h = lane >> 5;
#pragma unroll
    for (int g = 0; g < 16; ++g) {
      Dout[(ti * 32 + crow(g, h)) * 65 + c] = a1[g];
      Aout[(ti * 32 + crow(g, h)) * 65 + c] = a2[g];
    }
  }
  HALF_BARRIER();
  float aa[16];
#pragma unroll
  for (int i = 0; i < 16; ++i) {
    const int ch = dir * 512 + 64 * hd + cseg + i;
    const float d = P.decay_w0[ch] + Dout[sr * 65 + cseg + i];
    Wl[sr * 65 + cseg + i] = __expf(-0.6065306597126334f * sigm(d));
    aa[i] = sigm(P.iclr_a0[ch] + Aout[sr * 65 + cseg + i]);
  }
  HALF_BARRIER();
  ShiftRaw rk, rr_;
  shift_raw(P, trow, lo, hi, PRW0 + 512 + 64 * hd + cseg, rk);
  shift_raw(P, trow, lo, hi, PRW0 + 64 * hd + cseg, rr_);
  {
    const int c = lt >> 2, seg = lt & 3;
    float w[16];
#pragma unroll
    for (int i = 0; i < 16; ++i) w[i] = Wl[(seg * 16 + i) * 65 + c];
#pragma unroll
    for (int i = 1; i < 16; ++i) w[i] *= w[i - 1];
    const float tot = w[15];
    const float t0 = __shfl(tot, (lt & 63 & ~3) + 0), t1 = __shfl(tot, (lt & 63 & ~3) + 1), t2 = __shfl(tot, (lt & 63 & ~3) + 2);
    const float pre = (seg == 0) ? 1.f : (seg == 1) ? t0 : (seg == 2) ? t0 * t1 : t0 * t1 * t2;
    HALF_BARRIER();
#pragma unroll
    for (int i = 0; i < 16; ++i) Wl[(seg * 16 + i) * 65 + c] = w[i] * pre;
  }
  HALF_BARRIER();
  {
    float rr[16], kk[16], vv[16];
    shift_finish(P, rk, PRW0 + 512 + 64 * hd + cseg, kk);
    shift_finish(P, rr_, PRW0 + 64 * hd + cseg, rr);
    load_shift16(P, trow, lo, hi, PRW0 + 1024 + 64 * hd + cseg, vv);
    float nrm = 0.f, bsum = 0.f;
#pragma unroll
    for (int i = 0; i < 16; ++i) {
      const float kap = kk[i] * P.key_xi[dir * 512 + 64 * hd + cseg + i];
      nrm += kap * kap;
    }
    nrm += __shfl_xor(nrm, 1);
    nrm += __shfl_xor(nrm, 2);
    const float rn = __builtin_amdgcn_rsqf(nrm + 1e-12f);
    {
      const int o = sr * LD + cseg;
#pragma unroll
      for (int h8 = 0; h8 < 2; ++h8) {
        float xi[8], al[8], rho[8];
#pragma unroll
        for (int i = 0; i < 2; ++i) {
          const f32x4 a = *(const f32x4*)(P.key_xi + dir * 512 + 64 * hd + cseg + 8 * h8 + 4 * i);
          const f32x4 b = *(const f32x4*)(P.key_alpha + dir * 512 + 64 * hd + cseg + 8 * h8 + 4 * i);
          const f32x4 c = *(const f32x4*)(P.bonus_rho + 64 * hd + cseg + 8 * h8 + 4 * i);
#pragma unroll
          for (int j = 0; j < 4; ++j) { xi[4 * i + j] = a[j]; al[4 * i + j] = b[j]; rho[4 * i + j] = c[j]; }
        }
        u32x4 wKp, wBp, wKt, wRp, wV;
#pragma unroll
        for (int p2 = 0; p2 < 4; ++p2) {
          float vKp[2], vBp[2], vKt[2], vRp[2];
#pragma unroll
          for (int e2 = 0; e2 < 2; ++e2) {
            const int i8 = 2 * p2 + e2, i = 8 * h8 + i8;
            const float gsv = Wl[sr * 65 + cseg + i];
            const float gpv = (sr > 0) ? Wl[(sr - 1) * 65 + cseg + i] : 1.f;
            const float kh = kk[i] * xi[i8] * rn;
            const float kt = kk[i] * (1.f + (aa[i] - 1.f) * al[i8]);
            const float bq = aa[i] * kh;
            const float ig = __builtin_amdgcn_rcpf(gsv);
            bsum += rr[i] * rho[i8] * kt;
            vKp[e2] = gpv * kh; vBp[e2] = bq * ig; vKt[e2] = kt * ig; vRp[e2] = gsv * rr[i];
            if (sr == 63) gC[cseg + i] = gsv;
          }
          wKp[p2] = pack2(vKp[0], vKp[1]); wBp[p2] = pack2(vBp[0], vBp[1]); wKt[p2] = pack2(vKt[0], vKt[1]); wRp[p2] = pack2(vRp[0], vRp[1]);
          wV[p2] = pack2(vv[8 * h8 + 2 * p2], vv[8 * h8 + 2 * p2 + 1]);
        }
        *(u32x4*)(slot[2] + o + 8 * h8) = wKp;
        *(u32x4*)(slot[3] + o + 8 * h8) = wBp;
        *(u32x4*)(slot[4] + o + 8 * h8) = wKt;
        *(u32x4*)(slot[5] + o + 8 * h8) = wRp;
        *(u32x4*)(slot[6] + o + 8 * h8) = wV;
      }
    }
    bsum += __shfl_xor(bsum, 1);
    bsum += __shfl_xor(bsum, 2);
    if (q4 == 0 && cc < 256) P.bon[((size_t)dir * L + trow) * 8 + hd] = bsum;
  }
  HALF_BARRIER();
  {
    f32x16 m2 = mm_tile<true, true>(slot[2], slot[3], ti, tj, lane, zero16());
    f32x16 m1 = mm_tile<true, true>(slot[2], slot[4], ti, tj, lane, zero16());
    const int c = tj * 32 + (lane & 31), h = lane >> 5;
#pragma unroll
    for (int g = 0; g < 16; ++g) {
      const int r = ti * 32 + crow(g, h);
      m2[g] = (r > c) ? m2[g] : 0.f;
      m1[g] = (r > c) ? m1[g] : 0.f;
    }
    store_rm_bf16(slot[0], m2, ti, tj, lane);
    store_rm_bf16(slot[7], m1, ti, tj, lane);
  }
  HALF_BARRIER();
  f32x16 x1 = mm_tile<true, false>(slot[7], slot[6], ti, tj, lane, zero16());
  HALF_BARRIER();
  store_tr_bf16(slot[7], x1, ti, tj, lane);
  if (lw == 0) {
    const int hb = lane >> 5, j = lane & 31, o = hb * 32;
    const bf16_t* M2b = slot[0];
    bf16_t* Tb = slot[1];
    float t[32];
#pragma unroll
    for (int s = 0; s < 32; ++s) {
      float a = (s == j) ? 1.f : 0.f;
#pragma unroll
      for (int i = 0; i < s; ++i) a -= bf2f(M2b[(o + s) * LD + o + i]) * t[i];
      t[s] = a;
    }
#pragma unroll
    for (int s = 0; s < 32; ++s) Tb[(o + s) * LD + o + j] = f2bf(t[s]);
    f32x16 xx = zero16();
    {
      const int r = lane & 31, h = lane >> 5;
#pragma unroll
      for (int ks = 0; ks < 2; ++ks) {
        const int k = ks * 16 + 8 * h;
        xx = mfma32(frag_c(M2b, 32 + r, k), frag_s(Tb, k, r), xx);
      }
#pragma unroll
      for (int g = 0; g < 4; ++g) {
        u32x2 v;
        v[0] = pack2(xx[4 * g], xx[4 * g + 1]);
        v[1] = pack2(xx[4 * g + 2], xx[4 * g + 3]);
        *(u32x2*)(Tb + r * LD + 32 + 8 * g + 4 * h) = v;
      }
      f32x16 t21 = zero16();
#pragma unroll
      for (int ks = 0; ks < 2; ++ks) {
        const int k = ks * 16 + 8 * h;
        t21 = mfma32(frag_c(Tb, 32 + r, 32 + k), frag_c(Tb, r, 32 + k), t21);
      }
#pragma unroll
      for (int g = 0; g < 16; ++g) Tb[(32 + crow(g, h)) * LD + r] = f2bf(-t21[g]);
#pragma unroll
      for (int g = 0; g < 16; ++g) Tb[(g + 16 * h) * LD + 32 + r] = 0;
    }
  }
  HALF_BARRIER();
  f32x16 wm = mm_tile<true, false>(slot[1], slot[2], ti, tj, lane, zero16());
  f32x16 uu = mm_tile<true, true>(slot[1], slot[7], ti, tj, lane, zero16());
  HALF_BARRIER();
  {
    store_tr_bf16(slot[2], wm, ti, tj, lane);
    store_tr_bf16(slot[7], uu, ti, tj, lane);
    f32x16 q1 = mm_tile<true, true>(slot[5], slot[4], ti, tj, lane, zero16());
    f32x16 q2 = mm_tile<true, true>(slot[5], slot[3], ti, tj, lane, zero16());
    const int c = tj * 32 + (lane & 31), h = lane >> 5;
#pragma unroll
    for (int g = 0; g < 16; ++g) {
      const int r = ti * 32 + crow(g, h);
      q1[g] = (r >= c) ? q1[g] : 0.f;
      q2[g] = (r >= c) ? q2[g] : 0.f;
    }
    store_rm_bf16(slot[0], q1, ti, tj, lane);
    store_rm_bf16(slot[1], q2, ti, tj, lane);
  }
  HALF_BARRIER();
  {
    const int c = tj * 32 + (lane & 31), h = lane >> 5;
    f32x16 acc = mm_tile<true, true>(slot[1], slot[2], ti, tj, lane, zero16());
    bf16_t* rpp = P.rpp + (size_t)task * 4096;
#pragma unroll
    for (int g = 0; g < 16; ++g) {
      const int r = ti * 32 + crow(g, h);
      const int tt = dir ? 63 - r : r;
      rpp[tt * 64 + c] = f2bf(bf2f(slot[5][r * LD + c]) - acc[g]);
    }
    __builtin_amdgcn_sched_barrier(0);
    {
      f32x16 y1 = mm_tile<true, false>(slot[0], slot[6], ti, tj, lane, zero16());
      f32x16 y2 = mm_tile<true, true>(slot[1], slot[7], ti, tj, lane, zero16());
      float* yl = P.yl + (size_t)task * 4096 + (dir ? ((1 - ti) * 2 + tj) * 1024 + (lane ^ 32) * 4 : (ti * 2 + tj) * 1024 + lane * 4);
#pragma unroll
      for (int q = 0; q < 4; ++q) {
        f32x4 v;
#pragma unroll
        for (int e = 0; e < 4; ++e) { const int gd = 4 * q + e; v[e] = dir ? (y1[15 - gd] - y2[15 - gd]) : (y1[gd] - y2[gd]); }
        *(f32x4*)(yl + 256 * q) = v;
      }
    }
    __builtin_amdgcn_sched_barrier(0);
    f32x16 gacc = mm_tile<false, true>(slot[3], slot[2], ti, tj, lane, zero16());
    bf16_t* gt = P.gt + (size_t)task * 4096;
#pragma unroll
    for (int g = 0; g < 16; ++g) {
      const int r = ti * 32 + crow(g, h);
      gt[r * 64 + c] = f2bf(gC[r] * (((r == c) ? 1.f : 0.f) - gacc[g]));
    }
    __builtin_amdgcn_sched_barrier(0);
    {
      f32x16 h1 = mm_tile<false, false>(slot[4], slot[6], ti, tj, lane, zero16());
      f32x16 h2 = mm_tile<false, true>(slot[3], slot[7], ti, tj, lane, zero16());
      float* ht = P.ht + (size_t)task * 4096 + (ti * 2 + tj) * 1024 + lane * 4;
#pragma unroll
      for (int q = 0; q < 4; ++q) {
        f32x4 v;
#pragma unroll
        for (int e = 0; e < 4; ++e) { const int g = 4 * q + e; v[e] = gC[ti * 32 + crow(g, h)] * (h1[g] - h2[g]); }
        *(f32x4*)(ht + 256 * q) = v;
      }
    }
  }
  HALF_BARRIER();
}

#undef HALF_BARRIER
DI void phase3(const Params& P, char* smem) {
  const int tid_ = fresh_tid();
  const int half = tid_ >> 8, lt = tid_ & 255;
  char* hs = smem + half * (8 * SLOT + 256);
  LAS unsigned* hctr = (LAS unsigned*)(smem + 2 * (8 * SLOT + 256) + 64 * half);
  if (lt == 0) *hctr = 0u;
  unsigned hgen = 0;
  __syncthreads();
  for (int pair = blockIdx.x; pair < NTASK / 2; pair += gridDim.x) {
    const int task = pair * 2 + half;
    phase3_task(P, hs, task, lt, hctr, hgen);
  }
  __syncthreads();
  if (blockIdx.x >= 32) prep_experts(P, smem, blockIdx.x - 32, gridDim.x - 32, PREP_E0, PREP_E1);
}

DI int p4_task(int n, int dir, int hd) {
  int cc;
  if (dir == 0) cc = (n < 4) ? 256 + n : n - 4;
  else cc = 259 - n;
  return cc * 16 + dir * 8 + hd;
}
struct P4Buf { bf16x8 g[4]; f32x16 h; };
DI void p4_load(const Params& P, P4Buf& B, int n, int dir, int hd, int ti, int tj, int r, int h) {
  if (n >= NCH) return;
  const int task = p4_task(n, dir, hd);
  const bf16_t* gt = P.gt + (size_t)task * 4096;
  const float* ht = P.ht + (size_t)task * 4096;
#pragma unroll
  for (int ks = 0; ks < 4; ++ks) B.g[ks] = *(const bf16x8*)(gt + (ti * 32 + r) * 64 + ks * 16 + 8 * h);
  const float* hp = ht + (ti * 2 + tj) * 1024 + (r + 32 * h) * 4;
#pragma unroll
  for (int q = 0; q < 4; ++q) {
    const f32x4 v = *(const f32x4*)(hp + 256 * q);
    B.h[4 * q] = v[0]; B.h[4 * q + 1] = v[1]; B.h[4 * q + 2] = v[2]; B.h[4 * q + 3] = v[3];
  }
}
DI void p4_step(const Params& P, const P4Buf& B, bf16_t* Scur, bf16_t* Snext, int n, int dir, int hd, int tid, int ti, int tj, int lane) {
  const int task = p4_task(n, dir, hd);
  const int r = lane & 31, h = lane >> 5;
  {
    const int v = tid >> 2, sg = (tid & 3) * 16;
    u32x4 a = *(const u32x4*)(Scur + v * LD + sg), b = *(const u32x4*)(Scur + v * LD + sg + 8);
    bf16_t* dst = P.s0 + (size_t)task * 4096 + v * 64 + sg;
    *(u32x4*)dst = a;
    *(u32x4*)(dst + 8) = b;
  }
  f32x16 acc = B.h;
#pragma unroll
  for (int ks = 0; ks < 4; ++ks) acc = mfma32(B.g[ks], frag_c(Scur, tj * 32 + r, ks * 16 + 8 * h), acc);
  store_tr_bf16(Snext, acc, ti, tj, lane);
}
DI void phase4(const Params& P, char* smem) {
  if (blockIdx.x >= 16) { prep_experts(P, smem, blockIdx.x - 16, gridDim.x - 16, PREP_E2, PREP_TOTAL); return; }
  const int tid = fresh_tid();
  const int chain = blockIdx.x, dir = chain >> 3, hd = chain & 7;
  bf16_t* S0b = (bf16_t*)smem;
  bf16_t* S1b = (bf16_t*)(smem + SLOT);
  const int lw = tid >> 6, lane = tid & 63, ti = lw >> 1, tj = lw & 1, r = lane & 31, h = lane >> 5;
  const bool work = tid < 256;
  if (work) {
    for (int i = tid; i < 64 * LD; i += 256) S0b[i] = 0;
  }
  P4Buf B0, B1, B2, B3;
  if (work) {
    p4_load(P, B0, 0, dir, hd, ti, tj, r, h);
    p4_load(P, B1, 1, dir, hd, ti, tj, r, h);
    p4_load(P, B2, 2, dir, hd, ti, tj, r, h);
    p4_load(P, B3, 3, dir, hd, ti, tj, r, h);
  }
  __syncthreads();
  for (int n = 0; n < NCH; n += 4) {
    if (work) { p4_step(P, B0, S0b, S1b, n, dir, hd, tid, ti, tj, lane); p4_load(P, B0, n + 4, dir, hd, ti, tj, r, h); }
    __syncthreads();
    if (work) { p4_step(P, B1, S1b, S0b, n + 1, dir, hd, tid, ti, tj, lane); p4_load(P, B1, n + 5, dir, hd, ti, tj, r, h); }
    __syncthreads();
    if (work) { p4_step(P, B2, S0b, S1b, n + 2, dir, hd, tid, ti, tj, lane); p4_load(P, B2, n + 6, dir, hd, ti, tj, r, h); }
    __syncthreads();
    if (work) { p4_step(P, B3, S1b, S0b, n + 3, dir, hd, tid, ti, tj, lane); p4_load(P, B3, n + 7, dir, hd, ti, tj, r, h); }
    __syncthreads();
  }
}

DI void unpack8(const u32x4& w, float* o) {
#pragma unroll
  for (int i = 0; i < 4; ++i) { o[2 * i] = __uint_as_float(w[i] << 16); o[2 * i + 1] = __uint_as_float(w[i] & 0xFFFF0000u); }
}
DI void phase5(const Params& P, char* smem) {
  bf16_t* SG = (bf16_t*)smem;
  bf16_t* VS = (bf16_t*)(smem + 17408);
  float* BON = (float*)(smem + 17408 + 66560);
  constexpr int LG = 136, LV = 520;
  for (int cc = blockIdx.x; cc < 256; cc += gridDim.x) {
    const int tid = fresh_tid();
    const int wid = __builtin_amdgcn_readfirstlane(tid >> 6);
    const int rb = cc * 64;
    {
      const int c = (tid & 63) * 8, t0 = (tid >> 6) * 8;
      float z[10][8];
#pragma unroll
      for (int i = 0; i < 10; ++i) {
        const int t = t0 - 1 + i;
        if (t >= 0 && t < 64) {
          const bf16_t* pr = P.p + (size_t)(rb + t) * PIN + c;
          float cg[8], vv[8];
          unpack8(*(const u32x4*)(pr + 512), cg);
          unpack8(*(const u32x4*)(pr + 1024), vv);
#pragma unroll
          for (int j = 0; j < 8; ++j) z[i][j] = cg[j] * vv[j];
        } else {
#pragma unroll
          for (int j = 0; j < 8; ++j) z[i][j] = 0.f;
        }
      }
      float w0[8], w1[8], w2[8];
#pragma unroll
      for (int j = 0; j < 8; ++j) { w0[j] = P.conv_w[c + j]; w1[j] = P.conv_w[512 + c + j]; w2[j] = P.conv_w[1024 + c + j]; }
#pragma unroll
      for (int i = 0; i < 8; ++i) {
        float bg[8];
        unpack8(*(const u32x4*)(P.p + (size_t)(rb + t0 + i) * PIN + c), bg);
        u32x4 o;
#pragma unroll
        for (int j = 0; j < 4; ++j) {
          const float y0 = bg[2 * j] * (w0[2 * j] * z[i][2 * j] + w1[2 * j] * z[i + 1][2 * j] + w2[2 * j] * z[i + 2][2 * j]);
          const float y1 = bg[2 * j + 1] * (w0[2 * j + 1] * z[i][2 * j + 1] + w1[2 * j + 1] * z[i + 1][2 * j + 1] + w2[2 * j + 1] * z[i + 2][2 * j + 1]);
          o[j] = pack2(y0, y1);
        }
        *(u32x4*)(P.mixin + (size_t)(rb + t0 + i) * D + c) = o;
      }
    }
    {
      float tmp[16];
      const int row = tid >> 3, cs = (tid & 7) * 16;
      ShiftRaw rg, rq[4];
      shift_raw(P, rb + row, 0, L, 3328 + cs, rg);
#pragma unroll
      for (int q = 0; q < 4; ++q) shift_raw(P, rb + row, 0, L, PRW0 + 1024 + (tid & 7) * 64 + q * 16, rq[q]);
      shift_finish(P, rg, 3328 + cs, tmp);
#pragma unroll
      for (int i = 0; i < 16; ++i) tmp[i] = sigm(tmp[i]);
      st16_bf16(SG + row * LG + cs, tmp);
#pragma unroll
      for (int q = 0; q < 4; ++q) {
        const int vc = (tid & 7) * 64 + q * 16;
        shift_finish(P, rq[q], PRW0 + 1024 + vc, tmp);
        st16_bf16(VS + row * LV + vc, tmp);
      }
      const int t = tid >> 3, hd = tid & 7;
      BON[t * 8 + hd] = P.bon[(size_t)(rb + t) * 8 + hd] + P.bon[((size_t)L + rb + t) * 8 + hd];
    }
    __syncthreads();
    const int hd = wid;
#pragma unroll 1
    for (int ti = 0; ti < 2; ++ti) {
      int lane = tid & 63;
      asm volatile("" : "+v"(lane));
      const int r = lane & 31, h = lane >> 5;
      f32x16 y[2], gg[2];
#pragma unroll
      for (int tj = 0; tj < 2; ++tj) {
        f32x16 acc;
        const int c = tj * 32 + r;
        const float* yl0 = P.yl + (size_t)(cc * 16 + hd) * 4096;
        const float* yl1 = P.yl + (size_t)(cc * 16 + 8 + hd) * 4096;
#pragma unroll
        for (int q = 0; q < 4; ++q) {
          const int fo = (ti * 2 + tj) * 1024 + 256 * q + lane * 4;
          const f32x4 a0 = *(const f32x4*)(yl0 + fo), a1 = *(const f32x4*)(yl1 + fo);
          acc[4 * q] = a0[0] + a1[0]; acc[4 * q + 1] = a0[1] + a1[1]; acc[4 * q + 2] = a0[2] + a1[2]; acc[4 * q + 3] = a0[3] + a1[3];
        }
#pragma unroll
        for (int d = 0; d < 2; ++d) {
          const size_t task = (size_t)cc * 16 + d * 8 + hd;
          const bf16_t* rp = P.rpp + task * 4096;
          const bf16_t* s0 = P.s0 + task * 4096;
#pragma unroll
          for (int ks = 0; ks < 4; ++ks) {
            const int k = ks * 16 + 8 * h;
            bf16x8 a = *(const bf16x8*)(rp + (ti * 32 + r) * 64 + k);
            bf16x8 b = *(const bf16x8*)(s0 + (tj * 32 + r) * 64 + k);
            acc = mfma32(a, b, acc);
          }
        }
        y[tj] = acc;
        gg[tj] = zero16();
      }
#pragma unroll
      for (int ks = 0; ks < 8; ++ks) {
        const int k = ks * 16 + 8 * h;
        bf16x8 a = frag_c(SG, ti * 32 + r, k, LG);
#pragma unroll
        for (int tj = 0; tj < 2; ++tj) {
          bf16x8 bfr = *(const bf16x8*)(P.gateT + (size_t)(64 * hd + tj * 32 + r) * 128 + k);
          gg[tj] = mfma32(a, bfr, gg[tj]);
        }
      }
      float gw[2], gb[2];
#pragma unroll
      for (int tj = 0; tj < 2; ++tj) {
        const int ch = 64 * hd + tj * 32 + r;
        gw[tj] = P.gn_w[ch];
        gb[tj] = P.gn_b[ch];
      }
#pragma unroll
      for (int g = 0; g < 16; ++g) {
        float sacc = y[0][g] + y[1][g];
#pragma unroll
        for (int o = 16; o > 0; o >>= 1) sacc += __shfl_xor(sacc, o);
        const float mean = sacc * (1.f / 64.f);
        const float d0 = y[0][g] - mean, d1 = y[1][g] - mean;
        float v = d0 * d0 + d1 * d1;
#pragma unroll
        for (int o = 16; o > 0; o >>= 1) v += __shfl_xor(v, o);
        const float rstd = __builtin_amdgcn_rsqf(v * (1.f / 64.f) + 64e-5f);
        const int tl = ti * 32 + crow(g, h);
        const float bonus = BON[tl * 8 + hd];
#pragma unroll
        for (int tj = 0; tj < 2; ++tj) {
          const int ch = 64 * hd + tj * 32 + r;
          const float vs = bf2f(VS[tl * LV + ch]);
          const float dn = (tj ? d1 : d0) * rstd * gw[tj] + gb[tj];
          P.mixin[(size_t)(rb + tl) * D + 512 + ch] = f2bf((dn + bonus * vs) * gg[tj][g]);
        }
      }
    }
    __syncthreads();
  }
}

struct SchedRows : g8::DenseOrder {
  static constexpr int PF_LINES = 0;
  DI void pf(const g8::Unit2&, LAS unsigned char*, int) const {}
  DI void aoffs_late(const g8::Unit2& u, LAS unsigned char*, int, int R0, int R1, int C0, int C1, unsigned (&o)[2][2]) const { aoffs(u, R0, R1, C0, C1, o); }
  const bf16_t* A; const bf16_t* Bt;
  DI const char* abase() const { return (const char*)A; }
  DI const char* bbase(const g8::Unit2& u) const { return (const char*)(Bt + (size_t)u.pn * 256 * D); }
  DI void aoffs(const g8::Unit2& u, int R0, int R1, int C0, int C1, unsigned (&o)[2][2]) const {
#pragma unroll
    for (int h = 0; h < 2; ++h) {
      o[h][0] = (unsigned)(((u.pm * 256 + h * 128 + R0) * D + C0) * 2);
      o[h][1] = (unsigned)(((u.pm * 256 + h * 128 + R1) * D + C1) * 2);
    }
  }
};
DI void phase6(const Params& P, char* smem) {
  SchedRows S; S.init(L / 256, D / 256, gridDim.x, blockIdx.x); S.A = P.mixin; S.Bt = P.woutT;
  g8::gemm<g8::Unit2>((LAS unsigned char*)smem, S,
      [&](const g8::Acc& acc, const g8::Unit2& u, int wr, int wc, int fr, int fq, int) {
        const float* g1 = P.mod + 2048 + u.pn * 256 + wc * 32 + 4 * fq;
#pragma unroll
        for (int ai = 0; ai < 2; ++ai)
#pragma unroll
          for (int m = 0; m < 4; ++m) {
            const size_t ro = (size_t)(u.pm * 256 + ai * 128 + wr * 64 + m * 16 + fr) * D + u.pn * 256 + wc * 32 + 4 * fq;
#pragma unroll
            for (int bj = 0; bj < 2; ++bj)
#pragma unroll
              for (int n = 0; n < 2; ++n) {
                const f32x4 gv = *(const f32x4*)(g1 + bj * 128 + n * 16);
                const f32x4 xv = *(const f32x4*)(P.x + ro + bj * 128 + n * 16);
                *(f32x4*)(P.x1 + ro + bj * 128 + n * 16) = xv + gv * acc[ai][bj][m][n];
              }
          }
      }, D);
}

DI void phase8(const Params& P, char* smem) {
  SchedRows S; S.init(L / 256, 3, gridDim.x, blockIdx.x); S.A = P.h2; S.Bt = P.rsT;
  g8::gemm<g8::Unit2>((LAS unsigned char*)smem, S,
      [&](const g8::Acc& acc, const g8::Unit2& u, int wr, int wc, int fr, int fq, int) {
#pragma unroll
        for (int ai = 0; ai < 2; ++ai)
#pragma unroll
          for (int m = 0; m < 4; ++m) {
            const int row = u.pm * 256 + ai * 128 + wr * 64 + m * 16 + fr;
            if (u.pn == 0) {
              float* rp = P.logits + (size_t)row * NE + wc * 32 + 4 * fq;
#pragma unroll
              for (int bj = 0; bj < 2; ++bj)
#pragma unroll
                for (int n = 0; n < 2; ++n) *(f32x4*)(rp + bj * 128 + n * 16) = acc[ai][bj][m][n];
            } else {
              bf16_t* ap = P.act + ((size_t)row * NSLOT + 8) * DE + (u.pn - 1) * 128 + 4 * fq;
#pragma unroll
              for (int bj = 0; bj < 2; ++bj) {
                const f32x4 a = acc[ai][bj][m][0], bb = acc[ai][bj][m][1];
                u32x2 w;
                w[0] = pack2(siluf(a[0]) * bb[0], siluf(a[1]) * bb[1]);
                w[1] = pack2(siluf(a[2]) * bb[2], siluf(a[3]) * bb[3]);
                *(u32x2*)(ap + 16 * (4 * bj + wc)) = w;
              }
            }
          }
      }, D);
  if ((int)gridDim.x > 192) { if ((int)blockIdx.x >= 192) prep_experts(P, smem, blockIdx.x - 192, gridDim.x - 192, PREP_E1, PREP_E2); }
  else prep_experts(P, smem, blockIdx.x, gridDim.x, PREP_E1, PREP_E2);
}

DI void phase9(const Params& P) {
  const int tid_ = fresh_tid();
  const int wid = tid_ >> 6, lane = tid_ & 63;
  for (int tok = blockIdx.x * 8 + wid; tok < L; tok += gridDim.x * 8) {
    float sc[4], bs[4];
#pragma unroll
    for (int q = 0; q < 4; ++q) {
      sc[q] = sigm(P.logits[(size_t)tok * NE + q * 64 + lane]);
      bs[q] = sc[q] + P.router_bias[q * 64 + lane];
    }
    int sel_i[8];
    float sel_s[8], ssum = 0.f;
#pragma unroll
    for (int j = 0; j < 8; ++j) {
      float best = bs[0];
      int bq = 0;
#pragma unroll
      for (int q = 1; q < 4; ++q)
        if (bs[q] > best) { best = bs[q]; bq = q; }
      float m = best;
#pragma unroll
      for (int o = 32; o > 0; o >>= 1) m = fmaxf(m, __shfl_xor(m, o));
      const unsigned long long msk = __ballot(best == m);
      const int ol = __ffsll((long long)msk) - 1;
      const int q = __shfl(bq, ol);
      const float cand = (q == 0) ? sc[0] : (q == 1) ? sc[1] : (q == 2) ? sc[2] : sc[3];
      const float s = __shfl(cand, ol);
#pragma unroll
      for (int qq = 0; qq < 4; ++qq) bs[qq] = (lane == ol && q == qq) ? -1e30f : bs[qq];
      sel_i[j] = q * 64 + ol;
      sel_s[j] = s;
      ssum += s;
    }
    const float inv = 2.5f / ssum;
    int my_e = 0;
    float my_g = 0.f;
#pragma unroll
    for (int j = 0; j < 8; ++j)
      if (lane == j) { my_e = sel_i[j]; my_g = sel_s[j] * inv; }
    if (lane < 8) {
      const int pos = atomicAdd(&P.cnt[my_e], 1);
      P.lid[(size_t)my_e * L + pos] = tok * NSLOT + lane;
      P.lgate[(size_t)my_e * L + pos] = my_g;
    }
  }
}

DI int moe_prefix(const Params& P, int* pre, int tid) {
  if (tid == 0) {
    int s = 0;
    for (int e = 0; e < 257; ++e) {
      pre[e] = s;
      const int c = (e < 256) ? P.cnt[e] : L;
      s += (c + 255) >> 8;
    }
    pre[257] = s;
  }
  __syncthreads();
  return pre[257];
}
DI int find_expert(const int* pre, int mt) {
  int lo = 0, hi = 256;
  while (lo < hi) {
    const int mid = (lo + hi + 1) >> 1;
    if (pre[mid] <= mt) lo = mid; else hi = mid - 1;
  }
  return lo;
}
DI int row_id(const Params& P, int e, int gi, int cnt) {
  const int g = gi < cnt ? gi : cnt - 1;
  return (e < 256) ? P.lid[(size_t)e * L + g] : g * NSLOT + 8;
}

struct UnitM { int e, mt, nt, cnt; };
template <int NN, int NEXP, int KD>
struct SchedMoe {
  static constexpr int PF_LINES = 0;
  const Params* P; const int* pre; int total, G, c;
  const bf16_t* A; const bf16_t* Bt;
  DI bool compute(int i, UnitM& u) const {
    const int U = total * NN, CH = (U + 7) >> 3;
    const int k = (c >> 3) + (G >> 3) * i;
    if (k >= CH) return false;
    const long Lx = (long)(c & 7) * CH + k; if (Lx >= U) return false;
    const int mtg = (int)(Lx / NN); u.nt = (int)(Lx % NN);
    u.e = find_expert(pre, mtg);
    u.mt = mtg - pre[u.e];
    u.cnt = pre[260 + u.e];
    return true;
  }
  DI void tabulate(int tid) const {
    if (tid < 16) {
      UnitM u; u.e = -1; u.mt = 0; u.nt = 0; u.cnt = 0;
      (void)compute(tid, u);
      int* tb = const_cast<int*>(pre) + 800 + tid * 4;
      tb[0] = u.e; tb[1] = u.mt; tb[2] = u.nt; tb[3] = u.cnt;
    }
    __syncthreads();
  }
  DI bool next(int i, UnitM& u) const {
    if (i >= 16) return false;
    const int* tb = pre + 800 + i * 4;
    u.e = __builtin_amdgcn_readfirstlane(tb[0]);
    if (u.e < 0) return false;
    u.mt = __builtin_amdgcn_readfirstlane(tb[1]);
    u.nt = __builtin_amdgcn_readfirstlane(tb[2]);
    u.cnt = __builtin_amdgcn_readfirstlane(tb[3]);
    return true;
  }
  static constexpr int IDS_OFF = 144384;
  DI void pf(const UnitM& u, LAS unsigned char* lds, int buf) const {
    const int tid = fresh_tid(), wid = __builtin_amdgcn_readfirstlane(tid >> 6);
    if (tid < 256) {
      const int gi = u.mt * 256 + tid, gc = gi < u.cnt ? gi : u.cnt - 1;
      const int* src = (u.e < 256) ? P->lid + (size_t)u.e * L + gc : P->ident + gc;
      __builtin_amdgcn_global_load_lds((const unsigned*)src, (LAS unsigned*)(lds + IDS_OFF + buf * 2048 + wid * 256), 4, 0, 0);
      if (KD != D) {
        const float* gs = (u.e < 256) ? P->lgate + (size_t)u.e * L + gc : P->ones;
        __builtin_amdgcn_global_load_lds((const unsigned*)gs, (LAS unsigned*)(lds + IDS_OFF + buf * 2048 + 1024 + wid * 256), 4, 0, 0);
      }
    }
  }
  DI void aoffs_late(const UnitM& u, LAS unsigned char* lds, int buf, int R0, int R1, int C0, int C1, unsigned (&o)[2][2]) const {
    const LAS int* ids = (const LAS int*)(lds + IDS_OFF + buf * 2048);
#pragma unroll
    for (int h = 0; h < 2; ++h) {
      const int i0 = ids[h * 128 + R0], i1 = ids[h * 128 + R1];
      o[h][0] = (unsigned)((KD == D) ? (i0 / NSLOT) : i0) * (unsigned)(KD * 2) + C0 * 2;
      o[h][1] = (unsigned)((KD == D) ? (i1 / NSLOT) : i1) * (unsigned)(KD * 2) + C1 * 2;
    }
  }
  DI const char* abase() const { return (const char*)A; }
  DI const char* bbase(const UnitM& u) const { return (const char*)(Bt + ((size_t)u.e * NN + u.nt) * 256 * KD); }
  DI unsigned arow(const UnitM& u, int r) const {
    const int id = row_id(*P, u.e, u.mt * 256 + r, u.cnt);
    return (unsigned)((KD == D) ? (id / NSLOT) : id) * (unsigned)(KD * 2);
  }
  DI void aoffs(const UnitM& u, int R0, int R1, int C0, int C1, unsigned (&o)[2][2]) const {
#pragma unroll
    for (int h = 0; h < 2; ++h) { o[h][0] = arow(u, h * 128 + R0) + C0 * 2; o[h][1] = arow(u, h * 128 + R1) + C1 * 2; }
  }
};
DI int moe_prefix_n(const Params& P, int* pre, int tid, int nexp) {
  int* tl = pre + 520;
  if (tid < 258) {
    const int c = (tid < 256) ? P.cnt[tid] : L;
    pre[260 + tid] = c;
    tl[tid] = (tid < nexp) ? ((c + 255) >> 8) : 0;
  }
  __syncthreads();
  if (tid < 258) {
    int sacc = 0;
    for (int e = 0; e < tid; ++e) sacc += tl[e];
    pre[tid] = sacc;
  }
  __syncthreads();
  return __builtin_amdgcn_readfirstlane(pre[257]);
}
DI void phase10(const Params& P, char* smem) {
  int* pre = (int*)(smem + 137216);
  SchedMoe<2, 256, D> S;
  S.total = moe_prefix_n(P, pre, fresh_tid(), 256);
  S.P = &P; S.pre = pre; S.G = gridDim.x; S.c = blockIdx.x; S.A = P.h2; S.Bt = P.w13T;
  S.tabulate(fresh_tid());
  g8::gemm<UnitM>((LAS unsigned char*)smem, S,
      [&](const g8::Acc& acc, const UnitM& u, int wr, int wc, int fr, int fq, int buf) {
        const int* IDS = (const int*)(smem + 144384 + buf * 2048);
#pragma unroll
        for (int ai = 0; ai < 2; ++ai)
#pragma unroll
          for (int m = 0; m < 4; ++m) {
            const int gi = u.mt * 256 + ai * 128 + wr * 64 + m * 16 + fr;
            if (gi < u.cnt) {
              bf16_t* ap = P.act + (size_t)IDS[ai * 128 + wr * 64 + m * 16 + fr] * DE + u.nt * 128 + 4 * fq;
#pragma unroll
              for (int bj = 0; bj < 2; ++bj) {
                const f32x4 a = acc[ai][bj][m][0], bb = acc[ai][bj][m][1];
                u32x2 w;
                w[0] = pack2(siluf(a[0]) * bb[0], siluf(a[1]) * bb[1]);
                w[1] = pack2(siluf(a[2]) * bb[2], siluf(a[3]) * bb[3]);
                *(u32x2*)(ap + 16 * (4 * bj + wc)) = w;
              }
            }
          }
      }, D);
}

DI void phase11(const Params& P, char* smem) {
  int* pre = (int*)(smem + 137216);
  SchedMoe<4, 257, DE> S;
  S.total = moe_prefix_n(P, pre, fresh_tid(), 257);
  S.P = &P; S.pre = pre; S.G = gridDim.x; S.c = blockIdx.x; S.A = P.act; S.Bt = P.w2T;
  S.tabulate(fresh_tid());
  g8::gemm<UnitM>((LAS unsigned char*)smem, S,
      [&](const g8::Acc& acc, const UnitM& u, int wr, int wc, int fr, int fq, int buf) {
        const int* IDS = (const int*)(smem + 144384 + buf * 2048);
        const float* GTS = (const float*)(smem + 144384 + buf * 2048 + 1024);
#pragma unroll
        for (int ai = 0; ai < 2; ++ai)
#pragma unroll
          for (int m = 0; m < 4; ++m) {
            const int gi = u.mt * 256 + ai * 128 + wr * 64 + m * 16 + fr;
            if (gi < u.cnt) {
              const int row = ai * 128 + wr * 64 + m * 16 + fr;
              const float gate = GTS[row] * SLAB_SCALE;
              unsigned char* sp = P.slab + (size_t)IDS[row] * D + u.nt * 256 + wc * 64 + 16 * fq;
              u32x4 w;
#pragma unroll
              for (int bj = 0; bj < 2; ++bj)
#pragma unroll
                for (int n = 0; n < 2; ++n) {
                  const f32x4 v = acc[ai][bj][m][n];
                  int q = 0;
                  q = __builtin_amdgcn_cvt_pk_fp8_f32(__builtin_amdgcn_fmed3f(gate * v[0], -440.f, 440.f), __builtin_amdgcn_fmed3f(gate * v[1], -440.f, 440.f), q, false);
                  q = __builtin_amdgcn_cvt_pk_fp8_f32(__builtin_amdgcn_fmed3f(gate * v[2], -440.f, 440.f), __builtin_amdgcn_fmed3f(gate * v[3], -440.f, 440.f), q, true);
                  w[2 * bj + n] = (unsigned)q;
                }
              *(u32x4*)sp = w;
            }
          }
      }, DE);
}

DI void phase12(const Params& P) {
  const int tid_ = fresh_tid();
  const int wid = tid_ >> 6, lane = tid_ & 63;
  const float* g2 = P.mod + 5120;
  for (int row = blockIdx.x * 8 + wid; row < L; row += gridDim.x * 8) {
    float v[2][8];
    float ss = 0.f;
#pragma unroll
    for (int i = 0; i < 2; ++i) {
      const int c = i * 512 + lane * 8;
      float sacc[8];
#pragma unroll
      for (int j = 0; j < 8; ++j) sacc[j] = 0.f;
#pragma unroll
      for (int j = 0; j < NSLOT; ++j) {
        const u32x2 w = __builtin_nontemporal_load((const u32x2*)(P.slab + ((size_t)row * NSLOT + j) * D + c));
#pragma unroll
        for (int e = 0; e < 2; ++e) {
          const f32x2v lo = __builtin_amdgcn_cvt_pk_f32_fp8((int)w[e], false), hi = __builtin_amdgcn_cvt_pk_f32_fp8((int)w[e], true);
          sacc[4 * e] += lo[0]; sacc[4 * e + 1] += lo[1]; sacc[4 * e + 2] += hi[0]; sacc[4 * e + 3] += hi[1];
        }
      }
      const f32x4 x0 = *(const f32x4*)(P.x1 + (size_t)row * D + c), x1v = *(const f32x4*)(P.x1 + (size_t)row * D + c + 4);
      const f32x4 g0 = *(const f32x4*)(g2 + c), g1v = *(const f32x4*)(g2 + c + 4);
#pragma unroll
      for (int j = 0; j < 4; ++j) {
        v[i][j] = x0[j] + g0[j] * (sacc[j] * (1.f / SLAB_SCALE));
        v[i][4 + j] = x1v[j] + g1v[j] * (sacc[4 + j] * (1.f / SLAB_SCALE));
        ss += v[i][j] * v[i][j] + v[i][4 + j] * v[i][4 + j];
      }
    }
    ss = wave_sum(ss);
    const float rs = __builtin_amdgcn_rsqf(ss * (1.f / 1024.f) + 1e-6f);
#pragma unroll
    for (int i = 0; i < 2; ++i) {
      const int c = i * 512 + lane * 8;
      const f32x4 f0 = *(const f32x4*)(P.final_g + c), f1 = *(const f32x4*)(P.final_g + c + 4);
      f32x4 o0, o1;
#pragma unroll
      for (int j = 0; j < 4; ++j) { o0[j] = v[i][j] * rs * f0[j]; o1[j] = v[i][4 + j] * rs * f1[j]; }
      __builtin_nontemporal_store(o0, (f32x4*)(P.out + (size_t)row * D + c));
      __builtin_nontemporal_store(o1, (f32x4*)(P.out + (size_t)row * D + c + 4));
    }
  }
}

__global__ void __launch_bounds__(NTHR) mega(Params P) {
  cg::grid_group grid = cg::this_grid();
  extern __shared__ __attribute__((aligned(16))) char smem[];
  volatile LAS unsigned* xst = (volatile LAS unsigned*)(smem + kDynLds - 16);
  if (threadIdx.x < 4) xst[threadIdx.x] = 0u;
  __syncthreads();
  XcdBarrier xb = xcd_barrier_post(P.bar, xst);
  prep_dense_win(P, smem);
  phase0(P, smem);
  if (P.coop_probe) grid.sync();
  xcd_barrier(xb);
  phase1(P);
  xcd_barrier(xb);
  phase2(P, smem);
  xcd_barrier(xb);
  phase3(P, smem);
  xcd_barrier(xb);
  phase4(P, smem);
  xcd_barrier(xb);
  phase5(P, smem);
  xcd_barrier(xb);
  phase6(P, smem);
  xcd_barrier(xb);
  phase7(P);
  xcd_barrier(xb);
  phase8(P, smem);
  xcd_barrier(xb);
  phase9(P);
  xcd_barrier(xb);
  phase10(P, smem);
  xcd_barrier(xb);
  phase11(P, smem);
  xcd_barrier(xb);
  phase12(P);
}

extern "C" void kernel_launch(void* const* d_in, const int* in_sizes, int n_in, void* d_out, int out_size, void* d_ws,
                              size_t ws_size, hipStream_t stream) {
  static int grid_blocks = 0;
  if (!grid_blocks) {
    int dev = 0, cus = 0, per_cu = 0;
    (void)hipGetDevice(&dev);
    (void)hipDeviceGetAttribute(&cus, hipDeviceAttributeMultiprocessorCount, dev);
    (void)hipFuncSetAttribute((const void*)mega, hipFuncAttributeMaxDynamicSharedMemorySize, (int)kDynLds);
    (void)hipOccupancyMaxActiveBlocksPerMultiprocessor(&per_cu, mega, NTHR, kDynLds);
    if (per_cu > 1) per_cu = 1;
    grid_blocks = cus * per_cu;
  }
  Params P{};
  const float* const* in = (const float* const*)d_in;
  P.x = in[0]; P.c = in[1]; P.ctx = in[2]; P.c_ctx = in[3]; P.ada_w = in[4]; P.ada_b = in[5]; P.norm1_g = in[6]; P.norm2_g = in[7];
  P.w_in = in[8]; P.conv_w = in[9]; P.shift_mu = in[10]; P.decay_w0 = in[11]; P.decay_up = in[12]; P.iclr_a0 = in[13];
  P.iclr_up = in[14]; P.key_xi = in[15]; P.key_alpha = in[16]; P.bonus_rho = in[17]; P.gate_up = in[18]; P.gn_w = in[19];
  P.gn_b = in[20]; P.w_out = in[21]; P.router_w = in[22]; P.router_bias = in[23]; P.exp_w1 = in[24]; P.exp_w3 = in[25];
  P.exp_w2 = in[26]; P.sh_w1 = in[27]; P.sh_w3 = in[28]; P.sh_w2 = in[29]; P.final_g = in[30];
  P.out = (float*)d_out;
  char* w = (char*)d_ws;
  size_t off = 0;
  auto take = [&](size_t bytes) { char* r = w + off; off += (bytes + 255) & ~(size_t)255; return r; };
  P.mod = (float*)take(6144 * 4);
  P.modc = (float*)take(6144 * 4);
  P.cnt = (int*)take(272 * 4);
  P.bar = (unsigned*)take(XCD_BAR_WORDS * 4);
  P.ident = (int*)take((size_t)L * 4);
  P.ones = (float*)take(1024);
  P.winT = (bf16_t*)take((size_t)PIN * D * 2);
  P.woutT = (bf16_t*)take((size_t)D * D * 2);
  P.rsT = (bf16_t*)take((size_t)768 * D * 2);
  P.gateT = (bf16_t*)take((size_t)512 * 128 * 2);
  P.bon = (float*)take((size_t)2 * L * 8 * 4);
  P.mixin = (bf16_t*)take((size_t)L * D * 2);
  P.w2T = (bf16_t*)take((size_t)257 * D * DE * 2);
  {
    const size_t r1 = off;
    P.hx = (bf16_t*)take((size_t)LT * D * 2);
    P.p = (bf16_t*)take((size_t)LT * PIN * 2 + 65536);
    const size_t r1_end = off;
    off = r1;
    P.x1 = (float*)take((size_t)L * D * 4);
    if (off < r1_end) off = r1_end;
  }
  {
    const size_t r2 = off;
    P.rpp = (bf16_t*)take((size_t)NTASK * 4096 * 2);
    P.yl = (float*)take((size_t)NTASK * 4096 * 4);
    P.gt = (bf16_t*)take((size_t)NTASK * 4096 * 2);
    P.ht = (float*)take((size_t)NTASK * 4096 * 4);
    P.s0 = (bf16_t*)take((size_t)NTASK * 4096 * 2);
    const size_t r2_end = off;
    off = r2;
    P.h2 = (bf16_t*)take((size_t)L * D * 2);
    P.logits = (float*)take((size_t)L * NE * 4);
    P.lid = (int*)take((size_t)NE * L * 4);
    P.lgate = (float*)take((size_t)NE * L * 4);
    P.act = (bf16_t*)take((size_t)L * NSLOT * DE * 2);
    if (off < r2_end) off = r2_end;
  }
  {
    const size_t r4 = off;
    P.w13T = (bf16_t*)take((size_t)256 * 512 * D * 2);
    const size_t r4_end = off;
    off = r4;
    P.slab = (unsigned char*)take((size_t)L * NSLOT * D);
    if (off < r4_end) off = r4_end;
  }
  if (off > ws_size) fprintf(stderr, "workspace too small: need %zu have %zu\n", off, ws_size);
  (void)hipMemsetAsync(P.bar, 0, XCD_BAR_WORDS * 4, stream);
  void* args[] = {&P};
  hipError_t e = hipLaunchCooperativeKernel((void*)mega, dim3(grid_blocks), dim3(NTHR), args, kDynLds, stream);
  if (e != hipSuccess) fprintf(stderr, "cooperative launch failed: %s (grid %d)\n", hipGetErrorString(e), grid_blocks);
}
```

```cpp
#include <hip/hip_runtime.h>
#include <hip/hip_cooperative_groups.h>
#include <cstdio>
#include <cstdint>
namespace cg = cooperative_groups;

#define DI __device__ __forceinline__
__device__ __forceinline__ int fresh_tid() { int t = threadIdx.x; asm volatile("" : "+v"(t)); return t; }
typedef unsigned short bf16_t;
typedef short bf16x8 __attribute__((ext_vector_type(8)));
typedef float f32x4 __attribute__((ext_vector_type(4)));
typedef float f32x16 __attribute__((ext_vector_type(16)));
typedef unsigned u32x4 __attribute__((ext_vector_type(4)));
typedef unsigned u32x2 __attribute__((ext_vector_type(2)));

constexpr int D = 1024, L = 16384, LC = 256, LT = L + LC;
constexpr int PINW = 3456;
constexpr int PIN = 3584, PRW0 = 1536;
constexpr int NE = 256, TOPK = 8, DE = 256;
constexpr int NCH = LT / 64;
constexpr int NTASK = NCH * 16;
constexpr int NSLOT = 9;
constexpr int NTHR = 512;
constexpr size_t kDynLds = 152 * 1024;
constexpr float SLAB_SCALE = 8.f;


struct Params {
  const float *x, *c, *ctx, *c_ctx, *ada_w, *ada_b, *norm1_g, *norm2_g, *w_in, *conv_w, *shift_mu, *decay_w0, *decay_up,
      *iclr_a0, *iclr_up, *key_xi, *key_alpha, *bonus_rho, *gate_up, *gn_w, *gn_b, *w_out, *router_w, *router_bias, *exp_w1,
      *exp_w3, *exp_w2, *sh_w1, *sh_w3, *sh_w2, *final_g;
  float* out;
  float *mod, *modc;
  int* cnt;
  int coop_probe, pad0;
  int* ident; float* ones;
  unsigned* bar;
  unsigned* qh;
  unsigned* flags;
  bf16_t* hx;
  bf16_t *winT, *woutT, *rsT, *w13T, *w2T, *gateT;
  bf16_t* p;
  bf16_t* rpp;
  float* yl;
  bf16_t* gt;
  float* ht;
  bf16_t* s0;
  float* bon;
  bf16_t* mixin;
  float* x1;
  bf16_t* h2;
  float* logits;
  int* lid;
  float* lgate;
  bf16_t* act;
  unsigned char* slab;
};

DI float bf2f(bf16_t h) { return __uint_as_float(((unsigned)h) << 16); }
typedef float f32x2v __attribute__((ext_vector_type(2)));
typedef __bf16 bf16x2v __attribute__((ext_vector_type(2)));
DI bf16_t f2bf(float f) { return __builtin_bit_cast(unsigned short, (__bf16)f); }
DI unsigned pack2(float lo, float hi) {
  f32x2v v = {lo, hi};
  return __builtin_bit_cast(unsigned, __builtin_convertvector(v, bf16x2v));
}
DI float sigm(float x) { return __builtin_amdgcn_rcpf(1.f + __expf(-x)); }
DI float siluf(float x) { return x * sigm(x); }
DI float tanh_(float x) { return 1.f - 2.f * __builtin_amdgcn_rcpf(1.f + __expf(2.f * x)); }
DI float wave_sum(float v) {
#pragma unroll
  for (int o = 32; o > 0; o >>= 1) v += __shfl_xor(v, o);
  return v;
}


#define XB_TMO      128
#define XB_XCNT(j)  (256  + 64 * (j))
#define XB_XSUB(j)  (1280 + 64 * (j))
#define XB_XGEN(j)  (2304 + 64 * (j))
#define XB_TOP      3328
#define XB_TOPGEN   3392
#define XCD_BAR_WORDS 3456
#define XB_SPIN_CAP (1u << 22)
#define LAS __attribute__((address_space(3)))
#define GAS __attribute__((address_space(1)))
DI unsigned xb_ld(unsigned* p) { return __hip_atomic_load(p, __ATOMIC_RELAXED, __HIP_MEMORY_SCOPE_AGENT); }
DI unsigned xb_add(unsigned* p, unsigned v) { return __hip_atomic_fetch_add(p, v, __ATOMIC_RELAXED, __HIP_MEMORY_SCOPE_AGENT); }
DI unsigned xb_xcc_id() { return (unsigned)__builtin_amdgcn_s_getreg((3 << 11) | 20) & 0xFu; }
#define XB_SPIN(cond, bar) do { unsigned _sp = 0; while (cond) { __builtin_amdgcn_s_sleep(1); \
    if ((++_sp & 255u) == 0u) { if (xb_ld(&(bar)[XB_TMO])) break; if (_sp > XB_SPIN_CAP) { atomicAdd(&(bar)[XB_TMO], 1u); break; } } } } while (0)
struct XcdBarrier { unsigned* bar; unsigned x; volatile LAS unsigned* st; };
DI XcdBarrier xcd_barrier_post(unsigned* bar, volatile LAS unsigned* st) {
  XcdBarrier b; b.bar = bar; b.x = xb_xcc_id(); b.st = st;
  if (threadIdx.x == 0) (void)xb_add(&bar[XB_XCNT(b.x)], 1u);
  return b;
}
DI void xcd_barrier_complete(unsigned* bar, unsigned x, unsigned& nloc, unsigned& nx) {
  const unsigned G = gridDim.x * gridDim.y * gridDim.z;
  unsigned sum, cnt, mine, sp = 0u;
  for (;;) {
    sum = 0u; cnt = 0u; mine = 0u;
#pragma unroll
    for (unsigned j = 0; j < 16; ++j) { const unsigned c = xb_ld(&bar[XB_XCNT(j)]); sum += c; cnt += (c > 0u) ? 1u : 0u; mine = (j == x) ? c : mine; }
    if (sum == G) break;
    __builtin_amdgcn_s_sleep(1);
    if ((++sp & 255u) == 0u) { if (xb_ld(&bar[XB_TMO])) break; if (sp > XB_SPIN_CAP) { atomicAdd(&bar[XB_TMO], 1u); break; } }
  }
  nloc = mine > 0u ? mine : 1u; nx = cnt > 0u ? cnt : 1u;
}
DI void xcd_barrier(const XcdBarrier& b) {
  asm volatile("s_waitcnt vmcnt(0)" ::: "memory");
  __syncthreads();
  if (threadIdx.x == 0) {
    unsigned* bar = b.bar;
    __builtin_amdgcn_s_waitcnt(0);
    unsigned nloc = b.st[0], nx = b.st[1];
    if (nloc == 0u) { xcd_barrier_complete(bar, b.x, nloc, nx); b.st[0] = nloc; b.st[1] = nx; }
    const unsigned old = xb_add(&bar[XB_XSUB(b.x)], 1u);
    const unsigned gen = old / nloc;
    if (old + 1u == (gen + 1u) * nloc) {
      __builtin_amdgcn_fence(__ATOMIC_RELEASE, "agent");
      asm volatile("s_waitcnt vmcnt(0)" ::: "memory");
      const unsigned og = xb_add(&bar[XB_TOP], 1u);
      const unsigned tg = og / nx;
      if (og + 1u == (tg + 1u) * nx) xb_add(&bar[XB_TOPGEN], 1u);
      else XB_SPIN(xb_ld(&bar[XB_TOPGEN]) == tg, bar);
      __builtin_amdgcn_fence(__ATOMIC_ACQUIRE, "agent");
      xb_add(&bar[XB_XGEN(b.x)], 1u);
      asm volatile("s_waitcnt vmcnt(0)" ::: "memory");
    } else {
      XB_SPIN(xb_ld(&bar[XB_XGEN(b.x)]) == gen, bar);
      __builtin_amdgcn_fence(__ATOMIC_ACQUIRE, "agent");
      asm volatile("s_waitcnt vmcnt(0)" ::: "memory");
    }
  }
  __syncthreads();
}

struct GemmAcc { f32x4 a[4][4]; };

struct GStage { u32x4 a0, a1; f32x4 b0, b1; };
DI void g_load(GStage& S, const bf16_t* ap0, const bf16_t* ap1, const float* bp, int ldb, int t, int nt) {
  if (t < nt) {
    S.a0 = *(const u32x4*)(ap0 + t * 32);
    S.a1 = *(const u32x4*)(ap1 + t * 32);
    const float* bn = bp + (size_t)t * 32 * ldb;
    S.b0 = *(const f32x4*)(bn);
    S.b1 = *(const f32x4*)(bn + ldb);
  }
}
DI int swz4(int row) { return (0x78 >> (((row >> 2) & 3) * 2)) & 3; }
DI void g_write(const GStage& S, char* st, int tid, int kq, int ng) {
  {
    const int row = tid >> 2, ch = (tid & 3) ^ swz4(row);
    *(u32x4*)(st + row * 64 + ch * 16) = S.a0;
    *(u32x4*)(st + 8192 + row * 64 + ch * 16) = S.a1;
  }
  const int pc = ((kq >> 2) ^ swz4(4 * ng)) * 4 + (kq & 3);
  unsigned* dst = (unsigned*)(st + 16384) + (4 * ng) * 16 + pc;
  dst[0] = pack2(S.b0[0], S.b1[0]);
  dst[16] = pack2(S.b0[1], S.b1[1]);
  dst[32] = pack2(S.b0[2], S.b1[2]);
  dst[48] = pack2(S.b0[3], S.b1[3]);
}
DI void g_compute(GemmAcc& acc, const char* st, int wr, int wc, int fr, int fq) {
  bf16x8 At[4], Bt[4];
  const int pch = (fq ^ swz4(fr)) * 16;
#pragma unroll
  for (int m = 0; m < 4; ++m) At[m] = *(const bf16x8*)(st + (wr * 64 + m * 16 + fr) * 64 + pch);
#pragma unroll
  for (int n = 0; n < 4; ++n) Bt[n] = *(const bf16x8*)(st + 16384 + (wc * 64 + n * 16 + fr) * 64 + pch);
#pragma unroll
  for (int m = 0; m < 4; ++m)
#pragma unroll
    for (int n = 0; n < 4; ++n) acc.a[m][n] = __builtin_amdgcn_mfma_f32_16x16x32_bf16(At[m], Bt[n], acc.a[m][n], 0, 0, 0);
}
template <class ARow, class BCol, class Epi>
DI void gemm_tile(char* smem, const ARow& arow, const BCol& bcol, int ldb, int K, const Epi& epi) {
  const int tid = fresh_tid(), wid = tid >> 6, lane = tid & 63, wr = wid >> 1, wc = wid & 1, fr = lane & 15, fq = lane >> 4;
  const int ar0 = tid >> 2, ac0 = (tid & 3) * 8;
  const bf16_t* ap0 = arow(ar0) + ac0;
  const bf16_t* ap1 = arow(ar0 + 128) + ac0;
  const int kq = tid & 15, ng = tid >> 4;
  const float* bp = bcol(ng) + (size_t)(2 * kq) * ldb;
  GemmAcc acc;
#pragma unroll
  for (int m = 0; m < 4; ++m)
#pragma unroll
    for (int n = 0; n < 4; ++n) acc.a[m][n] = (f32x4){0.f, 0.f, 0.f, 0.f};
  const int nt = K / 32;
  char* st0 = smem;
  char* st1 = smem + 24576;
  GStage S0, S1, S2;
  g_load(S0, ap0, ap1, bp, ldb, 0, nt);
  g_load(S1, ap0, ap1, bp, ldb, 1, nt);
  g_load(S2, ap0, ap1, bp, ldb, 2, nt);
  g_write(S0, st0, tid, kq, ng);
  g_load(S0, ap0, ap1, bp, ldb, 3, nt);
  __syncthreads();
  for (int t = 0; t < nt; t += 3) {
    {
      char* cur = (t & 1) ? st1 : st0; char* nxt = (t & 1) ? st0 : st1;
      g_compute(acc, cur, wr, wc, fr, fq);
      if (t + 1 < nt) g_write(S1, nxt, tid, kq, ng);
      g_load(S1, ap0, ap1, bp, ldb, t + 4, nt);
      __syncthreads();
    }
    if (t + 1 < nt) {
      char* cur = ((t + 1) & 1) ? st1 : st0; char* nxt = ((t + 1) & 1) ? st0 : st1;
      g_compute(acc, cur, wr, wc, fr, fq);
      if (t + 2 < nt) g_write(S2, nxt, tid, kq, ng);
      g_load(S2, ap0, ap1, bp, ldb, t + 5, nt);
      __syncthreads();
    }
    if (t + 2 < nt) {
      char* cur = ((t + 2) & 1) ? st1 : st0; char* nxt = ((t + 2) & 1) ? st0 : st1;
      g_compute(acc, cur, wr, wc, fr, fq);
      if (t + 3 < nt) g_write(S0, nxt, tid, kq, ng);
      g_load(S0, ap0, ap1, bp, ldb, t + 6, nt);
      __syncthreads();
    }
  }
  epi(acc, wr, wc, fr, fq);
}


template <int NC, class Val, class RowPtr>
DI void epi_bf16_lds(char* smem, int wr, int wc, int fr, int fq, const Val& val, const RowPtr& rowptr) {
  constexpr int LDC = NC + 8;
  bf16_t* T = (bf16_t*)smem;
#pragma unroll
  for (int m = 0; m < 4; ++m)
#pragma unroll
    for (int n = 0; n < NC / 32; ++n)
#pragma unroll
      for (int j = 0; j < 4; ++j) T[(wr * 64 + m * 16 + fq * 4 + j) * LDC + wc * (NC / 2) + n * 16 + fr] = f2bf(val(m, n, j));
  __syncthreads();
  constexpr int CPR = NC / 8;
  constexpr int RPI = NTHR / CPR;
  const int tid = fresh_tid(), ch = tid % CPR, r0 = tid / CPR;
#pragma unroll 4
  for (int it = 0; it < 256 / RPI; ++it) {
    const int r = it * RPI + r0;
    bf16_t* dst = rowptr(r);
    if (dst) *(u32x4*)(dst + ch * 8) = *(const u32x4*)(T + r * LDC + ch * 8);
  }
  __syncthreads();
}


struct Acc256 { f32x4 a[8][4]; };
struct GStage2 { u32x4 a0, a1; f32x4 b00, b01, b10, b11; };
template <class BP>
DI void g2_load(GStage2& S, const bf16_t* ap0, const bf16_t* ap1, const BP& bp0, const BP& bp1, int ldb, int t, int nt) {
  if (t < nt) {
    S.a0 = *(const u32x4*)(ap0 + t * 32);
    S.a1 = *(const u32x4*)(ap1 + t * 32);
    const size_t o = (size_t)t * 32 * ldb;
    S.b00 = *(const f32x4*)(bp0 + o);
    S.b01 = *(const f32x4*)(bp0 + o + ldb);
    S.b10 = *(const f32x4*)(bp1 + o);
    S.b11 = *(const f32x4*)(bp1 + o + ldb);
  }
}
DI void g2_write(const GStage2& S, char* st, int tid, int kq, int ng) {
  {
    const int row = tid >> 2, ch = (tid & 3) ^ swz4(row);
    *(u32x4*)(st + row * 64 + ch * 16) = S.a0;
    *(u32x4*)(st + 8192 + row * 64 + ch * 16) = S.a1;
  }
  const int pc = ((kq >> 2) ^ swz4(4 * ng)) * 4 + (kq & 3);
  unsigned* dst = (unsigned*)(st + 16384) + (4 * ng) * 16 + pc;
  dst[0] = pack2(S.b00[0], S.b01[0]);
  dst[16] = pack2(S.b00[1], S.b01[1]);
  dst[32] = pack2(S.b00[2], S.b01[2]);
  dst[48] = pack2(S.b00[3], S.b01[3]);
  dst[2048 + 0] = pack2(S.b10[0], S.b11[0]);
  dst[2048 + 16] = pack2(S.b10[1], S.b11[1]);
  dst[2048 + 32] = pack2(S.b10[2], S.b11[2]);
  dst[2048 + 48] = pack2(S.b10[3], S.b11[3]);
}
DI void g2_compute(Acc256& acc, const char* st, int wr, int wc, int fr, int fq) {
  bf16x8 Bt[4];
  const int pch = (fq ^ swz4(fr)) * 16;
#pragma unroll
  for (int n = 0; n < 4; ++n) Bt[n] = *(const bf16x8*)(st + 16384 + (wc * 64 + n * 16 + fr) * 64 + pch);
#pragma unroll
  for (int m = 0; m < 8; ++m) {
    const bf16x8 At = *(const bf16x8*)(st + (wr * 128 + m * 16 + fr) * 64 + pch);
#pragma unroll
    for (int n = 0; n < 4; ++n) acc.a[m][n] = __builtin_amdgcn_mfma_f32_16x16x32_bf16(At, Bt[n], acc.a[m][n], 0, 0, 0);
  }
}
template <class ARow, class BCol, class Epi>
DI void gemm256(char* smem, const ARow& arow, const BCol& bcol, int ldb, int K, const Epi& epi) {
  const int tid = fresh_tid(), wid = tid >> 6, lane = tid & 63, wr = wid >> 2, wc = wid & 3, fr = lane & 15, fq = lane >> 4;
  const int ar0 = tid >> 2, ac0 = (tid & 3) * 8;
  const bf16_t* ap0 = arow(ar0) + ac0;
  const bf16_t* ap1 = arow(ar0 + 128) + ac0;
  const int kq = tid & 15, ng = tid >> 4;
  const float* bp0 = bcol(ng) + (size_t)(2 * kq) * ldb;
  const float* bp1 = bcol(ng + 32) + (size_t)(2 * kq) * ldb;
  Acc256 acc;
#pragma unroll
  for (int m = 0; m < 8; ++m)
#pragma unroll
    for (int n = 0; n < 4; ++n) acc.a[m][n] = (f32x4){0.f, 0.f, 0.f, 0.f};
  const int nt = K / 32;
  char* st0 = smem;
  char* st1 = smem + 32768;
  GStage2 S0, S1;
  g2_load(S0, ap0, ap1, bp0, bp1, ldb, 0, nt);
  g2_load(S1, ap0, ap1, bp0, bp1, ldb, 1, nt);
  g2_write(S0, st0, tid, kq, ng);
  g2_load(S0, ap0, ap1, bp0, bp1, ldb, 2, nt);
  __syncthreads();
  for (int t = 0; t < nt; t += 2) {
    g2_compute(acc, st0, wr, wc, fr, fq);
    g2_write(S1, st1, tid, kq, ng);
    g2_load(S1, ap0, ap1, bp0, bp1, ldb, t + 3, nt);
    __syncthreads();
    g2_compute(acc, st1, wr, wc, fr, fq);
    if (t + 2 < nt) g2_write(S0, st0, tid, kq, ng);
    g2_load(S0, ap0, ap1, bp0, bp1, ldb, t + 4, nt);
    __syncthreads();
  }
  epi(acc, wr, wc, fr, fq);
}
template <int NC, class Val, class RowPtr>
DI void epi256_bf16(char* smem, int wr, int wc, int fr, int fq, const Val& val, const RowPtr& rowptr, int ncv = 1 << 30) {
  constexpr int LDC = NC + 8;
  bf16_t* T = (bf16_t*)smem;
#pragma unroll
  for (int m = 0; m < 8; ++m)
#pragma unroll
    for (int n = 0; n < NC / 64; ++n)
#pragma unroll
      for (int j = 0; j < 4; ++j) T[(wr * 128 + m * 16 + fq * 4 + j) * LDC + wc * (NC / 4) + n * 16 + fr] = f2bf(val(m, n, j));
  __syncthreads();
  constexpr int CPR = NC / 8, RPI = NTHR / CPR;
  const int tid = fresh_tid(), ch = tid % CPR, r0 = tid / CPR;
#pragma unroll 4
  for (int it = 0; it < 256 / RPI; ++it) {
    const int r = it * RPI + r0;
    bf16_t* dst = rowptr(r);
    if (dst && ch * 8 < ncv) *(u32x4*)(dst + ch * 8) = *(const u32x4*)(T + r * LDC + ch * 8);
  }
  __syncthreads();
}


namespace g8 {
constexpr int BK = 64, HALF = 128, HTB = HALF * BK * 2;
DI int lds_byte(int r, int c) { const int st = (r >> 4) * 2 + (c >> 5), rr = r & 15, cc = c & 31, ob = rr * 64 + cc * 2; return st * 1024 + (ob ^ (((ob >> 9) & 1) << 5)); }
DI void stage_rc(int b, int& R, int& C) { const int st = b / 1024, sb = b % 1024, swz = sb ^ (((sb >> 9) & 1) << 5); R = (st >> 1) * 16 + swz / 64; C = (st & 1) * 32 + (swz % 64) / 2; }
typedef f32x4 Acc[2][2][4][2];
template <class Unit, class Sched, class Epi>
DI void gemm(LAS unsigned char* lds, const Sched& S, const Epi& E, int K) {
  asm volatile("" : "+s"(K));
  const int tid = fresh_tid(), wid = __builtin_amdgcn_readfirstlane(tid >> 6), lane = tid & 63, wr = wid >> 2, wc = wid & 3, fr = lane & 15, fq = lane >> 4;
  const int nt = K / BK;
  int R[2], C[2];
  unsigned voffB[2];
#pragma unroll
  for (int i = 0; i < 2; ++i) { stage_rc(tid * 16 + i * 8192, R[i], C[i]); voffB[i] = (unsigned)(R[i] * K + C[i]) * 2u; }
  const size_t kstep = (size_t)(BK * 2);
  const size_t hstep = (size_t)HALF * K * 2;
  const unsigned ldsw = (unsigned)wid * 1024u;
  const int aoff = lds_byte(wr * 64 + fr, fq * 8), boff = lds_byte(wc * 32 + fr, fq * 8);
#define G8_SA(b, h) (((b) * 2 + (h)) * HTB)
#define G8_SB(b, h) ((4 + (b) * 2 + (h)) * HTB)
#define G8_STAGEB(bufoff, gbase) do { _Pragma("unroll") for (int _i = 0; _i < 2; ++_i) \
    __builtin_amdgcn_global_load_lds((const unsigned*)((const char*)(gbase) + voffB[_i]), (LAS unsigned*)(lds + (bufoff) + ldsw + _i * 8192), 16, 0, 0); } while (0)
#define G8_STAGEA(bufoff, offs, h, kb) do { _Pragma("unroll") for (int _i = 0; _i < 2; ++_i) \
    __builtin_amdgcn_global_load_lds((const unsigned*)(abase + (size_t)(offs)[h][_i] + (kb)), (LAS unsigned*)(lds + (bufoff) + ldsw + _i * 8192), 16, 0, 0); } while (0)
#define G8_LDA(dst, b, h) do { _Pragma("unroll") for (int m = 0; m < 4; ++m) _Pragma("unroll") for (int k = 0; k < 2; ++k) dst[m][k] = *(const LAS bf16x8*)(lds + G8_SA(b, h) + aoff + m * 2048 + k * 1024); } while (0)
#define G8_LDB(dst, b, h) do { _Pragma("unroll") for (int n = 0; n < 2; ++n) _Pragma("unroll") for (int k = 0; k < 2; ++k) dst[n][k] = *(const LAS bf16x8*)(lds + G8_SB(b, h) + boff + n * 2048 + k * 1024); } while (0)
#define G8_MMA(ai, bj, At, Bt) do { __builtin_amdgcn_s_setprio(1); _Pragma("unroll") for (int m = 0; m < 4; ++m) _Pragma("unroll") for (int n = 0; n < 2; ++n) _Pragma("unroll") for (int k = 0; k < 2; ++k) \
    acc[ai][bj][m][n] = __builtin_amdgcn_mfma_f32_16x16x32_bf16(Bt[n][k], At[m][k], acc[ai][bj][m][n], 0, 0, 0); __builtin_amdgcn_s_setprio(0); } while (0)
#define G8_WAIT_V(n) asm volatile("s_waitcnt vmcnt(" #n ")" ::: "memory")
#define G8_WAIT_L(n) asm volatile("s_waitcnt lgkmcnt(" #n ")" ::: "memory")
#define G8_BAR __builtin_amdgcn_s_barrier()
#define G8_SCHED __builtin_amdgcn_sched_barrier(0)
  Unit cur, nxt; int ui = 0;
  if (!S.next(0, cur)) return;
  const char* abase = S.abase();
  Acc acc;
#pragma unroll
  for (int a = 0; a < 2; ++a)
#pragma unroll
    for (int b = 0; b < 2; ++b)
#pragma unroll
      for (int m = 0; m < 4; ++m)
#pragma unroll
        for (int n = 0; n < 2; ++n) acc[a][b][m][n] = (f32x4){0.f, 0.f, 0.f, 0.f};
  bf16x8 At[4][2], B0[2][2], B1[2][2];
  unsigned co[2][2], no[2][2];
  S.pf(cur, lds, 0);
  S.aoffs(cur, R[0], R[1], C[0], C[1], co);
  const char* cB = S.bbase(cur);
  G8_STAGEB(G8_SB(0, 0), cB); G8_STAGEA(G8_SA(0, 0), co, 0, 0); G8_STAGEB(G8_SB(0, 1), cB + hstep); G8_STAGEA(G8_SA(0, 1), co, 1, 0);
  if (wr == 1) G8_BAR;
  G8_WAIT_V(4); G8_BAR;
  G8_STAGEB(G8_SB(1, 0), cB + kstep); G8_STAGEA(G8_SA(1, 0), co, 0, kstep); G8_STAGEB(G8_SB(1, 1), cB + hstep + kstep);
  G8_WAIT_V(6); G8_BAR;
  for (;;) {
    const bool has_next = S.next(ui + 1, nxt);
    const char* nB = cB;
    if (has_next) { nB = S.bbase(nxt); S.pf(nxt, lds, (ui + 1) % 3); }
    for (int t = 0; t < nt; t += 2) {
      const bool last = (t == nt - 2);
      const size_t k1 = (size_t)(t + 1) * kstep;
      const size_t k2 = last ? 0 : (size_t)(t + 2) * kstep;
      const size_t k3 = k2 + kstep;
      const char* b2 = (last ? nB : cB) + k2;
      const char* b3 = b2 + kstep;
      if (last) {
        if (has_next) S.aoffs_late(nxt, lds, (ui + 1) % 3, R[0], R[1], C[0], C[1], no);
        else {
#pragma unroll
          for (int h = 0; h < 2; ++h)
#pragma unroll
            for (int i = 0; i < 2; ++i) no[h][i] = co[h][i];
        }
      }
      G8_LDB(B0, 0, 0); G8_SCHED; G8_LDA(At, 0, 0); G8_STAGEA(G8_SA(1, 1), co, 1, k1);
      G8_WAIT_L(8); G8_BAR; G8_WAIT_L(0); G8_MMA(0, 0, At, B0); G8_BAR; G8_SCHED;
      G8_LDB(B1, 0, 1); G8_STAGEB(G8_SB(0, 0), b2);
      G8_BAR; G8_WAIT_L(0); G8_MMA(0, 1, At, B1); G8_BAR;
      G8_LDA(At, 0, 1);
      if (last) { G8_STAGEA(G8_SA(0, 0), no, 0, k2); } else { G8_STAGEA(G8_SA(0, 0), co, 0, k2); }
      G8_BAR; G8_WAIT_L(0); G8_MMA(1, 0, At, B0); G8_BAR; G8_SCHED;
      G8_STAGEB(G8_SB(0, 1), b2 + hstep);
      G8_WAIT_V(6); G8_BAR; G8_MMA(1, 1, At, B1); G8_BAR;
      G8_LDB(B0, 1, 0); G8_SCHED; G8_LDA(At, 1, 0);
      if (last) { G8_STAGEA(G8_SA(0, 1), no, 1, k2); } else { G8_STAGEA(G8_SA(0, 1), co, 1, k2); }
      G8_WAIT_L(8); G8_BAR; G8_WAIT_L(0); G8_MMA(0, 0, At, B0); G8_BAR; G8_SCHED;
      G8_LDB(B1, 1, 1); G8_STAGEB(G8_SB(1, 0), b3);
      G8_BAR; G8_WAIT_L(0); G8_MMA(0, 1, At, B1); G8_BAR;
      G8_LDA(At, 1, 1);
      if (last) { G8_STAGEA(G8_SA(1, 0), no, 0, k3); } else { G8_STAGEA(G8_SA(1, 0), co, 0, k3); }
      G8_BAR; G8_WAIT_L(0); G8_MMA(1, 0, At, B0); G8_BAR; G8_SCHED;
      G8_STAGEB(G8_SB(1, 1), b3 + hstep);
      G8_WAIT_V(6); G8_BAR; G8_MMA(1, 1, At, B1); G8_BAR;
    }
    E(acc, cur, wr, wc, fr, fq, ui % 3);
    if (!has_next) break;
#pragma unroll
    for (int a = 0; a < 2; ++a)
#pragma unroll
      for (int b = 0; b < 2; ++b)
#pragma unroll
        for (int m = 0; m < 4; ++m)
#pragma unroll
          for (int n = 0; n < 2; ++n) acc[a][b][m][n] = (f32x4){0.f, 0.f, 0.f, 0.f};
    cur = nxt; cB = nB; ++ui;
#pragma unroll
    for (int h = 0; h < 2; ++h)
#pragma unroll
      for (int i = 0; i < 2; ++i) co[h][i] = no[h][i];
  }
  G8_WAIT_V(0);
  if (wr == 0) G8_BAR;
  G8_BAR;
#undef G8_SA
#undef G8_SB
#undef G8_STAGEA
#undef G8_STAGEB
#undef G8_LDA
#undef G8_LDB
#undef G8_MMA
#undef G8_WAIT_V
#undef G8_WAIT_L
#undef G8_BAR
#undef G8_SCHED
}
struct Unit2 { int pm, pn; };
struct DenseOrder {
  int nM, nN, nwg, G, c;
  DI void init(int nM_, int nN_, int G_, int c_) { nM = nM_; nN = nN_; nwg = nM * nN; G = G_; c = c_; }
  DI bool next(int i, Unit2& u) const {
    const long Lx = (long)i * G + c; if (Lx >= nwg) return false;
    int wgid = (int)Lx; { const int q = nwg / 8, r = nwg % 8, xcd = wgid % 8, off = wgid / 8; wgid = (xcd < r ? xcd * (q + 1) : r * (q + 1) + (xcd - r) * q) + off; }
    const int nig = 8 * nN, gid = wgid / nig, fm = gid * 8, gsz = (nM - fm) < 8 ? (nM - fm) : 8;
    u.pm = fm + ((wgid % nig) % gsz); u.pn = (wgid % nig) / gsz; return true;
  }
};
}

template <class ColPtr>
DI void transpose_tile(char* smem, int ld, bf16_t* dst, int Kdim, int k0, int rho0, const ColPtr& colptr) {
  bf16_t* T = (bf16_t*)smem;
  const int tid = fresh_tid();
  {
    const int kk = tid >> 3, g = tid & 7;
    const int rho = rho0 + g * 8;
    const float* cp = colptr(rho);
    const float* cp2 = colptr(rho + 4);
    f32x4 v0, v1;
    if (cp) { v0 = *(const f32x4*)(cp + (size_t)(k0 + kk) * ld); v1 = *(const f32x4*)(cp2 + (size_t)(k0 + kk) * ld); }
    else { v0 = (f32x4){0.f, 0.f, 0.f, 0.f}; v1 = v0; }
#pragma unroll
    for (int j = 0; j < 4; ++j) { T[(g * 8 + j) * 72 + kk] = f2bf(v0[j]); T[(g * 8 + 4 + j) * 72 + kk] = f2bf(v1[j]); }
  }
  __syncthreads();
  {
    const int r = tid >> 3, ch = tid & 7;
    *(u32x4*)(dst + (size_t)(rho0 + r) * Kdim + k0 + ch * 8) = *(const u32x4*)(T + r * 72 + ch * 8);
  }
  __syncthreads();
}

DI int swiglu_col(int rho, int& z);
struct PrepTile { const float* src[4]; const float* src2[4]; bf16_t* dst; int ld, Kdim, perm; };
DI int w2_row(int c) { const int wc = c >> 6, fq = (c >> 4) & 3, bj = (c >> 3) & 1, n = (c >> 2) & 1, e = c & 3; return 128 * bj + 32 * wc + 16 * n + 4 * fq + e; }
DI int w2_col(int rho) { const int bj = rho >> 7, wc = (rho >> 5) & 3, n = (rho >> 4) & 1, fq = (rho >> 2) & 3, e = rho & 3; return 64 * wc + 16 * fq + 8 * bj + 4 * n + e; }
DI int perm32(int rho) { const int n = rho >> 4, i = rho & 15; return 8 * (i >> 2) + 4 * n + (i & 3); }
DI void prep_tile_desc(const Params& P, int u, int g, int kk, PrepTile& t) {
  constexpr int PER_E = 32 + 16;
  const int e = u / PER_E, v = u % PER_E;
  if (e < 256 && v < 32) {
    const int pn = v >> 4, kt = v & 15;
    const float* W1 = P.exp_w1 + (size_t)e * D * DE;
    const float* W3 = P.exp_w3 + (size_t)e * D * DE;
    t.ld = DE; t.Kdim = D; t.perm = 0;
    t.dst = P.w13T + ((size_t)e * 512 + pn * 256) * D + kt * 64;
#pragma unroll
    for (int sb = 0; sb < 4; ++sb) {
      int z; const int col = swiglu_col(pn * 256 + sb * 64 + g * 8, z);
      t.src[sb] = (z ? W3 : W1) + col + (size_t)(kt * 64 + kk) * DE;
      t.src2[sb] = t.src[sb] + 4;
    }
  } else {
    const int w = (e < 256) ? v - 32 : v;
    const int pn = w >> 2, kt = w & 3;
    const float* W2 = (e < 256) ? P.exp_w2 + (size_t)e * DE * D : P.sh_w2;
    t.ld = D; t.Kdim = DE;
    t.dst = P.w2T + ((size_t)e * D + pn * 256) * DE + kt * 64;
    t.perm = 1;
#pragma unroll
    for (int sb = 0; sb < 4; ++sb) {
      t.src[sb] = W2 + pn * 256 + sb * 64 + g * 8 + (size_t)(kt * 64 + kk) * D;
      t.src2[sb] = t.src[sb] + 4;
    }
  }
}
constexpr int PREP_TOTAL = 256 * 48 + 16;
constexpr int NPREPB = 60;
constexpr int PREP_Q0 = NPREPB * 8;
constexpr int TASK_Q0 = (256 - 16 - NPREPB) * 2;
DI void prep_experts(const Params& P, char* smem, int worker, int nworkers, int u_begin, int total) {
  bf16_t* T = (bf16_t*)smem;
  const int tid = fresh_tid();
  const int kk = tid >> 3, g = tid & 7;
  f32x4 v[4][2];
  PrepTile cur;
  int u = u_begin + worker;
  if (u < total) {
    prep_tile_desc(P, u, g, kk, cur);
#pragma unroll
    for (int sb = 0; sb < 4; ++sb) { v[sb][0] = __builtin_nontemporal_load((const f32x4*)cur.src[sb]); v[sb][1] = __builtin_nontemporal_load((const f32x4*)cur.src2[sb]); }
  }
  for (; u < total; u += nworkers) {
#pragma unroll
    for (int sb = 0; sb < 4; ++sb)
#pragma unroll
      for (int j = 0; j < 4; ++j) {
        const int c0 = sb * 64 + g * 8 + j, c1 = c0 + 4;
        T[(cur.perm ? w2_row(c0) : c0) * 66 + kk] = f2bf(v[sb][0][j]);
        T[(cur.perm ? w2_row(c1) : c1) * 66 + kk] = f2bf(v[sb][1][j]);
      }
    bf16_t* dst = cur.dst; const int Kdim = cur.Kdim;
    if (u + nworkers < total) {
      prep_tile_desc(P, u + nworkers, g, kk, cur);
#pragma unroll
      for (int sb = 0; sb < 4; ++sb) { v[sb][0] = __builtin_nontemporal_load((const f32x4*)cur.src[sb]); v[sb][1] = __builtin_nontemporal_load((const f32x4*)cur.src2[sb]); }
    }
    __syncthreads();
#pragma unroll
    for (int it = 0; it < 4; ++it) {
      const int r = it * 64 + (tid >> 3), ch = tid & 7;
      const unsigned* tp = (const unsigned*)(T + r * 66 + ch * 8);
      u32x4 o; o[0] = tp[0]; o[1] = tp[1]; o[2] = tp[2]; o[3] = tp[3];
      __builtin_nontemporal_store(o, (u32x4*)(dst + (size_t)r * Kdim + ch * 8));
    }
    __syncthreads();
  }
}

DI int swiglu_col(int rho, int& z) { const int kap = rho & 255, pn = rho >> 8; z = (kap >> 4) & 1; return pn * 128 + (kap >> 5) * 16 + (kap & 15); }

constexpr int LD = 72;
constexpr int SLOT = 64 * LD * 2;
DI f32x16 mfma32(bf16x8 a, bf16x8 b, f32x16 c) { return __builtin_amdgcn_mfma_f32_32x32x16_bf16(a, b, c, 0, 0, 0); }
DI f32x16 zero16() {
  f32x16 z;
#pragma unroll
  for (int i = 0; i < 16; ++i) z[i] = 0.f;
  return z;
}
DI bf16x8 frag_c(const bf16_t* M, int row, int k, int ld = LD) { return *(const bf16x8*)(M + row * ld + k); }
DI bf16x8 frag_s(const bf16_t* M, int k, int col, int ld = LD) {
  bf16x8 v;
#pragma unroll
  for (int j = 0; j < 8; ++j) v[j] = (short)M[(k + j) * ld + col];
  return v;
}
DI int crow(int reg, int half) { return (reg & 3) + 8 * (reg >> 2) + 4 * half; }
template <bool AC, bool BC>
DI f32x16 mm_tile(const bf16_t* A, const bf16_t* B, int ti, int tj, int lane, f32x16 acc) {
  const int r = lane & 31, h = lane >> 5;
#pragma unroll
  for (int ks = 0; ks < 4; ++ks) {
    const int k = ks * 16 + 8 * h;
    bf16x8 a = AC ? frag_c(A, ti * 32 + r, k) : frag_s(A, k, ti * 32 + r);
    bf16x8 b = BC ? frag_c(B, tj * 32 + r, k) : frag_s(B, k, tj * 32 + r);
    acc = mfma32(a, b, acc);
    __builtin_amdgcn_sched_barrier(0);
  }
  return acc;
}
DI void store_rm_bf16(bf16_t* M, const f32x16& acc, int ti, int tj, int lane) {
  const int c = tj * 32 + (lane & 31), h = lane >> 5;
#pragma unroll
  for (int g = 0; g < 16; ++g) M[(ti * 32 + crow(g, h)) * LD + c] = f2bf(acc[g]);
}
DI void store_tr_bf16(bf16_t* Mt, const f32x16& acc, int ti, int tj, int lane, int ld = LD) {
  const int c = tj * 32 + (lane & 31), h = lane >> 5;
#pragma unroll
  for (int g = 0; g < 4; ++g) {
    u32x2 v;
    v[0] = pack2(acc[4 * g], acc[4 * g + 1]);
    v[1] = pack2(acc[4 * g + 2], acc[4 * g + 3]);
    *(u32x2*)(Mt + c * ld + ti * 32 + 8 * g + 4 * h) = v;
  }
}

DI void phase0(const Params& P, char* smem) {
  const int tid = fresh_tid();
  if (blockIdx.x == 0 && tid < 272) P.cnt[tid] = 0;
  if (blockIdx.x == 1 && tid < 256) P.ones[tid] = 1.f;
  for (int i = blockIdx.x * NTHR + tid; i < L; i += gridDim.x * NTHR) P.ident[i] = i * NSLOT + 8;
  float* red = (float*)smem;
  for (int cb = blockIdx.x; cb < 6144 / 24; cb += gridDim.x) {
    const int n0 = cb * 24;
    if (tid < 504) {
      const int col = tid % 24, ks = tid / 24;
      const int k0 = ks * 49, k1 = (k0 + 49 < 1024) ? k0 + 49 : 1024;
      float s0 = 0.f, s1 = 0.f;
      for (int k = k0; k < k1; ++k) {
        const float w = P.ada_w[(size_t)k * 6144 + n0 + col];
        s0 += siluf(P.c[k]) * w;
        s1 += siluf(P.c_ctx[k]) * w;
      }
      red[(ks * 24 + col) * 2] = s0;
      red[(ks * 24 + col) * 2 + 1] = s1;
    }
    __syncthreads();
    if (tid < 48) {
      const int col = tid >> 1, z = tid & 1;
      float s = 0.f;
      for (int ks = 0; ks < 21; ++ks) s += red[(ks * 24 + col) * 2 + z];
      s += P.ada_b[n0 + col];
      (z ? P.modc : P.mod)[n0 + col] = s;
    }
    __syncthreads();
  }
}

DI void norm_mod_row(const float* src, const float* g, const float* shift, const float* scale, bf16_t* dst, int lane) {
  f32x4 v[4];
  float ss = 0.f;
#pragma unroll
  for (int i = 0; i < 4; ++i) {
    v[i] = *(const f32x4*)(src + i * 256 + lane * 4);
    ss += v[i][0] * v[i][0] + v[i][1] * v[i][1] + v[i][2] * v[i][2] + v[i][3] * v[i][3];
  }
  ss = wave_sum(ss);
  const float rs = __builtin_amdgcn_rsqf(ss * (1.f / 1024.f) + 1e-6f);
#pragma unroll
  for (int i = 0; i < 4; ++i) {
    const int c = i * 256 + lane * 4;
    const f32x4 gg = *(const f32x4*)(g + c), sh = *(const f32x4*)(shift + c), sc = *(const f32x4*)(scale + c);
    float o[4];
#pragma unroll
    for (int j = 0; j < 4; ++j) o[j] = v[i][j] * rs * gg[j] * (1.f + sc[j]) + sh[j];
    u32x2 w;
    w[0] = pack2(o[0], o[1]);
    w[1] = pack2(o[2], o[3]);
    *(u32x2*)(dst + c) = w;
  }
}
DI void phase1(const Params& P) {
  const int tid_ = fresh_tid();
  const int wid = tid_ >> 6, lane = tid_ & 63;
  for (int row = blockIdx.x * 8 + wid; row < LT; row += gridDim.x * 8) {
    if (row < L) norm_mod_row(P.x + (size_t)row * D, P.norm1_g, P.mod, P.mod + 1024, P.hx + (size_t)row * D, lane);
    else norm_mod_row(P.ctx + (size_t)(row - L) * D, P.norm1_g, P.modc, P.modc + 1024, P.hx + (size_t)row * D, lane);
  }
}
DI void phase7(const Params& P) {
  const int tid_ = fresh_tid();
  const int wid = tid_ >> 6, lane = tid_ & 63;
  for (int row = blockIdx.x * 8 + wid; row < L; row += gridDim.x * 8)
    norm_mod_row(P.x1 + (size_t)row * D, P.norm2_g, P.mod + 3072, P.mod + 4096, P.h2 + (size_t)row * D, lane);
}


DI void prep_dense(const Params& P, char* smem) {
  constexpr int T_WIN = (PIN / 64) * 16, T_WOUT = 16 * 16, T_RS = 12 * 16, T_G = 16;
  for (int u = blockIdx.x; u < T_WIN + T_WOUT + T_RS + T_G; u += gridDim.x) {
    if (u < T_WIN) {
      const int rt = u >> 4, kt = u & 15;
      transpose_tile(smem, PINW, P.winT, D, kt * 64, rt * 64, [&](int rho) -> const float* { return rho < PINW ? P.w_in + (rho & ~31) + perm32(rho & 31) : nullptr; });
    } else if (u < T_WIN + T_WOUT) {
      const int v = u - T_WIN, rt = v >> 4, kt = v & 15;
      transpose_tile(smem, D, P.woutT, D, kt * 64, rt * 64, [&](int rho) -> const float* { return P.w_out + rho; });
    } else if (u >= T_WIN + T_WOUT + T_RS) {
      const int v = u - T_WIN - T_WOUT - T_RS, rt = v >> 1, kt = v & 1;
      transpose_tile(smem, 512, P.gateT, 128, kt * 64, rt * 64, [&](int rho) -> const float* { return P.gate_up + rho; });
    } else {
      const int v = u - T_WIN - T_WOUT, rt = v >> 4, kt = v & 15;
      transpose_tile(smem, 256, P.rsT, D, kt * 64, rt * 64, [&](int rho) -> const float* {
        if (rho < 256) return P.router_w + rho;
        int z; const int col = swiglu_col(rho - 256, z);
        return (z ? P.sh_w3 : P.sh_w1) + col;
      });
    }
  }
}

struct SchedP2 : g8::DenseOrder {
  static constexpr int PF_LINES = 0;
  DI void pf(const g8::Unit2&, LAS unsigned char*, int) const {}
  DI void aoffs_late(const g8::Unit2& u, LAS unsigned char*, int, int R0, int R1, int C0, int C1, unsigned (&o)[2][2]) const { aoffs(u, R0, R1, C0, C1, o); }
  const Params* P;
  DI const char* abase() const { return (const char*)P->hx; }
  DI const char* bbase(const g8::Unit2& u) const { return (const char*)(P->winT + (size_t)u.pn * 256 * D); }
  DI void aoffs(const g8::Unit2& u, int R0, int R1, int C0, int C1, unsigned (&o)[2][2]) const {
#pragma unroll
    for (int h = 0; h < 2; ++h) {
      o[h][0] = (unsigned)(((u.pm * 256 + h * 128 + R0) * D + C0) * 2);
      o[h][1] = (unsigned)(((u.pm * 256 + h * 128 + R1) * D + C1) * 2);
    }
  }
};
DI void phase2(const Params& P, char* smem) {
  SchedP2 S; S.init(LT / 256, PIN / 256, gridDim.x, blockIdx.x); S.P = &P;
  g8::gemm<g8::Unit2>((LAS unsigned char*)smem, S,
      [&](const g8::Acc& acc, const g8::Unit2& u, int wr, int wc, int fr, int fq, int) {
#pragma unroll
        for (int ai = 0; ai < 2; ++ai)
#pragma unroll
          for (int m = 0; m < 4; ++m) {
            bf16_t* rowp = P.p + (size_t)(u.pm * 256 + ai * 128 + wr * 64 + m * 16 + fr) * PIN + u.pn * 256 + wc * 32 + 8 * fq;
#pragma unroll
            for (int bj = 0; bj < 2; ++bj) {
              const f32x4 v0 = acc[ai][bj][m][0], v1 = acc[ai][bj][m][1];
              u32x4 w;
              w[0] = pack2(v0[0], v0[1]); w[1] = pack2(v0[2], v0[3]); w[2] = pack2(v1[0], v1[1]); w[3] = pack2(v1[2], v1[3]);
              *(u32x4*)(rowp + bj * 128) = w;
            }
          }
      }, D);
}

DI void load_shift16(const Params& P, int t, int lo, int hi, int col, float* o) {
  const bf16_t* pc = P.p + (size_t)t * PIN + col;
  u32x4 c0 = *(const u32x4*)pc, c1 = *(const u32x4*)(pc + 8);
  u32x4 p0 = (u32x4){0, 0, 0, 0}, p1 = p0, n0 = p0, n1 = p0;
  if (t - 1 >= lo) { p0 = *(const u32x4*)(pc - PIN); p1 = *(const u32x4*)(pc - PIN + 8); }
  if (t + 1 < hi) { n0 = *(const u32x4*)(pc + PIN); n1 = *(const u32x4*)(pc + PIN + 8); }
  const float* mu0 = P.shift_mu + (col - PRW0);
  const float* mu1 = P.shift_mu + 1920 + (col - PRW0);
#pragma unroll
  for (int i = 0; i < 16; ++i) {
    const unsigned cw = (i < 8) ? c0[(i & 7) >> 1] : c1[(i & 7) >> 1];
    const unsigned pw = (i < 8) ? p0[(i & 7) >> 1] : p1[(i & 7) >> 1];
    const unsigned nw = (i < 8) ? n0[(i & 7) >> 1] : n1[(i & 7) >> 1];
    const float cv = (i & 1) ? __uint_as_float(cw & 0xFFFF0000u) : __uint_as_float(cw << 16);
    const float pv = (i & 1) ? __uint_as_float(pw & 0xFFFF0000u) : __uint_as_float(pw << 16);
    const float nv = (i & 1) ? __uint_as_float(nw & 0xFFFF0000u) : __uint_as_float(nw << 16);
    o[i] = cv + mu0[i] * (pv - cv) + mu1[i] * (nv - cv);
  }
}


DI void st16_bf16(bf16_t* dst, const float* v) {
  u32x4 a, b;
#pragma unroll
  for (int i = 0; i < 4; ++i) { a[i] = pack2(v[2 * i], v[2 * i + 1]); b[i] = pack2(v[8 + 2 * i], v[8 + 2 * i + 1]); }
  *(u32x4*)dst = a;
  *(u32x4*)(dst + 8) = b;
}

struct ShiftRaw { u32x4 c0, c1, p0, p1, n0, n1; };
DI void shift_raw(const Params& P, int t, int lo, int hi, int col, ShiftRaw& R) {
  const bf16_t* pc = P.p + (size_t)t * PIN + col;
  R.c0 = *(const u32x4*)pc; R.c1 = *(const u32x4*)(pc + 8);
  R.p0 = (u32x4){0, 0, 0, 0}; R.p1 = R.p0; R.n0 = R.p0; R.n1 = R.p0;
  if (t - 1 >= lo) { R.p0 = *(const u32x4*)(pc - PIN); R.p1 = *(const u32x4*)(pc - PIN + 8); }
  if (t + 1 < hi) { R.n0 = *(const u32x4*)(pc + PIN); R.n1 = *(const u32x4*)(pc + PIN + 8); }
}
DI void shift_finish(const Params& P, const ShiftRaw& R, int col, float* o) {
  const float* mu0 = P.shift_mu + (col - PRW0);
  const float* mu1 = P.shift_mu + 1920 + (col - PRW0);
#pragma unroll
  for (int i = 0; i < 16; ++i) {
    const unsigned cw = (i < 8) ? R.c0[(i & 7) >> 1] : R.c1[(i & 7) >> 1];
    const unsigned pw = (i < 8) ? R.p0[(i & 7) >> 1] : R.p1[(i & 7) >> 1];
    const unsigned nw = (i < 8) ? R.n0[(i & 7) >> 1] : R.n1[(i & 7) >> 1];
    const float cv = (i & 1) ? __uint_as_float(cw & 0xFFFF0000u) : __uint_as_float(cw << 16);
    const float pv = (i & 1) ? __uint_as_float(pw & 0xFFFF0000u) : __uint_as_float(pw << 16);
    const float nv = (i & 1) ? __uint_as_float(nw & 0xFFFF0000u) : __uint_as_float(nw << 16);
    o[i] = cv + mu0[i] * (pv - cv) + mu1[i] * (nv - cv);
  }
}


DI void half_barrier(LAS unsigned* ctr, unsigned& gen, int lt) {
  ++gen;
  asm volatile("s_waitcnt lgkmcnt(0)" ::: "memory");
  if ((lt & 63) == 0) (void)__hip_atomic_fetch_add(ctr, 1u, __ATOMIC_RELAXED, __HIP_MEMORY_SCOPE_WORKGROUP);
  const unsigned want = 4u * gen;
  while (__hip_atomic_load(ctr, __ATOMIC_RELAXED, __HIP_MEMORY_SCOPE_WORKGROUP) < want) __builtin_amdgcn_s_sleep(1);
  asm volatile("" ::: "memory");
}
DI void phase3_task(const Params& P, char* hs, int task, int lt, LAS unsigned* hctr, unsigned& hgen, LAS unsigned* hq) {
#define HALF_BARRIER() half_barrier(hctr, hgen, lt)
  asm volatile("" : "+v"(lt));
  const int lw = lt >> 6, lane = lt & 63;
  const int cc = task >> 4, dir = (task >> 3) & 1, hd = task & 7;
  const int rb = cc * 64;
  const int lo = (rb < L) ? 0 : L, hi = (rb < L) ? L : LT;
  const int sr = lt >> 2, q4 = lt & 3, cseg = q4 * 16;
  const int trow = rb + (dir ? 63 - sr : sr);
  const int ti = lw >> 1, tj = lw & 1;
  bf16_t* slot[8];
#pragma unroll
  for (int i = 0; i < 8; ++i) slot[i] = (bf16_t*)(hs + i * SLOT);
  float* gC = (float*)(hs + 8 * SLOT);
  float* Dout = (float*)(hs + 4 * SLOT);
  float* Aout = (float*)(hs + 6 * SLOT);
  float* Wl = (float*)(hs);

  {
    ShiftRaw rw, ra;
    shift_raw(P, trow, lo, hi, 3072 + 64 * dir + cseg, rw);
    shift_raw(P, trow, lo, hi, 3200 + 64 * dir + cseg, ra);
    const float* du = P.decay_up + ((size_t)(dir * 64 + sr)) * 512 + 64 * hd + cseg;
    const float* iu = P.iclr_up + ((size_t)(dir * 64 + sr)) * 512 + 64 * hd + cseg;
    f32x4 dq[4], iq[4];
#pragma unroll
    for (int i = 0; i < 4; ++i) { dq[i] = *(const f32x4*)(du + 4 * i); iq[i] = *(const f32x4*)(iu + 4 * i); }
    float tmp[16];
    shift_finish(P, rw, 3072 + 64 * dir + cseg, tmp);
#pragma unroll
    for (int i = 0; i < 16; ++i) tmp[i] = tanh_(tmp[i]);
    st16_bf16(slot[0] + sr * LD + cseg, tmp);
    shift_finish(P, ra, 3200 + 64 * dir + cseg, tmp);
    st16_bf16(slot[1] + sr * LD + cseg, tmp);
#pragma unroll
    for (int i = 0; i < 4; ++i) { tmp[4 * i] = dq[i][0]; tmp[4 * i + 1] = dq[i][1]; tmp[4 * i + 2] = dq[i][2]; tmp[4 * i + 3] = dq[i][3]; }
    st16_bf16(slot[2] + sr * LD + cseg, tmp);
#pragma unroll
    for (int i = 0; i < 4; ++i) { tmp[4 * i] = iq[i][0]; tmp[4 * i + 1] = iq[i][1]; tmp[4 * i + 2] = iq[i][2]; tmp[4 * i + 3] = iq[i][3]; }
    st16_bf16(slot[3] + sr * LD + cseg, tmp);
  }
  HALF_BARRIER();
  {
    f32x16 a1 = mm_tile<true, false>(slot[0], slot[2], ti, tj, lane, zero16());
    f32x16 a2 = mm_tile<true, false>(slot[1], slot[3], ti, tj, lane, zero16());
    const int c = tj * 32 + (lane & 31), h = lane >> 5;
#pragma unroll
    for (int g = 0; g < 16; ++g) {
      Dout[(ti * 32 + crow(g, h)) * 65 + c] = a1[g];
      Aout[(ti * 32 + crow(g, h)) * 65 + c] = a2[g];
    }
  }
  HALF_BARRIER();
  float aa[16];
#pragma unroll
  for (int i = 0; i < 16; ++i) {
    const int ch = dir * 512 + 64 * hd + cseg + i;
    const float d = P.decay_w0[ch] + Dout[sr * 65 + cseg + i];
    Wl[sr * 65 + cseg + i] = __expf(-0.6065306597126334f * sigm(d));
    aa[i] = sigm(P.iclr_a0[ch] + Aout[sr * 65 + cseg + i]);
  }
  HALF_BARRIER();
  ShiftRaw rk, rr_;
  shift_raw(P, trow, lo, hi, PRW0 + 512 + 64 * hd + cseg, rk);
  shift_raw(P, trow, lo, hi, PRW0 + 64 * hd + cseg, rr_);
  {
    const int c = lt >> 2, seg = lt & 3;
    float w[16];
#pragma unroll
    for (int i = 0; i < 16; ++i) w[i] = Wl[(seg * 16 + i) * 65 + c];
#pragma unroll
    for (int i = 1; i < 16; ++i) w[i] *= w[i - 1];
    const float tot = w[15];
    const float t0 = __shfl(tot, (lt & 63 & ~3) + 0), t1 = __shfl(tot, (lt & 63 & ~3) + 1), t2 = __shfl(tot, (lt & 63 & ~3) + 2);
    const float pre = (seg == 0) ? 1.f : (seg == 1) ? t0 : (seg == 2) ? t0 * t1 : t0 * t1 * t2;
    HALF_BARRIER();
#pragma unroll
    for (int i = 0; i < 16; ++i) Wl[(seg * 16 + i) * 65 + c] = w[i] * pre;
  }
  HALF_BARRIER();
  {
    float rr[16], kk[16], vv[16];
    shift_finish(P, rk, PRW0 + 512 + 64 * hd + cseg, kk);
    shift_finish(P, rr_, PRW0 + 64 * hd + cseg, rr);
    load_shift16(P, trow, lo, hi, PRW0 + 1024 + 64 * hd + cseg, vv);
    float nrm = 0.f, bsum = 0.f;
#pragma unroll
    for (int i = 0; i < 16; ++i) {
      const float kap = kk[i] * P.key_xi[dir * 512 + 64 * hd + cseg + i];
      nrm += kap * kap;
    }
    nrm += __shfl_xor(nrm, 1);
    nrm += __shfl_xor(nrm, 2);
    const float rn = __builtin_amdgcn_rsqf(nrm + 1e-12f);
    {
      const int o = sr * LD + cseg;
#pragma unroll
      for (int h8 = 0; h8 < 2; ++h8) {
        float xi[8], al[8], rho[8];
#pragma unroll
        for (int i = 0; i < 2; ++i) {
          const f32x4 a = *(const f32x4*)(P.key_xi + dir * 512 + 64 * hd + cseg + 8 * h8 + 4 * i);
          const f32x4 b = *(const f32x4*)(P.key_alpha + dir * 512 + 64 * hd + cseg + 8 * h8 + 4 * i);
          const f32x4 c = *(const f32x4*)(P.bonus_rho + 64 * hd + cseg + 8 * h8 + 4 * i);
#pragma unroll
          for (int j = 0; j < 4; ++j) { xi[4 * i + j] = a[j]; al[4 * i + j] = b[j]; rho[4 * i + j] = c[j]; }
        }
        u32x4 wKp, wBp, wKt, wRp, wV;
#pragma unroll
        for (int p2 = 0; p2 < 4; ++p2) {
          float vKp[2], vBp[2], vKt[2], vRp[2];
#pragma unroll
          for (int e2 = 0; e2 < 2; ++e2) {
            const int i8 = 2 * p2 + e2, i = 8 * h8 + i8;
            const float gsv = Wl[sr * 65 + cseg + i];
            const float gpv = (sr > 0) ? Wl[(sr - 1) * 65 + cseg + i] : 1.f;
            const float kh = kk[i] * xi[i8] * rn;
            const float kt = kk[i] * (1.f + (aa[i] - 1.f) * al[i8]);
            const float bq = aa[i] * kh;
            const float ig = __builtin_amdgcn_rcpf(gsv);
            bsum += rr[i] * rho[i8] * kt;
            vKp[e2] = gpv * kh; vBp[e2] = bq * ig; vKt[e2] = kt * ig; vRp[e2] = gsv * rr[i];
            if (sr == 63) gC[cseg + i] = gsv;
          }
          wKp[p2] = pack2(vKp[0], vKp[1]); wBp[p2] = pack2(vBp[0], vBp[1]); wKt[p2] = pack2(vKt[0], vKt[1]); wRp[p2] = pack2(vRp[0], vRp[1]);
          wV[p2] = pack2(vv[8 * h8 + 2 * p2], vv[8 * h8 + 2 * p2 + 1]);
        }
        *(u32x4*)(slot[2] + o + 8 * h8) = wKp;
        *(u32x4*)(slot[3] + o + 8 * h8) = wBp;
        *(u32x4*)(slot[4] + o + 8 * h8) = wKt;
        *(u32x4*)(slot[5] + o + 8 * h8) = wRp;
        *(u32x4*)(slot[6] + o + 8 * h8) = wV;
      }
    }
    bsum += __shfl_xor(bsum, 1);
    bsum += __shfl_xor(bsum, 2);
    if (q4 == 0 && cc < 256) P.bon[((size_t)dir * L + trow) * 8 + hd] = bsum;
  }
  HALF_BARRIER();
  {
    f32x16 m2 = mm_tile<true, true>(slot[2], slot[3], ti, tj, lane, zero16());
    f32x16 m1 = mm_tile<true, true>(slot[2], slot[4], ti, tj, lane, zero16());
    const int c = tj * 32 + (lane & 31), h = lane >> 5;
#pragma unroll
    for (int g = 0; g < 16; ++g) {
      const int r = ti * 32 + crow(g, h);
      m2[g] = (r > c) ? m2[g] : 0.f;
      m1[g] = (r > c) ? m1[g] : 0.f;
    }
    store_rm_bf16(slot[0], m2, ti, tj, lane);
    store_rm_bf16(slot[7], m1, ti, tj, lane);
  }
  HALF_BARRIER();
  f32x16 x1 = mm_tile<true, false>(slot[7], slot[6], ti, tj, lane, zero16());
  HALF_BARRIER();
  store_tr_bf16(slot[7], x1, ti, tj, lane);
  if (lw == 0) {
    const int hb = lane >> 5, j = lane & 31, o = hb * 32;
    const bf16_t* M2b = slot[0];
    bf16_t* Tb = slot[1];
    float t[32];
#pragma unroll
    for (int s = 0; s < 32; ++s) {
      float a = (s == j) ? 1.f : 0.f;
#pragma unroll
      for (int i = 0; i < s; ++i) a -= bf2f(M2b[(o + s) * LD + o + i]) * t[i];
      t[s] = a;
    }
#pragma unroll
    for (int s = 0; s < 32; ++s) Tb[(o + s) * LD + o + j] = f2bf(t[s]);
    f32x16 xx = zero16();
    {
      const int r = lane & 31, h = lane >> 5;
#pragma unroll
      for (int ks = 0; ks < 2; ++ks) {
        const int k = ks * 16 + 8 * h;
        xx = mfma32(frag_c(M2b, 32 + r, k), frag_s(Tb, k, r), xx);
      }
#pragma unroll
      for (int g = 0; g < 4; ++g) {
        u32x2 v;
        v[0] = pack2(xx[4 * g], xx[4 * g + 1]);
        v[1] = pack2(xx[4 * g + 2], xx[4 * g + 3]);
        *(u32x2*)(Tb + r * LD + 32 + 8 * g + 4 * h) = v;
      }
      f32x16 t21 = zero16();
#pragma unroll
      for (int ks = 0; ks < 2; ++ks) {
        const int k = ks * 16 + 8 * h;
        t21 = mfma32(frag_c(Tb, 32 + r, 32 + k), frag_c(Tb, r, 32 + k), t21);
      }
#pragma unroll
      for (int g = 0; g < 16; ++g) Tb[(32 + crow(g, h)) * LD + r] = f2bf(-t21[g]);
#pragma unroll
      for (int g = 0; g < 16; ++g) Tb[(g + 16 * h) * LD + 32 + r] = 0;
    }
  }
  HALF_BARRIER();
  f32x16 wm = mm_tile<true, false>(slot[1], slot[2], ti, tj, lane, zero16());
  f32x16 uu = mm_tile<true, true>(slot[1], slot[7], ti, tj, lane, zero16());
  HALF_BARRIER();
  {
    store_tr_bf16(slot[2], wm, ti, tj, lane);
    store_tr_bf16(slot[7], uu, ti, tj, lane);
    f32x16 q1 = mm_tile<true, true>(slot[5], slot[4], ti, tj, lane, zero16());
    f32x16 q2 = mm_tile<true, true>(slot[5], slot[3], ti, tj, lane, zero16());
    const int c = tj * 32 + (lane & 31), h = lane >> 5;
#pragma unroll
    for (int g = 0; g < 16; ++g) {
      const int r = ti * 32 + crow(g, h);
      q1[g] = (r >= c) ? q1[g] : 0.f;
      q2[g] = (r >= c) ? q2[g] : 0.f;
    }
    store_rm_bf16(slot[0], q1, ti, tj, lane);
    store_rm_bf16(slot[1], q2, ti, tj, lane);
  }
  HALF_BARRIER();
  {
    unsigned nxt = 0;
    if (lt == 0) nxt = (unsigned)TASK_Q0 + __hip_atomic_fetch_add((GAS unsigned*)P.qh, 1u, __ATOMIC_RELAXED, __HIP_MEMORY_SCOPE_AGENT);
    const int c = tj * 32 + (lane & 31), h = lane >> 5;
    {
      f32x16 gacc = mm_tile<true, false>(slot[2], slot[3], ti, tj, lane, zero16());
      const float gk = gC[c];
      u32x4 w0, w1;
#pragma unroll
      for (int i = 0; i < 4; ++i) {
        const int ga = 2 * i, gb = 2 * i + 1;
        w0[i] = pack2(gk * (((ti * 32 + crow(ga, h) == c) ? 1.f : 0.f) - gacc[ga]), gk * (((ti * 32 + crow(gb, h) == c) ? 1.f : 0.f) - gacc[gb]));
        w1[i] = pack2(gk * (((ti * 32 + crow(8 + ga, h) == c) ? 1.f : 0.f) - gacc[8 + ga]), gk * (((ti * 32 + crow(8 + gb, h) == c) ? 1.f : 0.f) - gacc[8 + gb]));
      }
      const __amdgpu_buffer_rsrc_t gr = __builtin_amdgcn_make_buffer_rsrc((void*)P.gt, 0, NTASK * 8192, 0x00020000);
      const unsigned o = (unsigned)task * 8192u + (unsigned)(((tj * 4 + 2 * ti) * 64 + lane) * 16);
      __builtin_amdgcn_raw_buffer_store_b128(w0, gr, (int)o, 0, 16);
      __builtin_amdgcn_raw_buffer_store_b128(w1, gr, (int)(o + 1024u), 0, 16);
    }
    __builtin_amdgcn_sched_barrier(0);
    {
      f32x16 h1 = mm_tile<false, false>(slot[4], slot[6], ti, tj, lane, zero16());
      f32x16 h2 = mm_tile<false, true>(slot[3], slot[7], ti, tj, lane, zero16());
      const __amdgpu_buffer_rsrc_t hr = __builtin_amdgcn_make_buffer_rsrc((void*)P.ht, 0, NTASK * 16384, 0x00020000);
      const unsigned o = (unsigned)task * 16384u + (unsigned)((((ti * 2 + tj) * 4) * 64 + lane) * 16);
#pragma unroll
      for (int q = 0; q < 4; ++q) {
        f32x4 v;
#pragma unroll
        for (int e = 0; e < 4; ++e) v[e] = gC[ti * 32 + crow(4 * q + e, h)] * (h1[4 * q + e] - h2[4 * q + e]);
        __builtin_amdgcn_raw_buffer_store_b128(__builtin_bit_cast(u32x4, v), hr, (int)(o + 1024u * q), 0, 16);
      }
    }
    __builtin_amdgcn_sched_barrier(0);
    f32x16 acc = mm_tile<true, true>(slot[1], slot[2], ti, tj, lane, zero16());
    bf16_t* rpp = P.rpp + (size_t)task * 4096;
#pragma unroll
    for (int g = 0; g < 16; ++g) {
      const int r = ti * 32 + crow(g, h);
      const int tt = dir ? 63 - r : r;
      rpp[tt * 64 + c] = f2bf(bf2f(slot[5][r * LD + c]) - acc[g]);
    }
    __builtin_amdgcn_sched_barrier(0);
    f32x16 y1 = mm_tile<true, false>(slot[0], slot[6], ti, tj, lane, zero16());
    f32x16 y2 = mm_tile<true, true>(slot[1], slot[7], ti, tj, lane, zero16());
    float* yl = P.yl + (size_t)task * 4096;
#pragma unroll
    for (int g = 0; g < 16; ++g) {
      const int r = ti * 32 + crow(g, h);
      const int tt = dir ? 63 - r : r;
      yl[tt * 64 + c] = y1[g] - y2[g];
    }
    asm volatile("s_waitcnt vmcnt(0)" ::: "memory");
    if (lt == 0) *hq = nxt;
  }
  HALF_BARRIER();
  if (lt == 0) __hip_atomic_store((GAS unsigned*)(P.flags + task), 1u, __ATOMIC_RELAXED, __HIP_MEMORY_SCOPE_AGENT);
}

#undef HALF_BARRIER
constexpr int PB = 8;
DI void prep_dyn(const Params& P, char* smem, int first_base) {
  bf16_t* T = (bf16_t*)smem;
  LAS int* qw = (LAS int*)(smem + 36864);
  GAS unsigned* qp = (GAS unsigned*)(P.qh + 32);
  const int tid = fresh_tid();
  const int kk = tid >> 3, g = tid & 7;
  int base = first_base;
  if (base < 0) {
    if (tid == 0) qw[0] = PREP_Q0 + (int)__hip_atomic_fetch_add(qp, (unsigned)PB, __ATOMIC_RELAXED, __HIP_MEMORY_SCOPE_AGENT);
    __syncthreads();
    base = qw[0];
  }
  base = __builtin_amdgcn_readfirstlane(base);
  if (base >= PREP_TOTAL) return;
  f32x4 v[4][2];
  PrepTile cur;
  prep_tile_desc(P, base, g, kk, cur);
#pragma unroll
  for (int sb = 0; sb < 4; ++sb) { v[sb][0] = __builtin_nontemporal_load((const f32x4*)cur.src[sb]); v[sb][1] = __builtin_nontemporal_load((const f32x4*)cur.src2[sb]); }
  int u = base, bend = base + PB, nbase = PREP_TOTAL;
  unsigned nb_reg = 0;
  for (;;) {
    const bool first = (u == base);
    if (first && tid == 0) nb_reg = __hip_atomic_fetch_add(qp, (unsigned)PB, __ATOMIC_RELAXED, __HIP_MEMORY_SCOPE_AGENT);
#pragma unroll
    for (int sb = 0; sb < 4; ++sb)
#pragma unroll
      for (int j = 0; j < 4; ++j) {
        const int c0 = sb * 64 + g * 8 + j, c1 = c0 + 4;
        T[(cur.perm ? w2_row(c0) : c0) * 66 + kk] = f2bf(v[sb][0][j]);
        T[(cur.perm ? w2_row(c1) : c1) * 66 + kk] = f2bf(v[sb][1][j]);
      }
    bf16_t* dst = cur.dst; const int Kdim = cur.Kdim;
    int un = u + 1;
    if (un >= bend) un = nbase;
    if (un < PREP_TOTAL) {
      prep_tile_desc(P, un, g, kk, cur);
#pragma unroll
      for (int sb = 0; sb < 4; ++sb) { v[sb][0] = __builtin_nontemporal_load((const f32x4*)cur.src[sb]); v[sb][1] = __builtin_nontemporal_load((const f32x4*)cur.src2[sb]); }
    }
    __syncthreads();
#pragma unroll
    for (int it = 0; it < 4; ++it) {
      const int r = it * 64 + (tid >> 3), ch = tid & 7;
      const unsigned* tp = (const unsigned*)(T + r * 66 + ch * 8);
      u32x4 o; o[0] = tp[0]; o[1] = tp[1]; o[2] = tp[2]; o[3] = tp[3];
      __builtin_nontemporal_store(o, (u32x4*)(dst + (size_t)r * Kdim + ch * 8));
    }
    if (first && tid == 0) qw[0] = PREP_Q0 + (int)nb_reg;
    __syncthreads();
    if (first) nbase = __builtin_amdgcn_readfirstlane(qw[0]);
    if (un >= PREP_TOTAL) break;
    if (un >= bend || un < base) { base = un; bend = un + PB; nbase = PREP_TOTAL; }
    u = un;
  }
}

DI int p4_task(int n, int dir, int hd) {
  int cc;
  if (dir == 0) cc = (n < 4) ? 256 + n : n - 4;
  else cc = 259 - n;
  return cc * 16 + dir * 8 + hd;
}
DI void p3_dyn(const Params& P, char* smem, int first_q) {
  const int half = __builtin_amdgcn_readfirstlane(fresh_tid() >> 8);
  char* hs = smem + half * (8 * SLOT + 256);
  LAS unsigned* hctr = (LAS unsigned*)(smem + 2 * (8 * SLOT + 256) + 64 * half);
  LAS unsigned* hq = hctr + 4;
  if ((fresh_tid() & 255) == 0) {
    *hctr = 0u;
    *hq = (first_q >= 0) ? (unsigned)(first_q + half) : (unsigned)TASK_Q0 + __hip_atomic_fetch_add((GAS unsigned*)P.qh, 1u, __ATOMIC_RELAXED, __HIP_MEMORY_SCOPE_AGENT);
  }
  unsigned hgen = 0;
  __syncthreads();
  unsigned cur = __builtin_amdgcn_readfirstlane(*hq);
  while (cur < (unsigned)NTASK) {
    const int n = (int)(cur >> 4), combo = (int)(cur & 15u);
    phase3_task(P, hs, p4_task(n, combo >> 3, combo & 7), fresh_tid() & 255, hctr, hgen, hq);
    cur = __builtin_amdgcn_readfirstlane(*hq);
  }
  __syncthreads();
}

struct P4Buf { bf16x8 g[4]; f32x16 h; };
DI void p4_load(const Params& P, P4Buf& B, int n, int dir, int hd, int ti, int tj, int lane, unsigned& spins) {
  if (n >= NCH) return;
  const int task = p4_task(n, dir, hd);
  {
    const GAS unsigned* f = (const GAS unsigned*)(P.flags + task);
    while (__builtin_amdgcn_readfirstlane(__hip_atomic_load(f, __ATOMIC_RELAXED, __HIP_MEMORY_SCOPE_AGENT)) == 0u) {
      if (++spins > (1u << 21)) break;
      __builtin_amdgcn_s_sleep(2);
    }
    asm volatile("" ::: "memory");
  }
  const __amdgpu_buffer_rsrc_t gr = __builtin_amdgcn_make_buffer_rsrc((void*)P.gt, 0, NTASK * 8192, 0x00020000);
  const __amdgpu_buffer_rsrc_t hr = __builtin_amdgcn_make_buffer_rsrc((void*)P.ht, 0, NTASK * 16384, 0x00020000);
  const unsigned og = (unsigned)task * 8192u + (unsigned)(((ti * 4) * 64 + lane) * 16);
  const unsigned oh = (unsigned)task * 16384u + (unsigned)((((ti * 2 + tj) * 4) * 64 + lane) * 16);
#pragma unroll
  for (int ks = 0; ks < 4; ++ks) B.g[ks] = __builtin_bit_cast(bf16x8, __builtin_amdgcn_raw_buffer_load_b128(gr, (int)(og + 1024u * ks), 0, 16));
#pragma unroll
  for (int q = 0; q < 4; ++q) {
    const f32x4 v = __builtin_bit_cast(f32x4, __builtin_amdgcn_raw_buffer_load_b128(hr, (int)(oh + 1024u * q), 0, 16));
    B.h[4 * q] = v[0]; B.h[4 * q + 1] = v[1]; B.h[4 * q + 2] = v[2]; B.h[4 * q + 3] = v[3];
  }
}
DI void p4_step(const Params& P, const P4Buf& B, bf16_t* Scur, bf16_t* Snext, int n, int dir, int hd, int tid, int ti, int tj, int lane) {
  const int task = p4_task(n, dir, hd);
  const int r = lane & 31, h = lane >> 5;
  {
    const int v = tid >> 2, sg = (tid & 3) * 16;
    u32x4 a = *(const u32x4*)(Scur + v * LD + sg), b = *(const u32x4*)(Scur + v * LD + sg + 8);
    bf16_t* dst = P.s0 + (size_t)task * 4096 + v * 64 + sg;
    *(u32x4*)dst = a;
    *(u32x4*)(dst + 8) = b;
  }
  f32x16 acc = B.h;
#pragma unroll
  for (int ks = 0; ks < 4; ++ks) {
    const bf16_t* sp = Scur + (tj * 32 + r) * LD + 16 * ks + 4 * h;
    const u32x2 lo = *(const u32x2*)sp, hi = *(const u32x2*)(sp + 8);
    u32x4 bb; bb[0] = lo[0]; bb[1] = lo[1]; bb[2] = hi[0]; bb[3] = hi[1];
    acc = mfma32(B.g[ks], __builtin_bit_cast(bf16x8, bb), acc);
  }
  store_tr_bf16(Snext, acc, ti, tj, lane);
}
DI void scan_chains(const Params& P, char* smem) {
  const int tid = fresh_tid();
  const int chain = blockIdx.x, dir = chain >> 3, hd = chain & 7;
  bf16_t* S0b = (bf16_t*)smem;
  bf16_t* S1b = (bf16_t*)(smem + SLOT);
  const int lw = tid >> 6, lane = tid & 63, ti = lw >> 1, tj = lw & 1;
  const bool work = tid < 256;
  unsigned spins = 0;
  if (work) {
    for (int i = tid; i < 64 * LD; i += 256) S0b[i] = 0;
  }
  P4Buf B0, B1, B2, B3;
  if (work) {
    p4_load(P, B0, 0, dir, hd, ti, tj, lane, spins);
    p4_load(P, B1, 1, dir, hd, ti, tj, lane, spins);
    p4_load(P, B2, 2, dir, hd, ti, tj, lane, spins);
    p4_load(P, B3, 3, dir, hd, ti, tj, lane, spins);
  }
  __syncthreads();
  for (int n = 0; n < NCH; n += 4) {
    if (work) { p4_step(P, B0, S0b, S1b, n, dir, hd, tid, ti, tj, lane); p4_load(P, B0, n + 4, dir, hd, ti, tj, lane, spins); }
    __syncthreads();
    if (work) { p4_step(P, B1, S1b, S0b, n + 1, dir, hd, tid, ti, tj, lane); p4_load(P, B1, n + 5, dir, hd, ti, tj, lane, spins); }
    __syncthreads();
    if (work) { p4_step(P, B2, S0b, S1b, n + 2, dir, hd, tid, ti, tj, lane); p4_load(P, B2, n + 6, dir, hd, ti, tj, lane, spins); }
    __syncthreads();
    if (work) { p4_step(P, B3, S1b, S0b, n + 3, dir, hd, tid, ti, tj, lane); p4_load(P, B3, n + 7, dir, hd, ti, tj, lane, spins); }
    __syncthreads();
  }
}

DI void phase34(const Params& P, char* smem) {
  const int b = blockIdx.x;
  if (b < 16) {
    scan_chains(P, smem);
    prep_dyn(P, smem, -1);
  } else if (b < 16 + NPREPB) {
    prep_dyn(P, smem, (b - 16) * PB);
    p3_dyn(P, smem, -1);
  } else {
    p3_dyn(P, smem, (b - 16 - NPREPB) * 2);
    prep_dyn(P, smem, -1);
  }
}

DI void unpack8(const u32x4& w, float* o) {
#pragma unroll
  for (int i = 0; i < 4; ++i) { o[2 * i] = __uint_as_float(w[i] << 16); o[2 * i + 1] = __uint_as_float(w[i] & 0xFFFF0000u); }
}
DI void phase5(const Params& P, char* smem) {
  bf16_t* SG = (bf16_t*)smem;
  bf16_t* VS = (bf16_t*)(smem + 17408);
  float* BON = (float*)(smem + 17408 + 66560);
  constexpr int LG = 136, LV = 520;
  for (int cc = blockIdx.x; cc < 256; cc += gridDim.x) {
    const int tid = fresh_tid();
    const int wid = __builtin_amdgcn_readfirstlane(tid >> 6);
    const int rb = cc * 64;
    {
      const int c = (tid & 63) * 8, t0 = (tid >> 6) * 8;
      float z[10][8];
#pragma unroll
      for (int i = 0; i < 10; ++i) {
        const int t = t0 - 1 + i;
        if (t >= 0 && t < 64) {
          const bf16_t* pr = P.p + (size_t)(rb + t) * PIN + c;
          float cg[8], vv[8];
          unpack8(*(const u32x4*)(pr + 512), cg);
          unpack8(*(const u32x4*)(pr + 1024), vv);
#pragma unroll
          for (int j = 0; j < 8; ++j) z[i][j] = cg[j] * vv[j];
        } else {
#pragma unroll
          for (int j = 0; j < 8; ++j) z[i][j] = 0.f;
        }
      }
      float w0[8], w1[8], w2[8];
#pragma unroll
      for (int j = 0; j < 8; ++j) { w0[j] = P.conv_w[c + j]; w1[j] = P.conv_w[512 + c + j]; w2[j] = P.conv_w[1024 + c + j]; }
#pragma unroll
      for (int i = 0; i < 8; ++i) {
        float bg[8];
        unpack8(*(const u32x4*)(P.p + (size_t)(rb + t0 + i) * PIN + c), bg);
        u32x4 o;
#pragma unroll
        for (int j = 0; j < 4; ++j) {
          const float y0 = bg[2 * j] * (w0[2 * j] * z[i][2 * j] + w1[2 * j] * z[i + 1][2 * j] + w2[2 * j] * z[i + 2][2 * j]);
          const float y1 = bg[2 * j + 1] * (w0[2 * j + 1] * z[i][2 * j + 1] + w1[2 * j + 1] * z[i + 1][2 * j + 1] + w2[2 * j + 1] * z[i + 2][2 * j + 1]);
          o[j] = pack2(y0, y1);
        }
        *(u32x4*)(P.mixin + (size_t)(rb + t0 + i) * D + c) = o;
      }
    }
    {
      float tmp[16];
      const int row = tid >> 3, cs = (tid & 7) * 16;
      ShiftRaw rg, rq[4];
      shift_raw(P, rb + row, 0, L, 3328 + cs, rg);
#pragma unroll
      for (int q = 0; q < 4; ++q) shift_raw(P, rb + row, 0, L, PRW0 + 1024 + (tid & 7) * 64 + q * 16, rq[q]);
      shift_finish(P, rg, 3328 + cs, tmp);
#pragma unroll
      for (int i = 0; i < 16; ++i) tmp[i] = sigm(tmp[i]);
      st16_bf16(SG + row * LG + cs, tmp);
#pragma unroll
      for (int q = 0; q < 4; ++q) {
        const int vc = (tid & 7) * 64 + q * 16;
        shift_finish(P, rq[q], PRW0 + 1024 + vc, tmp);
        st16_bf16(VS + row * LV + vc, tmp);
      }
      const int t = tid >> 3, hd = tid & 7;
      BON[t * 8 + hd] = P.bon[(size_t)(rb + t) * 8 + hd] + P.bon[((size_t)L + rb + t) * 8 + hd];
    }
    __syncthreads();
    const int hd = wid;
#pragma unroll 1
    for (int ti = 0; ti < 2; ++ti) {
      int lane = tid & 63;
      asm volatile("" : "+v"(lane));
      const int r = lane & 31, h = lane >> 5;
      f32x16 y[2], gg[2];
#pragma unroll
      for (int tj = 0; tj < 2; ++tj) {
        f32x16 acc;
        const int c = tj * 32 + r;
        const float* yl0 = P.yl + (size_t)(cc * 16 + hd) * 4096;
        const float* yl1 = P.yl + (size_t)(cc * 16 + 8 + hd) * 4096;
#pragma unroll
        for (int g = 0; g < 16; ++g) {
          const int row = ti * 32 + crow(g, h);
          acc[g] = yl0[row * 64 + c] + yl1[row * 64 + c];
        }
#pragma unroll
        for (int d = 0; d < 2; ++d) {
          const size_t task = (size_t)cc * 16 + d * 8 + hd;
          const bf16_t* rp = P.rpp + task * 4096;
          const bf16_t* s0 = P.s0 + task * 4096;
#pragma unroll
          for (int ks = 0; ks < 4; ++ks) {
            const int k = ks * 16 + 8 * h;
            bf16x8 a = *(const bf16x8*)(rp + (ti * 32 + r) * 64 + k);
            bf16x8 b = *(const bf16x8*)(s0 + (tj * 32 + r) * 64 + k);
            acc = mfma32(a, b, acc);
          }
        }
        y[tj] = acc;
        gg[tj] = zero16();
      }
#pragma unroll
      for (int ks = 0; ks < 8; ++ks) {
        const int k = ks * 16 + 8 * h;
        bf16x8 a = frag_c(SG, ti * 32 + r, k, LG);
#pragma unroll
        for (int tj = 0; tj < 2; ++tj) {
          bf16x8 bfr = *(const bf16x8*)(P.gateT + (size_t)(64 * hd + tj * 32 + r) * 128 + k);
          gg[tj] = mfma32(a, bfr, gg[tj]);
        }
      }
      float gw[2], gb[2];
#pragma unroll
      for (int tj = 0; tj < 2; ++tj) {
        const int ch = 64 * hd + tj * 32 + r;
        gw[tj] = P.gn_w[ch];
        gb[tj] = P.gn_b[ch];
      }
#pragma unroll
      for (int g = 0; g < 16; ++g) {
        float sacc = y[0][g] + y[1][g];
#pragma unroll
        for (int o = 16; o > 0; o >>= 1) sacc += __shfl_xor(sacc, o);
        const float mean = sacc * (1.f / 64.f);
        const float d0 = y[0][g] - mean, d1 = y[1][g] - mean;
        float v = d0 * d0 + d1 * d1;
#pragma unroll
        for (int o = 16; o > 0; o >>= 1) v += __shfl_xor(v, o);
        const float rstd = __builtin_amdgcn_rsqf(v * (1.f / 64.f) + 64e-5f);
        const int tl = ti * 32 + crow(g, h);
        const float bonus = BON[tl * 8 + hd];
#pragma unroll
        for (int tj = 0; tj < 2; ++tj) {
          const int ch = 64 * hd + tj * 32 + r;
          const float vs = bf2f(VS[tl * LV + ch]);
          const float dn = (tj ? d1 : d0) * rstd * gw[tj] + gb[tj];
          P.mixin[(size_t)(rb + tl) * D + 512 + ch] = f2bf((dn + bonus * vs) * gg[tj][g]);
        }
      }
    }
    __syncthreads();
  }
}

struct SchedRows : g8::DenseOrder {
  static constexpr int PF_LINES = 0;
  DI void pf(const g8::Unit2&, LAS unsigned char*, int) const {}
  DI void aoffs_late(const g8::Unit2& u, LAS unsigned char*, int, int R0, int R1, int C0, int C1, unsigned (&o)[2][2]) const { aoffs(u, R0, R1, C0, C1, o); }
  const bf16_t* A; const bf16_t* Bt;
  DI const char* abase() const { return (const char*)A; }
  DI const char* bbase(const g8::Unit2& u) const { return (const char*)(Bt + (size_t)u.pn * 256 * D); }
  DI void aoffs(const g8::Unit2& u, int R0, int R1, int C0, int C1, unsigned (&o)[2][2]) const {
#pragma unroll
    for (int h = 0; h < 2; ++h) {
      o[h][0] = (unsigned)(((u.pm * 256 + h * 128 + R0) * D + C0) * 2);
      o[h][1] = (unsigned)(((u.pm * 256 + h * 128 + R1) * D + C1) * 2);
    }
  }
};
DI void phase6(const Params& P, char* smem) {
  SchedRows S; S.init(L / 256, D / 256, gridDim.x, blockIdx.x); S.A = P.mixin; S.Bt = P.woutT;
  g8::gemm<g8::Unit2>((LAS unsigned char*)smem, S,
      [&](const g8::Acc& acc, const g8::Unit2& u, int wr, int wc, int fr, int fq, int) {
        const float* g1 = P.mod + 2048 + u.pn * 256 + wc * 32 + 4 * fq;
#pragma unroll
        for (int ai = 0; ai < 2; ++ai)
#pragma unroll
          for (int m = 0; m < 4; ++m) {
            const size_t ro = (size_t)(u.pm * 256 + ai * 128 + wr * 64 + m * 16 + fr) * D + u.pn * 256 + wc * 32 + 4 * fq;
#pragma unroll
            for (int bj = 0; bj < 2; ++bj)
#pragma unroll
              for (int n = 0; n < 2; ++n) {
                const f32x4 gv = *(const f32x4*)(g1 + bj * 128 + n * 16);
                const f32x4 xv = *(const f32x4*)(P.x + ro + bj * 128 + n * 16);
                *(f32x4*)(P.x1 + ro + bj * 128 + n * 16) = xv + gv * acc[ai][bj][m][n];
              }
          }
      }, D);
}

DI void phase8(const Params& P, char* smem) {
  SchedRows S; S.init(L / 256, 3, gridDim.x, blockIdx.x); S.A = P.h2; S.Bt = P.rsT;
  g8::gemm<g8::Unit2>((LAS unsigned char*)smem, S,
      [&](const g8::Acc& acc, const g8::Unit2& u, int wr, int wc, int fr, int fq, int) {
#pragma unroll
        for (int ai = 0; ai < 2; ++ai)
#pragma unroll
          for (int m = 0; m < 4; ++m) {
            const int row = u.pm * 256 + ai * 128 + wr * 64 + m * 16 + fr;
            if (u.pn == 0) {
              float* rp = P.logits + (size_t)row * NE + wc * 32 + 4 * fq;
#pragma unroll
              for (int bj = 0; bj < 2; ++bj)
#pragma unroll
                for (int n = 0; n < 2; ++n) *(f32x4*)(rp + bj * 128 + n * 16) = acc[ai][bj][m][n];
            } else {
              bf16_t* ap = P.act + ((size_t)row * NSLOT + 8) * DE + (u.pn - 1) * 128 + 4 * fq;
#pragma unroll
              for (int bj = 0; bj < 2; ++bj) {
                const f32x4 a = acc[ai][bj][m][0], bb = acc[ai][bj][m][1];
                u32x2 w;
                w[0] = pack2(siluf(a[0]) * bb[0], siluf(a[1]) * bb[1]);
                w[1] = pack2(siluf(a[2]) * bb[2], siluf(a[3]) * bb[3]);
                *(u32x2*)(ap + 16 * (4 * bj + wc)) = w;
              }
            }
          }
      }, D);
}

DI void phase9(const Params& P) {
  const int tid_ = fresh_tid();
  const int wid = tid_ >> 6, lane = tid_ & 63;
  for (int tok = blockIdx.x * 8 + wid; tok < L; tok += gridDim.x * 8) {
    float sc[4], bs[4];
#pragma unroll
    for (int q = 0; q < 4; ++q) {
      sc[q] = sigm(P.logits[(size_t)tok * NE + q * 64 + lane]);
      bs[q] = sc[q] + P.router_bias[q * 64 + lane];
    }
    int sel_i[8];
    float sel_s[8], ssum = 0.f;
#pragma unroll
    for (int j = 0; j < 8; ++j) {
      float best = bs[0];
      int bq = 0;
#pragma unroll
      for (int q = 1; q < 4; ++q)
        if (bs[q] > best) { best = bs[q]; bq = q; }
      float m = best;
#pragma unroll
      for (int o = 32; o > 0; o >>= 1) m = fmaxf(m, __shfl_xor(m, o));
      const unsigned long long msk = __ballot(best == m);
      const int ol = __ffsll((long long)msk) - 1;
      const int q = __shfl(bq, ol);
      const float cand = (q == 0) ? sc[0] : (q == 1) ? sc[1] : (q == 2) ? sc[2] : sc[3];
      const float s = __shfl(cand, ol);
#pragma unroll
      for (int qq = 0; qq < 4; ++qq) bs[qq] = (lane == ol && q == qq) ? -1e30f : bs[qq];
      sel_i[j] = q * 64 + ol;
      sel_s[j] = s;
      ssum += s;
    }
    const float inv = 2.5f / ssum;
    int my_e = 0;
    float my_g = 0.f;
#pragma unroll
    for (int j = 0; j < 8; ++j)
      if (lane == j) { my_e = sel_i[j]; my_g = sel_s[j] * inv; }
    if (lane < 8) {
      const int pos = atomicAdd(&P.cnt[my_e], 1);
      P.lid[(size_t)my_e * L + pos] = tok * NSLOT + lane;
      P.lgate[(size_t)my_e * L + pos] = my_g;
    }
  }
}

DI int moe_prefix(const Params& P, int* pre, int tid) {
  if (tid == 0) {
    int s = 0;
    for (int e = 0; e < 257; ++e) {
      pre[e] = s;
      const int c = (e < 256) ? P.cnt[e] : L;
      s += (c + 255) >> 8;
    }
    pre[257] = s;
  }
  __syncthreads();
  return pre[257];
}
DI int find_expert(const int* pre, int mt) {
  int lo = 0, hi = 256;
  while (lo < hi) {
    const int mid = (lo + hi + 1) >> 1;
    if (pre[mid] <= mt) lo = mid; else hi = mid - 1;
  }
  return lo;
}
DI int row_id(const Params& P, int e, int gi, int cnt) {
  const int g = gi < cnt ? gi : cnt - 1;
  return (e < 256) ? P.lid[(size_t)e * L + g] : g * NSLOT + 8;
}

struct UnitM { int e, mt, nt, cnt; };
template <int NN, int NEXP, int KD>
struct SchedMoe {
  static constexpr int PF_LINES = 0;
  const Params* P; const int* pre; int total, G, c;
  const bf16_t* A; const bf16_t* Bt;
  DI bool compute(int i, UnitM& u) const {
    const int U = total * NN, CH = (U + 7) >> 3;
    const int k = (c >> 3) + (G >> 3) * i;
    if (k >= CH) return false;
    const long Lx = (long)(c & 7) * CH + k; if (Lx >= U) return false;
    const int mtg = (int)(Lx / NN); u.nt = (int)(Lx % NN);
    u.e = find_expert(pre, mtg);
    u.mt = mtg - pre[u.e];
    u.cnt = pre[260 + u.e];
    return true;
  }
  DI void tabulate(int tid) const {
    if (tid < 16) {
      UnitM u; u.e = -1; u.mt = 0; u.nt = 0; u.cnt = 0;
      (void)compute(tid, u);
      int* tb = const_cast<int*>(pre) + 800 + tid * 4;
      tb[0] = u.e; tb[1] = u.mt; tb[2] = u.nt; tb[3] = u.cnt;
    }
    __syncthreads();
  }
  DI bool next(int i, UnitM& u) const {
    if (i >= 16) return false;
    const int* tb = pre + 800 + i * 4;
    u.e = __builtin_amdgcn_readfirstlane(tb[0]);
    if (u.e < 0) return false;
    u.mt = __builtin_amdgcn_readfirstlane(tb[1]);
    u.nt = __builtin_amdgcn_readfirstlane(tb[2]);
    u.cnt = __builtin_amdgcn_readfirstlane(tb[3]);
    return true;
  }
  static constexpr int IDS_OFF = 144384;
  DI void pf(const UnitM& u, LAS unsigned char* lds, int buf) const {
    const int tid = fresh_tid(), wid = __builtin_amdgcn_readfirstlane(tid >> 6);
    if (tid < 256) {
      const int gi = u.mt * 256 + tid, gc = gi < u.cnt ? gi : u.cnt - 1;
      const int* src = (u.e < 256) ? P->lid + (size_t)u.e * L + gc : P->ident + gc;
      __builtin_amdgcn_global_load_lds((const unsigned*)src, (LAS unsigned*)(lds + IDS_OFF + buf * 2048 + wid * 256), 4, 0, 0);
      if (KD != D) {
        const float* gs = (u.e < 256) ? P->lgate + (size_t)u.e * L + gc : P->ones;
        __builtin_amdgcn_global_load_lds((const unsigned*)gs, (LAS unsigned*)(lds + IDS_OFF + buf * 2048 + 1024 + wid * 256), 4, 0, 0);
      }
    }
  }
  DI void aoffs_late(const UnitM& u, LAS unsigned char* lds, int buf, int R0, int R1, int C0, int C1, unsigned (&o)[2][2]) const {
    const LAS int* ids = (const LAS int*)(lds + IDS_OFF + buf * 2048);
#pragma unroll
    for (int h = 0; h < 2; ++h) {
      const int i0 = ids[h * 128 + R0], i1 = ids[h * 128 + R1];
      o[h][0] = (unsigned)((KD == D) ? (i0 / NSLOT) : i0) * (unsigned)(KD * 2) + C0 * 2;
      o[h][1] = (unsigned)((KD == D) ? (i1 / NSLOT) : i1) * (unsigned)(KD * 2) + C1 * 2;
    }
  }
  DI const char* abase() const { return (const char*)A; }
  DI const char* bbase(const UnitM& u) const { return (const char*)(Bt + ((size_t)u.e * NN + u.nt) * 256 * KD); }
  DI unsigned arow(const UnitM& u, int r) const {
    const int id = row_id(*P, u.e, u.mt * 256 + r, u.cnt);
    return (unsigned)((KD == D) ? (id / NSLOT) : id) * (unsigned)(KD * 2);
  }
  DI void aoffs(const UnitM& u, int R0, int R1, int C0, int C1, unsigned (&o)[2][2]) const {
#pragma unroll
    for (int h = 0; h < 2; ++h) { o[h][0] = arow(u, h * 128 + R0) + C0 * 2; o[h][1] = arow(u, h * 128 + R1) + C1 * 2; }
  }
};
DI int moe_prefix_n(const Params& P, int* pre, int tid, int nexp) {
  int* tl = pre + 520;
  if (tid < 258) {
    const int c = (tid < 256) ? P.cnt[tid] : L;
    pre[260 + tid] = c;
    tl[tid] = (tid < nexp) ? ((c + 255) >> 8) : 0;
  }
  __syncthreads();
  if (tid < 258) {
    int sacc = 0;
    for (int e = 0; e < tid; ++e) sacc += tl[e];
    pre[tid] = sacc;
  }
  __syncthreads();
  return __builtin_amdgcn_readfirstlane(pre[257]);
}
DI void phase10(const Params& P, char* smem) {
  int* pre = (int*)(smem + 137216);
  SchedMoe<2, 256, D> S;
  S.total = moe_prefix_n(P, pre, fresh_tid(), 256);
  S.P = &P; S.pre = pre; S.G = gridDim.x; S.c = blockIdx.x; S.A = P.h2; S.Bt = P.w13T;
  S.tabulate(fresh_tid());
  g8::gemm<UnitM>((LAS unsigned char*)smem, S,
      [&](const g8::Acc& acc, const UnitM& u, int wr, int wc, int fr, int fq, int buf) {
        const int* IDS = (const int*)(smem + 144384 + buf * 2048);
#pragma unroll
        for (int ai = 0; ai < 2; ++ai)
#pragma unroll
          for (int m = 0; m < 4; ++m) {
            const int gi = u.mt * 256 + ai * 128 + wr * 64 + m * 16 + fr;
            if (gi < u.cnt) {
              bf16_t* ap = P.act + (size_t)IDS[ai * 128 + wr * 64 + m * 16 + fr] * DE + u.nt * 128 + 4 * fq;
#pragma unroll
              for (int bj = 0; bj < 2; ++bj) {
                const f32x4 a = acc[ai][bj][m][0], bb = acc[ai][bj][m][1];
                u32x2 w;
                w[0] = pack2(siluf(a[0]) * bb[0], siluf(a[1]) * bb[1]);
                w[1] = pack2(siluf(a[2]) * bb[2], siluf(a[3]) * bb[3]);
                *(u32x2*)(ap + 16 * (4 * bj + wc)) = w;
              }
            }
          }
      }, D);
}

DI void phase11(const Params& P, char* smem) {
  int* pre = (int*)(smem + 137216);
  SchedMoe<4, 257, DE> S;
  S.total = moe_prefix_n(P, pre, fresh_tid(), 257);
  S.P = &P; S.pre = pre; S.G = gridDim.x; S.c = blockIdx.x; S.A = P.act; S.Bt = P.w2T;
  S.tabulate(fresh_tid());
  g8::gemm<UnitM>((LAS unsigned char*)smem, S,
      [&](const g8::Acc& acc, const UnitM& u, int wr, int wc, int fr, int fq, int buf) {
        const int* IDS = (const int*)(smem + 144384 + buf * 2048);
        const float* GTS = (const float*)(smem + 144384 + buf * 2048 + 1024);
#pragma unroll
        for (int ai = 0; ai < 2; ++ai)
#pragma unroll
          for (int m = 0; m < 4; ++m) {
            const int gi = u.mt * 256 + ai * 128 + wr * 64 + m * 16 + fr;
            if (gi < u.cnt) {
              const int row = ai * 128 + wr * 64 + m * 16 + fr;
              const float gate = GTS[row] * SLAB_SCALE;
              unsigned char* sp = P.slab + (size_t)IDS[row] * D + u.nt * 256 + wc * 64 + 16 * fq;
              u32x4 w;
#pragma unroll
              for (int bj = 0; bj < 2; ++bj)
#pragma unroll
                for (int n = 0; n < 2; ++n) {
                  const f32x4 v = acc[ai][bj][m][n];
                  int q = 0;
                  q = __builtin_amdgcn_cvt_pk_fp8_f32(__builtin_amdgcn_fmed3f(gate * v[0], -440.f, 440.f), __builtin_amdgcn_fmed3f(gate * v[1], -440.f, 440.f), q, false);
                  q = __builtin_amdgcn_cvt_pk_fp8_f32(__builtin_amdgcn_fmed3f(gate * v[2], -440.f, 440.f), __builtin_amdgcn_fmed3f(gate * v[3], -440.f, 440.f), q, true);
                  w[2 * bj + n] = (unsigned)q;
                }
              *(u32x4*)sp = w;
            }
          }
      }, DE);
}

DI void phase12(const Params& P) {
  const int tid_ = fresh_tid();
  const int wid = tid_ >> 6, lane = tid_ & 63;
  const float* g2 = P.mod + 5120;
  for (int row = blockIdx.x * 8 + wid; row < L; row += gridDim.x * 8) {
    float v[2][8];
    float ss = 0.f;
#pragma unroll
    for (int i = 0; i < 2; ++i) {
      const int c = i * 512 + lane * 8;
      float sacc[8];
#pragma unroll
      for (int j = 0; j < 8; ++j) sacc[j] = 0.f;
#pragma unroll
      for (int j = 0; j < NSLOT; ++j) {
        const u32x2 w = __builtin_nontemporal_load((const u32x2*)(P.slab + ((size_t)row * NSLOT + j) * D + c));
#pragma unroll
        for (int e = 0; e < 2; ++e) {
          const f32x2v lo = __builtin_amdgcn_cvt_pk_f32_fp8((int)w[e], false), hi = __builtin_amdgcn_cvt_pk_f32_fp8((int)w[e], true);
          sacc[4 * e] += lo[0]; sacc[4 * e + 1] += lo[1]; sacc[4 * e + 2] += hi[0]; sacc[4 * e + 3] += hi[1];
        }
      }
      const f32x4 x0 = *(const f32x4*)(P.x1 + (size_t)row * D + c), x1v = *(const f32x4*)(P.x1 + (size_t)row * D + c + 4);
      const f32x4 g0 = *(const f32x4*)(g2 + c), g1v = *(const f32x4*)(g2 + c + 4);
#pragma unroll
      for (int j = 0; j < 4; ++j) {
        v[i][j] = x0[j] + g0[j] * (sacc[j] * (1.f / SLAB_SCALE));
        v[i][4 + j] = x1v[j] + g1v[j] * (sacc[4 + j] * (1.f / SLAB_SCALE));
        ss += v[i][j] * v[i][j] + v[i][4 + j] * v[i][4 + j];
      }
    }
    ss = wave_sum(ss);
    const float rs = __builtin_amdgcn_rsqf(ss * (1.f / 1024.f) + 1e-6f);
#pragma unroll
    for (int i = 0; i < 2; ++i) {
      const int c = i * 512 + lane * 8;
      const f32x4 f0 = *(const f32x4*)(P.final_g + c), f1 = *(const f32x4*)(P.final_g + c + 4);
      f32x4 o0, o1;
#pragma unroll
      for (int j = 0; j < 4; ++j) { o0[j] = v[i][j] * rs * f0[j]; o1[j] = v[i][4 + j] * rs * f1[j]; }
      __builtin_nontemporal_store(o0, (f32x4*)(P.out + (size_t)row * D + c));
      __builtin_nontemporal_store(o1, (f32x4*)(P.out + (size_t)row * D + c + 4));
    }
  }
}

__global__ void __launch_bounds__(NTHR) mega(Params P) {
  cg::grid_group grid = cg::this_grid();
  extern __shared__ __attribute__((aligned(16))) char smem[];
  volatile LAS unsigned* xst = (volatile LAS unsigned*)(smem + kDynLds - 16);
  if (threadIdx.x < 4) xst[threadIdx.x] = 0u;
  __syncthreads();
  XcdBarrier xb = xcd_barrier_post(P.bar, xst);
  prep_dense(P, smem);
  phase0(P, smem);
  if (P.coop_probe) grid.sync();
  xcd_barrier(xb);
  phase1(P);
  xcd_barrier(xb);
  phase2(P, smem);
  xcd_barrier(xb);
  phase34(P, smem);
  xcd_barrier(xb);
  phase5(P, smem);
  xcd_barrier(xb);
  phase6(P, smem);
  xcd_barrier(xb);
  phase7(P);
  xcd_barrier(xb);
  phase8(P, smem);
  xcd_barrier(xb);
  phase9(P);
  xcd_barrier(xb);
  phase10(P, smem);
  xcd_barrier(xb);
  phase11(P, smem);
  xcd_barrier(xb);
  phase12(P);
}

extern "C" void kernel_launch(void* const* d_in, const int* in_sizes, int n_in, void* d_out, int out_size, void* d_ws,
                              size_t ws_size, hipStream_t stream) {
  static int grid_blocks = 0;
  if (!grid_blocks) {
    int dev = 0, cus = 0, per_cu = 0;
    (void)hipGetDevice(&dev);
    (void)hipDeviceGetAttribute(&cus, hipDeviceAttributeMultiprocessorCount, dev);
    (void)hipFuncSetAttribute((const void*)mega, hipFuncAttributeMaxDynamicSharedMemorySize, (int)kDynLds);
    (void)hipOccupancyMaxActiveBlocksPerMultiprocessor(&per_cu, mega, NTHR, kDynLds);
    if (per_cu > 1) per_cu = 1;
    grid_blocks = cus * per_cu;
  }
  Params P{};
  const float* const* in = (const float* const*)d_in;
  P.x = in[0]; P.c = in[1]; P.ctx = in[2]; P.c_ctx = in[3]; P.ada_w = in[4]; P.ada_b = in[5]; P.norm1_g = in[6]; P.norm2_g = in[7];
  P.w_in = in[8]; P.conv_w = in[9]; P.shift_mu = in[10]; P.decay_w0 = in[11]; P.decay_up = in[12]; P.iclr_a0 = in[13];
  P.iclr_up = in[14]; P.key_xi = in[15]; P.key_alpha = in[16]; P.bonus_rho = in[17]; P.gate_up = in[18]; P.gn_w = in[19];
  P.gn_b = in[20]; P.w_out = in[21]; P.router_w = in[22]; P.router_bias = in[23]; P.exp_w1 = in[24]; P.exp_w3 = in[25];
  P.exp_w2 = in[26]; P.sh_w1 = in[27]; P.sh_w3 = in[28]; P.sh_w2 = in[29]; P.final_g = in[30];
  P.out = (float*)d_out;
  char* w = (char*)d_ws;
  size_t off = 0;
  auto take = [&](size_t bytes) { char* r = w + off; off += (bytes + 255) & ~(size_t)255; return r; };
  P.mod = (float*)take(6144 * 4);
  P.modc = (float*)take(6144 * 4);
  P.cnt = (int*)take(272 * 4);
  P.bar = (unsigned*)take((XCD_BAR_WORDS + 64 + NTASK) * 4);
  P.qh = P.bar + XCD_BAR_WORDS;
  P.flags = P.qh + 64;
  P.ident = (int*)take((size_t)L * 4);
  P.ones = (float*)take(1024);
  P.winT = (bf16_t*)take((size_t)PIN * D * 2);
  P.woutT = (bf16_t*)take((size_t)D * D * 2);
  P.rsT = (bf16_t*)take((size_t)768 * D * 2);
  P.gateT = (bf16_t*)take((size_t)512 * 128 * 2);
  P.bon = (float*)take((size_t)2 * L * 8 * 4);
  P.mixin = (bf16_t*)take((size_t)L * D * 2);
  P.w2T = (bf16_t*)take((size_t)257 * D * DE * 2);
  {
    const size_t r1 = off;
    P.hx = (bf16_t*)take((size_t)LT * D * 2);
    P.p = (bf16_t*)take((size_t)LT * PIN * 2 + 65536);
    const size_t r1_end = off;
    off = r1;
    P.x1 = (float*)take((size_t)L * D * 4);
    if (off < r1_end) off = r1_end;
  }
  {
    const size_t r2 = off;
    P.rpp = (bf16_t*)take((size_t)NTASK * 4096 * 2);
    P.yl = (float*)take((size_t)NTASK * 4096 * 4);
    P.gt = (bf16_t*)take((size_t)NTASK * 4096 * 2);
    P.ht = (float*)take((size_t)NTASK * 4096 * 4);
    P.s0 = (bf16_t*)take((size_t)NTASK * 4096 * 2);
    const size_t r2_end = off;
    off = r2;
    P.h2 = (bf16_t*)take((size_t)L * D * 2);
    P.logits = (float*)take((size_t)L * NE * 4);
    P.lid = (int*)take((size_t)NE * L * 4);
    P.lgate = (float*)take((size_t)NE * L * 4);
    P.act = (bf16_t*)take((size_t)L * NSLOT * DE * 2);
    if (off < r2_end) off = r2_end;
  }
  {
    const size_t r4 = off;
    P.w13T = (bf16_t*)take((size_t)256 * 512 * D * 2);
    const size_t r4_end = off;
    off = r4;
    P.slab = (unsigned char*)take((size_t)L * NSLOT * D);
    if (off < r4_end) off = r4_end;
  }
  if (off > ws_size) fprintf(stderr, "workspace too small: need %zu have %zu\n", off, ws_size);
  (void)hipMemsetAsync(P.bar, 0, (XCD_BAR_WORDS + 64 + NTASK) * 4, stream);
  void* args[] = {&P};
  hipError_t e = hipLaunchCooperativeKernel((void*)mega, dim3(grid_blocks), dim3(NTHR), args, kDynLds, stream);
  if (e != hipSuccess) fprintf(stderr, "cooperative launch failed: %s (grid %d)\n", hipGetErrorString(e), grid_blocks);
}
```

```cpp
#include <hip/hip_runtime.h>
#include <hip/hip_cooperative_groups.h>
#include <cstdio>
#include <cstdint>
namespace cg = cooperative_groups;

#define DI __device__ __forceinline__
__device__ __forceinline__ int fresh_tid() { int t = threadIdx.x; asm volatile("" : "+v"(t)); return t; }
typedef unsigned short bf16_t;
typedef short bf16x8 __attribute__((ext_vector_type(8)));
typedef float f32x4 __attribute__((ext_vector_type(4)));
typedef float f32x16 __attribute__((ext_vector_type(16)));
typedef unsigned u32x4 __attribute__((ext_vector_type(4)));
typedef unsigned u32x2 __attribute__((ext_vector_type(2)));

constexpr int D = 1024, L = 16384, LC = 256, LT = L + LC;
constexpr int PINW = 3456;
constexpr int PIN = 3584, PRW0 = 1536;
constexpr int NE = 256, TOPK = 8, DE = 256;
constexpr int NCH = LT / 64;
constexpr int NTASK = NCH * 16;
constexpr int NSLOT = 9;
constexpr int NTHR = 512;
constexpr size_t kDynLds = 152 * 1024;
constexpr float SLAB_SCALE = 8.f;


struct Params {
  const float *x, *c, *ctx, *c_ctx, *ada_w, *ada_b, *norm1_g, *norm2_g, *w_in, *conv_w, *shift_mu, *decay_w0, *decay_up,
      *iclr_a0, *iclr_up, *key_xi, *key_alpha, *bonus_rho, *gate_up, *gn_w, *gn_b, *w_out, *router_w, *router_bias, *exp_w1,
      *exp_w3, *exp_w2, *sh_w1, *sh_w3, *sh_w2, *final_g;
  float* out;
  float *mod, *modc;
  int* cnt;
  int coop_probe, pad0;
  int* ident; float* ones;
  unsigned* bar;
  unsigned* qh;
  unsigned* flags;
  bf16_t* hx;
  bf16_t *winT, *woutT, *rsT, *w13T, *w2T, *gateT;
  bf16_t* p;
  bf16_t* rpp;
  float* yl;
  bf16_t* gt;
  float* ht;
  bf16_t* s0;
  float* bon;
  bf16_t* mixin;
  float* x1;
  bf16_t* h2;
  float* logits;
  int* lid;
  float* lgate;
  bf16_t* act;
  unsigned char* slab;
};

DI float bf2f(bf16_t h) { return __uint_as_float(((unsigned)h) << 16); }
typedef float f32x2v __attribute__((ext_vector_type(2)));
typedef __bf16 bf16x2v __attribute__((ext_vector_type(2)));
DI bf16_t f2bf(float f) { return __builtin_bit_cast(unsigned short, (__bf16)f); }
DI unsigned pack2(float lo, float hi) {
  f32x2v v = {lo, hi};
  return __builtin_bit_cast(unsigned, __builtin_convertvector(v, bf16x2v));
}
DI float sigm(float x) { return __builtin_amdgcn_rcpf(1.f + __expf(-x)); }
DI float siluf(float x) { return x * sigm(x); }
DI float tanh_(float x) { return 1.f - 2.f * __builtin_amdgcn_rcpf(1.f + __expf(2.f * x)); }
DI float wave_sum(float v) {
#pragma unroll
  for (int o = 32; o > 0; o >>= 1) v += __shfl_xor(v, o);
  return v;
}


#define XB_TMO      128
#define XB_XCNT(j)  (256  + 64 * (j))
#define XB_XSUB(j)  (1280 + 64 * (j))
#define XB_XGEN(j)  (2304 + 64 * (j))
#define XB_TOP      3328
#define XB_TOPGEN   3392
#define XCD_BAR_WORDS 3456
#define XB_SPIN_CAP (1u << 22)
#define LAS __attribute__((address_space(3)))
#define GAS __attribute__((address_space(1)))
DI unsigned xb_ld(unsigned* p) { return __hip_atomic_load(p, __ATOMIC_RELAXED, __HIP_MEMORY_SCOPE_AGENT); }
DI unsigned xb_add(unsigned* p, unsigned v) { return __hip_atomic_fetch_add(p, v, __ATOMIC_RELAXED, __HIP_MEMORY_SCOPE_AGENT); }
DI unsigned xb_xcc_id() { return (unsigned)__builtin_amdgcn_s_getreg((3 << 11) | 20) & 0xFu; }
#define XB_SPIN(cond, bar) do { unsigned _sp = 0; while (cond) { __builtin_amdgcn_s_sleep(1); \
    if ((++_sp & 255u) == 0u) { if (xb_ld(&(bar)[XB_TMO])) break; if (_sp > XB_SPIN_CAP) { atomicAdd(&(bar)[XB_TMO], 1u); break; } } } } while (0)
struct XcdBarrier { unsigned* bar; unsigned x; volatile LAS unsigned* st; };
DI XcdBarrier xcd_barrier_post(unsigned* bar, volatile LAS unsigned* st) {
  XcdBarrier b; b.bar = bar; b.x = xb_xcc_id(); b.st = st;
  if (threadIdx.x == 0) (void)xb_add(&bar[XB_XCNT(b.x)], 1u);
  return b;
}
DI void xcd_barrier_complete(unsigned* bar, unsigned x, unsigned& nloc, unsigned& nx) {
  const unsigned G = gridDim.x * gridDim.y * gridDim.z;
  unsigned sum, cnt, mine, sp = 0u;
  for (;;) {
    sum = 0u; cnt = 0u; mine = 0u;
#pragma unroll
    for (unsigned j = 0; j < 16; ++j) { const unsigned c = xb_ld(&bar[XB_XCNT(j)]); sum += c; cnt += (c > 0u) ? 1u : 0u; mine = (j == x) ? c : mine; }
    if (sum == G) break;
    __builtin_amdgcn_s_sleep(1);
    if ((++sp & 255u) == 0u) { if (xb_ld(&bar[XB_TMO])) break; if (sp > XB_SPIN_CAP) { atomicAdd(&bar[XB_TMO], 1u); break; } }
  }
  nloc = mine > 0u ? mine : 1u; nx = cnt > 0u ? cnt : 1u;
}
DI void xcd_barrier(const XcdBarrier& b) {
  asm volatile("s_waitcnt vmcnt(0)" ::: "memory");
  __syncthreads();
  if (threadIdx.x == 0) {
    unsigned* bar = b.bar;
    __builtin_amdgcn_s_waitcnt(0);
    unsigned nloc = b.st[0], nx = b.st[1];
    if (nloc == 0u) { xcd_barrier_complete(bar, b.x, nloc, nx); b.st[0] = nloc; b.st[1] = nx; }
    const unsigned old = xb_add(&bar[XB_XSUB(b.x)], 1u);
    const unsigned gen = old / nloc;
    if (old + 1u == (gen + 1u) * nloc) {
      __builtin_amdgcn_fence(__ATOMIC_RELEASE, "agent");
      asm volatile("s_waitcnt vmcnt(0)" ::: "memory");
      const unsigned og = xb_add(&bar[XB_TOP], 1u);
      const unsigned tg = og / nx;
      if (og + 1u == (tg + 1u) * nx) xb_add(&bar[XB_TOPGEN], 1u);
      else XB_SPIN(xb_ld(&bar[XB_TOPGEN]) == tg, bar);
      __builtin_amdgcn_fence(__ATOMIC_ACQUIRE, "agent");
      xb_add(&bar[XB_XGEN(b.x)], 1u);
      asm volatile("s_waitcnt vmcnt(0)" ::: "memory");
    } else {
      XB_SPIN(xb_ld(&bar[XB_XGEN(b.x)]) == gen, bar);
      __builtin_amdgcn_fence(__ATOMIC_ACQUIRE, "agent");
      asm volatile("s_waitcnt vmcnt(0)" ::: "memory");
    }
  }
  __syncthreads();
}

struct GemmAcc { f32x4 a[4][4]; };

struct GStage { u32x4 a0, a1; f32x4 b0, b1; };
DI void g_load(GStage& S, const bf16_t* ap0, const bf16_t* ap1, const float* bp, int ldb, int t, int nt) {
  if (t < nt) {
    S.a0 = *(const u32x4*)(ap0 + t * 32);
    S.a1 = *(const u32x4*)(ap1 + t * 32);
    const float* bn = bp + (size_t)t * 32 * ldb;
    S.b0 = *(const f32x4*)(bn);
    S.b1 = *(const f32x4*)(bn + ldb);
  }
}
DI int swz4(int row) { return (0x78 >> (((row >> 2) & 3) * 2)) & 3; }
DI void g_write(const GStage& S, char* st, int tid, int kq, int ng) {
  {
    const int row = tid >> 2, ch = (tid & 3) ^ swz4(row);
    *(u32x4*)(st + row * 64 + ch * 16) = S.a0;
    *(u32x4*)(st + 8192 + row * 64 + ch * 16) = S.a1;
  }
  const int pc = ((kq >> 2) ^ swz4(4 * ng)) * 4 + (kq & 3);
  unsigned* dst = (unsigned*)(st + 16384) + (4 * ng) * 16 + pc;
  dst[0] = pack2(S.b0[0], S.b1[0]);
  dst[16] = pack2(S.b0[1], S.b1[1]);
  dst[32] = pack2(S.b0[2], S.b1[2]);
  dst[48] = pack2(S.b0[3], S.b1[3]);
}
DI void g_compute(GemmAcc& acc, const char* st, int wr, int wc, int fr, int fq) {
  bf16x8 At[4], Bt[4];
  const int pch = (fq ^ swz4(fr)) * 16;
#pragma unroll
  for (int m = 0; m < 4; ++m) At[m] = *(const bf16x8*)(st + (wr * 64 + m * 16 + fr) * 64 + pch);
#pragma unroll
  for (int n = 0; n < 4; ++n) Bt[n] = *(const bf16x8*)(st + 16384 + (wc * 64 + n * 16 + fr) * 64 + pch);
#pragma unroll
  for (int m = 0; m < 4; ++m)
#pragma unroll
    for (int n = 0; n < 4; ++n) acc.a[m][n] = __builtin_amdgcn_mfma_f32_16x16x32_bf16(At[m], Bt[n], acc.a[m][n], 0, 0, 0);
}
template <class ARow, class BCol, class Epi>
DI void gemm_tile(char* smem, const ARow& arow, const BCol& bcol, int ldb, int K, const Epi& epi) {
  const int tid = fresh_tid(), wid = tid >> 6, lane = tid & 63, wr = wid >> 1, wc = wid & 1, fr = lane & 15, fq = lane >> 4;
  const int ar0 = tid >> 2, ac0 = (tid & 3) * 8;
  const bf16_t* ap0 = arow(ar0) + ac0;
  const bf16_t* ap1 = arow(ar0 + 128) + ac0;
  const int kq = tid & 15, ng = tid >> 4;
  const float* bp = bcol(ng) + (size_t)(2 * kq) * ldb;
  GemmAcc acc;
#pragma unroll
  for (int m = 0; m < 4; ++m)
#pragma unroll
    for (int n = 0; n < 4; ++n) acc.a[m][n] = (f32x4){0.f, 0.f, 0.f, 0.f};
  const int nt = K / 32;
  char* st0 = smem;
  char* st1 = smem + 24576;
  GStage S0, S1, S2;
  g_load(S0, ap0, ap1, bp, ldb, 0, nt);
  g_load(S1, ap0, ap1, bp, ldb, 1, nt);
  g_load(S2, ap0, ap1, bp, ldb, 2, nt);
  g_write(S0, st0, tid, kq, ng);
  g_load(S0, ap0, ap1, bp, ldb, 3, nt);
  __syncthreads();
  for (int t = 0; t < nt; t += 3) {
    {
      char* cur = (t & 1) ? st1 : st0; char* nxt = (t & 1) ? st0 : st1;
      g_compute(acc, cur, wr, wc, fr, fq);
      if (t + 1 < nt) g_write(S1, nxt, tid, kq, ng);
      g_load(S1, ap0, ap1, bp, ldb, t + 4, nt);
      __syncthreads();
    }
    if (t + 1 < nt) {
      char* cur = ((t + 1) & 1) ? st1 : st0; char* nxt = ((t + 1) & 1) ? st0 : st1;
      g_compute(acc, cur, wr, wc, fr, fq);
      if (t + 2 < nt) g_write(S2, nxt, tid, kq, ng);
      g_load(S2, ap0, ap1, bp, ldb, t + 5, nt);
      __syncthreads();
    }
    if (t + 2 < nt) {
      char* cur = ((t + 2) & 1) ? st1 : st0; char* nxt = ((t + 2) & 1) ? st0 : st1;
      g_compute(acc, cur, wr, wc, fr, fq);
      if (t + 3 < nt) g_write(S0, nxt, tid, kq, ng);
      g_load(S0, ap0, ap1, bp, ldb, t + 6, nt);
      __syncthreads();
    }
  }
  epi(acc, wr, wc, fr, fq);
}


template <int NC, class Val, class RowPtr>
DI void epi_bf16_lds(char* smem, int wr, int wc, int fr, int fq, const Val& val, const RowPtr& rowptr) {
  constexpr int LDC = NC + 8;
  bf16_t* T = (bf16_t*)smem;
#pragma unroll
  for (int m = 0; m < 4; ++m)
#pragma unroll
    for (int n = 0; n < NC / 32; ++n)
#pragma unroll
      for (int j = 0; j < 4; ++j) T[(wr * 64 + m * 16 + fq * 4 + j) * LDC + wc * (NC / 2) + n * 16 + fr] = f2bf(val(m, n, j));
  __syncthreads();
  constexpr int CPR = NC / 8;
  constexpr int RPI = NTHR / CPR;
  const int tid = fresh_tid(), ch = tid % CPR, r0 = tid / CPR;
#pragma unroll 4
  for (int it = 0; it < 256 / RPI; ++it) {
    const int r = it * RPI + r0;
    bf16_t* dst = rowptr(r);
    if (dst) *(u32x4*)(dst + ch * 8) = *(const u32x4*)(T + r * LDC + ch * 8);
  }
  __syncthreads();
}


struct Acc256 { f32x4 a[8][4]; };
struct GStage2 { u32x4 a0, a1; f32x4 b00, b01, b10, b11; };
template <class BP>
DI void g2_load(GStage2& S, const bf16_t* ap0, const bf16_t* ap1, const BP& bp0, const BP& bp1, int ldb, int t, int nt) {
  if (t < nt) {
    S.a0 = *(const u32x4*)(ap0 + t * 32);
    S.a1 = *(const u32x4*)(ap1 + t * 32);
    const size_t o = (size_t)t * 32 * ldb;
    S.b00 = *(const f32x4*)(bp0 + o);
    S.b01 = *(const f32x4*)(bp0 + o + ldb);
    S.b10 = *(const f32x4*)(bp1 + o);
    S.b11 = *(const f32x4*)(bp1 + o + ldb);
  }
}
DI void g2_write(const GStage2& S, char* st, int tid, int kq, int ng) {
  {
    const int row = tid >> 2, ch = (tid & 3) ^ swz4(row);
    *(u32x4*)(st + row * 64 + ch * 16) = S.a0;
    *(u32x4*)(st + 8192 + row * 64 + ch * 16) = S.a1;
  }
  const int pc = ((kq >> 2) ^ swz4(4 * ng)) * 4 + (kq & 3);
  unsigned* dst = (unsigned*)(st + 16384) + (4 * ng) * 16 + pc;
  dst[0] = pack2(S.b00[0], S.b01[0]);
  dst[16] = pack2(S.b00[1], S.b01[1]);
  dst[32] = pack2(S.b00[2], S.b01[2]);
  dst[48] = pack2(S.b00[3], S.b01[3]);
  dst[2048 + 0] = pack2(S.b10[0], S.b11[0]);
  dst[2048 + 16] = pack2(S.b10[1], S.b11[1]);
  dst[2048 + 32] = pack2(S.b10[2], S.b11[2]);
  dst[2048 + 48] = pack2(S.b10[3], S.b11[3]);
}
DI void g2_compute(Acc256& acc, const char* st, int wr, int wc, int fr, int fq) {
  bf16x8 Bt[4];
  const int pch = (fq ^ swz4(fr)) * 16;
#pragma unroll
  for (int n = 0; n < 4; ++n) Bt[n] = *(const bf16x8*)(st + 16384 + (wc * 64 + n * 16 + fr) * 64 + pch);
#pragma unroll
  for (int m = 0; m < 8; ++m) {
    const bf16x8 At = *(const bf16x8*)(st + (wr * 128 + m * 16 + fr) * 64 + pch);
#pragma unroll
    for (int n = 0; n < 4; ++n) acc.a[m][n] = __builtin_amdgcn_mfma_f32_16x16x32_bf16(At, Bt[n], acc.a[m][n], 0, 0, 0);
  }
}
template <class ARow, class BCol, class Epi>
DI void gemm256(char* smem, const ARow& arow, const BCol& bcol, int ldb, int K, const Epi& epi) {
  const int tid = fresh_tid(), wid = tid >> 6, lane = tid & 63, wr = wid >> 2, wc = wid & 3, fr = lane & 15, fq = lane >> 4;
  const int ar0 = tid >> 2, ac0 = (tid & 3) * 8;
  const bf16_t* ap0 = arow(ar0) + ac0;
  const bf16_t* ap1 = arow(ar0 + 128) + ac0;
  const int kq = tid & 15, ng = tid >> 4;
  const float* bp0 = bcol(ng) + (size_t)(2 * kq) * ldb;
  const float* bp1 = bcol(ng + 32) + (size_t)(2 * kq) * ldb;
  Acc256 acc;
#pragma unroll
  for (int m = 0; m < 8; ++m)
#pragma unroll
    for (int n = 0; n < 4; ++n) acc.a[m][n] = (f32x4){0.f, 0.f, 0.f, 0.f};
  const int nt = K / 32;
  char* st0 = smem;
  char* st1 = smem + 32768;
  GStage2 S0, S1;
  g2_load(S0, ap0, ap1, bp0, bp1, ldb, 0, nt);
  g2_load(S1, ap0, ap1, bp0, bp1, ldb, 1, nt);
  g2_write(S0, st0, tid, kq, ng);
  g2_load(S0, ap0, ap1, bp0, bp1, ldb, 2, nt);
  __syncthreads();
  for (int t = 0; t < nt; t += 2) {
    g2_compute(acc, st0, wr, wc, fr, fq);
    g2_write(S1, st1, tid, kq, ng);
    g2_load(S1, ap0, ap1, bp0, bp1, ldb, t + 3, nt);
    __syncthreads();
    g2_compute(acc, st1, wr, wc, fr, fq);
    if (t + 2 < nt) g2_write(S0, st0, tid, kq, ng);
    g2_load(S0, ap0, ap1, bp0, bp1, ldb, t + 4, nt);
    __syncthreads();
  }
  epi(acc, wr, wc, fr, fq);
}
template <int NC, class Val, class RowPtr>
DI void epi256_bf16(char* smem, int wr, int wc, int fr, int fq, const Val& val, const RowPtr& rowptr, int ncv = 1 << 30) {
  constexpr int LDC = NC + 8;
  bf16_t* T = (bf16_t*)smem;
#pragma unroll
  for (int m = 0; m < 8; ++m)
#pragma unroll
    for (int n = 0; n < NC / 64; ++n)
#pragma unroll
      for (int j = 0; j < 4; ++j) T[(wr * 128 + m * 16 + fq * 4 + j) * LDC + wc * (NC / 4) + n * 16 + fr] = f2bf(val(m, n, j));
  __syncthreads();
  constexpr int CPR = NC / 8, RPI = NTHR / CPR;
  const int tid = fresh_tid(), ch = tid % CPR, r0 = tid / CPR;
#pragma unroll 4
  for (int it = 0; it < 256 / RPI; ++it) {
    const int r = it * RPI + r0;
    bf16_t* dst = rowptr(r);
    if (dst && ch * 8 < ncv) *(u32x4*)(dst + ch * 8) = *(const u32x4*)(T + r * LDC + ch * 8);
  }
  __syncthreads();
}


namespace g8 {
constexpr int BK = 64, HALF = 128, HTB = HALF * BK * 2;
DI int lds_byte(int r, int c) { const int st = (r >> 4) * 2 + (c >> 5), rr = r & 15, cc = c & 31, ob = rr * 64 + cc * 2; return st * 1024 + (ob ^ (((ob >> 9) & 1) << 5)); }
DI void stage_rc(int b, int& R, int& C) { const int st = b / 1024, sb = b % 1024, swz = sb ^ (((sb >> 9) & 1) << 5); R = (st >> 1) * 16 + swz / 64; C = (st & 1) * 32 + (swz % 64) / 2; }
typedef f32x4 Acc[2][2][4][2];
template <class Unit, class Sched, class Epi>
DI void gemm(LAS unsigned char* lds, const Sched& S, const Epi& E, int K) {
  asm volatile("" : "+s"(K));
  const int tid = fresh_tid(), wid = __builtin_amdgcn_readfirstlane(tid >> 6), lane = tid & 63, wr = wid >> 2, wc = wid & 3, fr = lane & 15, fq = lane >> 4;
  const int nt = K / BK;
  int R[2], C[2];
  unsigned voffB[2];
#pragma unroll
  for (int i = 0; i < 2; ++i) { stage_rc(tid * 16 + i * 8192, R[i], C[i]); voffB[i] = (unsigned)(R[i] * K + C[i]) * 2u; }
  const size_t kstep = (size_t)(BK * 2);
  const size_t hstep = (size_t)HALF * K * 2;
  const unsigned ldsw = (unsigned)wid * 1024u;
  const int aoff = lds_byte(wr * 64 + fr, fq * 8), boff = lds_byte(wc * 32 + fr, fq * 8);
#define G8_SA(b, h) (((b) * 2 + (h)) * HTB)
#define G8_SB(b, h) ((4 + (b) * 2 + (h)) * HTB)
#define G8_STAGEB(bufoff, gbase) do { _Pragma("unroll") for (int _i = 0; _i < 2; ++_i) \
    __builtin_amdgcn_global_load_lds((const unsigned*)((const char*)(gbase) + voffB[_i]), (LAS unsigned*)(lds + (bufoff) + ldsw + _i * 8192), 16, 0, 0); } while (0)
#define G8_STAGEA(bufoff, offs, h, kb) do { _Pragma("unroll") for (int _i = 0; _i < 2; ++_i) \
    __builtin_amdgcn_global_load_lds((const unsigned*)(abase + (size_t)(offs)[h][_i] + (kb)), (LAS unsigned*)(lds + (bufoff) + ldsw + _i * 8192), 16, 0, 0); } while (0)
#define G8_LDA(dst, b, h) do { _Pragma("unroll") for (int m = 0; m < 4; ++m) _Pragma("unroll") for (int k = 0; k < 2; ++k) dst[m][k] = *(const LAS bf16x8*)(lds + G8_SA(b, h) + aoff + m * 2048 + k * 1024); } while (0)
#define G8_LDB(dst, b, h) do { _Pragma("unroll") for (int n = 0; n < 2; ++n) _Pragma("unroll") for (int k = 0; k < 2; ++k) dst[n][k] = *(const LAS bf16x8*)(lds + G8_SB(b, h) + boff + n * 2048 + k * 1024); } while (0)
#define G8_MMA(ai, bj, At, Bt) do { __builtin_amdgcn_s_setprio(1); _Pragma("unroll") for (int m = 0; m < 4; ++m) _Pragma("unroll") for (int n = 0; n < 2; ++n) _Pragma("unroll") for (int k = 0; k < 2; ++k) \
    acc[ai][bj][m][n] = __builtin_amdgcn_mfma_f32_16x16x32_bf16(Bt[n][k], At[m][k], acc[ai][bj][m][n], 0, 0, 0); __builtin_amdgcn_s_setprio(0); } while (0)
#define G8_WAIT_V(n) asm volatile("s_waitcnt vmcnt(" #n ")" ::: "memory")
#define G8_WAIT_L(n) asm volatile("s_waitcnt lgkmcnt(" #n ")" ::: "memory")
#define G8_BAR __builtin_amdgcn_s_barrier()
#define G8_SCHED __builtin_amdgcn_sched_barrier(0)
  Unit cur, nxt; int ui = 0;
  if (!S.next(0, cur)) return;
  const char* abase = S.abase();
  Acc acc;
#pragma unroll
  for (int a = 0; a < 2; ++a)
#pragma unroll
    for (int b = 0; b < 2; ++b)
#pragma unroll
      for (int m = 0; m < 4; ++m)
#pragma unroll
        for (int n = 0; n < 2; ++n) acc[a][b][m][n] = (f32x4){0.f, 0.f, 0.f, 0.f};
  bf16x8 At[4][2], B0[2][2], B1[2][2];
  unsigned co[2][2], no[2][2];
  S.pf(cur, lds, 0);
  S.aoffs(cur, R[0], R[1], C[0], C[1], co);
  const char* cB = S.bbase(cur);
  G8_STAGEB(G8_SB(0, 0), cB); G8_STAGEA(G8_SA(0, 0), co, 0, 0); G8_STAGEB(G8_SB(0, 1), cB + hstep); G8_STAGEA(G8_SA(0, 1), co, 1, 0);
  if (wr == 1) G8_BAR;
  G8_WAIT_V(4); G8_BAR;
  G8_STAGEB(G8_SB(1, 0), cB + kstep); G8_STAGEA(G8_SA(1, 0), co, 0, kstep); G8_STAGEB(G8_SB(1, 1), cB + hstep + kstep);
  G8_WAIT_V(6); G8_BAR;
  for (;;) {
    const bool has_next = S.next(ui + 1, nxt);
    const char* nB = cB;
    if (has_next) { nB = S.bbase(nxt); S.pf(nxt, lds, (ui + 1) % 3); }
    for (int t = 0; t < nt; t += 2) {
      const bool last = (t == nt - 2);
      const size_t k1 = (size_t)(t + 1) * kstep;
      const size_t k2 = last ? 0 : (size_t)(t + 2) * kstep;
      const size_t k3 = k2 + kstep;
      const char* b2 = (last ? nB : cB) + k2;
      const char* b3 = b2 + kstep;
      if (last) {
        if (has_next) S.aoffs_late(nxt, lds, (ui + 1) % 3, R[0], R[1], C[0], C[1], no);
        else {
#pragma unroll
          for (int h = 0; h < 2; ++h)
#pragma unroll
            for (int i = 0; i < 2; ++i) no[h][i] = co[h][i];
        }
      }
      G8_LDB(B0, 0, 0); G8_SCHED; G8_LDA(At, 0, 0); G8_STAGEA(G8_SA(1, 1), co, 1, k1);
      G8_WAIT_L(8); G8_BAR; G8_WAIT_L(0); G8_MMA(0, 0, At, B0); G8_BAR; G8_SCHED;
      G8_LDB(B1, 0, 1); G8_STAGEB(G8_SB(0, 0), b2);
      G8_BAR; G8_WAIT_L(0); G8_MMA(0, 1, At, B1); G8_BAR;
      G8_LDA(At, 0, 1);
      if (last) { G8_STAGEA(G8_SA(0, 0), no, 0, k2); } else { G8_STAGEA(G8_SA(0, 0), co, 0, k2); }
      G8_BAR; G8_WAIT_L(0); G8_MMA(1, 0, At, B0); G8_BAR; G8_SCHED;
      G8_STAGEB(G8_SB(0, 1), b2 + hstep);
      G8_WAIT_V(6); G8_BAR; G8_MMA(1, 1, At, B1); G8_BAR;
      G8_LDB(B0, 1, 0); G8_SCHED; G8_LDA(At, 1, 0);
      if (last) { G8_STAGEA(G8_SA(0, 1), no, 1, k2); } else { G8_STAGEA(G8_SA(0, 1), co, 1, k2); }
      G8_WAIT_L(8); G8_BAR; G8_WAIT_L(0); G8_MMA(0, 0, At, B0); G8_BAR; G8_SCHED;
      G8_LDB(B1, 1, 1); G8_STAGEB(G8_SB(1, 0), b3);
      G8_BAR; G8_WAIT_L(0); G8_MMA(0, 1, At, B1); G8_BAR;
      G8_LDA(At, 1, 1);
      if (last) { G8_STAGEA(G8_SA(1, 0), no, 0, k3); } else { G8_STAGEA(G8_SA(1, 0), co, 0, k3); }
      G8_BAR; G8_WAIT_L(0); G8_MMA(1, 0, At, B0); G8_BAR; G8_SCHED;
      G8_STAGEB(G8_SB(1, 1), b3 + hstep);
      G8_WAIT_V(6); G8_BAR; G8_MMA(1, 1, At, B1); G8_BAR;
    }
    E(acc, cur, wr, wc, fr, fq, ui % 3);
    if (!has_next) break;
#pragma unroll
    for (int a = 0; a < 2; ++a)
#pragma unroll
      for (int b = 0; b < 2; ++b)
#pragma unroll
        for (int m = 0; m < 4; ++m)
#pragma unroll
          for (int n = 0; n < 2; ++n) acc[a][b][m][n] = (f32x4){0.f, 0.f, 0.f, 0.f};
    cur = nxt; cB = nB; ++ui;
#pragma unroll
    for (int h = 0; h < 2; ++h)
#pragma unroll
      for (int i = 0; i < 2; ++i) co[h][i] = no[h][i];
  }
  G8_WAIT_V(0);
  if (wr == 0) G8_BAR;
  G8_BAR;
#undef G8_SA
#undef G8_SB
#undef G8_STAGEA
#undef G8_STAGEB
#undef G8_LDA
#undef G8_LDB
#undef G8_MMA
#undef G8_WAIT_V
#undef G8_WAIT_L
#undef G8_BAR
#undef G8_SCHED
}
struct Unit2 { int pm, pn; };
struct DenseOrder {
  int nM, nN, nwg, G, c;
  DI void init(int nM_, int nN_, int G_, int c_) { nM = nM_; nN = nN_; nwg = nM * nN; G = G_; c = c_; }
  DI bool next(int i, Unit2& u) const {
    const long Lx = (long)i * G + c; if (Lx >= nwg) return false;
    int wgid = (int)Lx; { const int q = nwg / 8, r = nwg % 8, xcd = wgid % 8, off = wgid / 8; wgid = (xcd < r ? xcd * (q + 1) : r * (q + 1) + (xcd - r) * q) + off; }
    const int nig = 8 * nN, gid = wgid / nig, fm = gid * 8, gsz = (nM - fm) < 8 ? (nM - fm) : 8;
    u.pm = fm + ((wgid % nig) % gsz); u.pn = (wgid % nig) / gsz; return true;
  }
};
}

template <class ColPtr>
DI void transpose_tile(char* smem, int ld, bf16_t* dst, int Kdim, int k0, int rho0, const ColPtr& colptr) {
  bf16_t* T = (bf16_t*)smem;
  const int tid = fresh_tid();
  {
    const int kk = tid >> 3, g = tid & 7;
    const int rho = rho0 + g * 8;
    const float* cp = colptr(rho);
    const float* cp2 = colptr(rho + 4);
    f32x4 v0, v1;
    if (cp) { v0 = *(const f32x4*)(cp + (size_t)(k0 + kk) * ld); v1 = *(const f32x4*)(cp2 + (size_t)(k0 + kk) * ld); }
    else { v0 = (f32x4){0.f, 0.f, 0.f, 0.f}; v1 = v0; }
#pragma unroll
    for (int j = 0; j < 4; ++j) { T[(g * 8 + j) * 72 + kk] = f2bf(v0[j]); T[(g * 8 + 4 + j) * 72 + kk] = f2bf(v1[j]); }
  }
  __syncthreads();
  {
    const int r = tid >> 3, ch = tid & 7;
    *(u32x4*)(dst + (size_t)(rho0 + r) * Kdim + k0 + ch * 8) = *(const u32x4*)(T + r * 72 + ch * 8);
  }
  __syncthreads();
}

DI int swiglu_col(int rho, int& z);
struct PrepTile { const float* src[4]; const float* src2[4]; bf16_t* dst; int ld, Kdim, perm; };
DI int w2_row(int c) { const int wc = c >> 6, fq = (c >> 4) & 3, bj = (c >> 3) & 1, n = (c >> 2) & 1, e = c & 3; return 128 * bj + 32 * wc + 16 * n + 4 * fq + e; }
DI int w2_col(int rho) { const int bj = rho >> 7, wc = (rho >> 5) & 3, n = (rho >> 4) & 1, fq = (rho >> 2) & 3, e = rho & 3; return 64 * wc + 16 * fq + 8 * bj + 4 * n + e; }
DI int perm32(int rho) { const int n = rho >> 4, i = rho & 15; return 8 * (i >> 2) + 4 * n + (i & 3); }
DI void prep_tile_desc(const Params& P, int u, int ch, int r, PrepTile& t) {
  constexpr int PER_E = 32 + 16;
  const int e = u / PER_E, v = u % PER_E;
  if (e < 256 && v < 32) {
    const int pn = v >> 4, kt = v & 15;
    const float* W1 = P.exp_w1 + (size_t)e * D * DE;
    const float* W3 = P.exp_w3 + (size_t)e * D * DE;
    t.ld = DE; t.Kdim = D; t.perm = 0;
    t.dst = P.w13T + ((size_t)e * 512 + pn * 256) * D + kt * 64;
#pragma unroll
    for (int sb = 0; sb < 4; ++sb) {
      int z; const int col = swiglu_col(pn * 256 + sb * 64 + ch * 4, z);
      t.src[sb] = (z ? W3 : W1) + col + (size_t)(kt * 64 + 2 * r) * DE;
      t.src2[sb] = t.src[sb] + DE;
    }
  } else {
    const int w = (e < 256) ? v - 32 : v;
    const int pn = w >> 2, kt = w & 3;
    const float* W2 = (e < 256) ? P.exp_w2 + (size_t)e * DE * D : P.sh_w2;
    t.ld = D; t.Kdim = DE;
    t.dst = P.w2T + ((size_t)e * D + pn * 256) * DE + kt * 64;
    t.perm = 1;
#pragma unroll
    for (int sb = 0; sb < 4; ++sb) {
      t.src[sb] = W2 + pn * 256 + sb * 64 + ch * 4 + (size_t)(kt * 64 + 2 * r) * D;
      t.src2[sb] = t.src[sb] + D;
    }
  }
}
constexpr int PREP_TOTAL = 256 * 48 + 16;
constexpr int NPREPB = 60;
constexpr int NW2 = 24, B2 = 2;
constexpr int B8 = 1;
constexpr int TASK_Q0 = (256 - 16 - NPREPB) * 2;
constexpr int FSTR = 384;
constexpr int PB = 8;
struct PrepSet { f32x4 v[4][2]; bf16_t* dst; int Kdim, perm; };
struct PrepGen { int u, bend, nbase; };
DI void prep_issue(const Params& P, PrepSet& S, int u, int ch, int r2) {
  PrepTile t;
  prep_tile_desc(P, u, ch, r2, t);
#pragma unroll
  for (int sb = 0; sb < 4; ++sb) { S.v[sb][0] = __builtin_nontemporal_load((const f32x4*)t.src[sb]); S.v[sb][1] = __builtin_nontemporal_load((const f32x4*)t.src2[sb]); }
  S.dst = t.dst; S.Kdim = t.Kdim; S.perm = t.perm;
}
DI int prep_gen_next(PrepGen& G, bool& entered) {
  const int r = G.u;
  entered = false;
  if (r < PREP_TOTAL) {
    G.u = r + 1;
    if (G.u >= G.bend) { G.u = G.nbase; G.bend = G.nbase + PB; G.nbase = PREP_TOTAL; entered = G.u < PREP_TOTAL; }
  }
  return r;
}
#define PREP_BODY(S, cid)                                                                                              \
  {                                                                                                                    \
    if (fstate && tid == 0) qw[0] = (int)nb_reg;                                                                       \
    unsigned* T = (unsigned*)(smem + par * 33792);                                                                     \
    par ^= 1;                                                                                                          \
    _Pragma("unroll") for (int sb = 0; sb < 4; ++sb)                                                                   \
      _Pragma("unroll") for (int j = 0; j < 4; ++j) {                                                                  \
        const int c = sb * 64 + ch * 4 + j;                                                                            \
        T[(S.perm ? w2_row(c) : c) * 33 + r2] = pack2(S.v[sb][0][j], S.v[sb][1][j]);                                   \
      }                                                                                                                \
    bf16_t* dst = S.dst; const int Kdim = S.Kdim;                                                                      \
    bool entered;                                                                                                      \
    cid = prep_gen_next(G, entered);                                                                                   \
    if (cid < PREP_TOTAL) prep_issue(P, S, cid, ch, r2);                                                               \
    if (entered) { if (left > 0) --left; else entered = false; }                                                       \
    if (entered && tid == 0) nb_reg = __hip_atomic_fetch_add(qp, (unsigned)PB, __ATOMIC_RELAXED, __HIP_MEMORY_SCOPE_AGENT); \
    __syncthreads();                                                                                                   \
    if (fstate) G.nbase = __builtin_amdgcn_readfirstlane(qw[0]);                                                       \
    fstate = entered;                                                                                                  \
    _Pragma("unroll") for (int it = 0; it < 4; ++it) {                                                                 \
      const int ro = it * 64 + (tid >> 3), co = tid & 7;                                                               \
      const unsigned* tp = T + ro * 33 + co * 4;                                                                       \
      u32x4 o; o[0] = tp[0]; o[1] = tp[1]; o[2] = tp[2]; o[3] = tp[3];                                                 \
      __builtin_nontemporal_store(o, (u32x4*)(dst + (size_t)ro * Kdim + co * 8));                                      \
    }                                                                                                                  \
  }
DI void prep_dyn(const Params& P, char* smem, int budget) {
  LAS int* qw = (LAS int*)(smem + 69632);
  GAS unsigned* qp = (GAS unsigned*)(P.qh + 32);
  const int tid = fresh_tid();
  const int ch = tid & 15, r2 = tid >> 4;
  int par = 0;
  if (tid == 0) qw[1] = (int)__hip_atomic_fetch_add(qp, (unsigned)PB, __ATOMIC_RELAXED, __HIP_MEMORY_SCOPE_AGENT);
  __syncthreads();
  const int base = __builtin_amdgcn_readfirstlane(qw[1]);
  if (base >= PREP_TOTAL) return;
  PrepGen G; G.u = base; G.bend = base + PB; G.nbase = PREP_TOTAL;
  unsigned nb_reg = 0;
  int left = budget - 1;
  bool fstate = left > 0;
  if (fstate) { --left; if (tid == 0) nb_reg = __hip_atomic_fetch_add(qp, (unsigned)PB, __ATOMIC_RELAXED, __HIP_MEMORY_SCOPE_AGENT); }
  PrepSet R0, R1, R2;
  bool e_;
  int c0 = prep_gen_next(G, e_), c1 = prep_gen_next(G, e_), c2 = prep_gen_next(G, e_);
  prep_issue(P, R0, c0, ch, r2);
  prep_issue(P, R1, c1, ch, r2);
  prep_issue(P, R2, c2, ch, r2);
  for (;;) {
    if (c0 >= PREP_TOTAL) break;
    PREP_BODY(R0, c0)
    if (c1 >= PREP_TOTAL) break;
    PREP_BODY(R1, c1)
    if (c2 >= PREP_TOTAL) break;
    PREP_BODY(R2, c2)
  }
  __syncthreads();
}

DI int swiglu_col(int rho, int& z) { const int kap = rho & 255, pn = rho >> 8; z = (kap >> 4) & 1; return pn * 128 + (kap >> 5) * 16 + (kap & 15); }

constexpr int LD = 72;
constexpr int SLOT = 64 * LD * 2;
DI f32x16 mfma32(bf16x8 a, bf16x8 b, f32x16 c) { return __builtin_amdgcn_mfma_f32_32x32x16_bf16(a, b, c, 0, 0, 0); }
DI f32x16 zero16() {
  f32x16 z;
#pragma unroll
  for (int i = 0; i < 16; ++i) z[i] = 0.f;
  return z;
}
DI bf16x8 frag_c(const bf16_t* M, int row, int k, int ld = LD) { return *(const bf16x8*)(M + row * ld + k); }
DI bf16x8 frag_s(const bf16_t* M, int k, int col, int ld = LD) {
  bf16x8 v;
#pragma unroll
  for (int j = 0; j < 8; ++j) v[j] = (short)M[(k + j) * ld + col];
  return v;
}
DI int crow(int reg, int half) { return (reg & 3) + 8 * (reg >> 2) + 4 * half; }
template <bool AC, bool BC>
DI f32x16 mm_tile(const bf16_t* A, const bf16_t* B, int ti, int tj, int lane, f32x16 acc) {
  const int r = lane & 31, h = lane >> 5;
#pragma unroll
  for (int ks = 0; ks < 4; ++ks) {
    const int k = ks * 16 + 8 * h;
    bf16x8 a = AC ? frag_c(A, ti * 32 + r, k) : frag_s(A, k, ti * 32 + r);
    bf16x8 b = BC ? frag_c(B, tj * 32 + r, k) : frag_s(B, k, tj * 32 + r);
    acc = mfma32(a, b, acc);
    __builtin_amdgcn_sched_barrier(0);
  }
  return acc;
}
DI void store_rm_bf16(bf16_t* M, const f32x16& acc, int ti, int tj, int lane) {
  const int c = tj * 32 + (lane & 31), h = lane >> 5;
#pragma unroll
  for (int g = 0; g < 16; ++g) M[(ti * 32 + crow(g, h)) * LD + c] = f2bf(acc[g]);
}
DI void store_tr_bf16(bf16_t* Mt, const f32x16& acc, int ti, int tj, int lane, int ld = LD) {
  const int c = tj * 32 + (lane & 31), h = lane >> 5;
#pragma unroll
  for (int g = 0; g < 4; ++g) {
    u32x2 v;
    v[0] = pack2(acc[4 * g], acc[4 * g + 1]);
    v[1] = pack2(acc[4 * g + 2], acc[4 * g + 3]);
    *(u32x2*)(Mt + c * ld + ti * 32 + 8 * g + 4 * h) = v;
  }
}

DI void phase0(const Params& P, char* smem) {
  const int tid = fresh_tid();
  if (blockIdx.x == 0 && tid < 272) P.cnt[tid] = 0;
  if (blockIdx.x == 1 && tid < 256) P.ones[tid] = 1.f;
  for (int i = blockIdx.x * NTHR + tid; i < L; i += gridDim.x * NTHR) P.ident[i] = i * NSLOT + 8;
  float* red = (float*)smem;
  for (int cb = blockIdx.x; cb < 6144 / 24; cb += gridDim.x) {
    const int n0 = cb * 24;
    if (tid < 504) {
      const int col = tid % 24, ks = tid / 24;
      const int k0 = ks * 49, k1 = (k0 + 49 < 1024) ? k0 + 49 : 1024;
      float s0 = 0.f, s1 = 0.f;
      for (int k = k0; k < k1; ++k) {
        const float w = P.ada_w[(size_t)k * 6144 + n0 + col];
        s0 += siluf(P.c[k]) * w;
        s1 += siluf(P.c_ctx[k]) * w;
      }
      red[(ks * 24 + col) * 2] = s0;
      red[(ks * 24 + col) * 2 + 1] = s1;
    }
    __syncthreads();
    if (tid < 48) {
      const int col = tid >> 1, z = tid & 1;
      float s = 0.f;
      for (int ks = 0; ks < 21; ++ks) s += red[(ks * 24 + col) * 2 + z];
      s += P.ada_b[n0 + col];
      (z ? P.modc : P.mod)[n0 + col] = s;
    }
    __syncthreads();
  }
}

DI void norm_mod_row(const float* src, const float* g, const float* shift, const float* scale, bf16_t* dst, int lane) {
  f32x4 v[4];
  float ss = 0.f;
#pragma unroll
  for (int i = 0; i < 4; ++i) {
    v[i] = *(const f32x4*)(src + i * 256 + lane * 4);
    ss += v[i][0] * v[i][0] + v[i][1] * v[i][1] + v[i][2] * v[i][2] + v[i][3] * v[i][3];
  }
  ss = wave_sum(ss);
  const float rs = __builtin_amdgcn_rsqf(ss * (1.f / 1024.f) + 1e-6f);
#pragma unroll
  for (int i = 0; i < 4; ++i) {
    const int c = i * 256 + lane * 4;
    const f32x4 gg = *(const f32x4*)(g + c), sh = *(const f32x4*)(shift + c), sc = *(const f32x4*)(scale + c);
    float o[4];
#pragma unroll
    for (int j = 0; j < 4; ++j) o[j] = v[i][j] * rs * gg[j] * (1.f + sc[j]) + sh[j];
    u32x2 w;
    w[0] = pack2(o[0], o[1]);
    w[1] = pack2(o[2], o[3]);
    *(u32x2*)(dst + c) = w;
  }
}
DI void phase1(const Params& P) {
  const int tid_ = fresh_tid();
  const int wid = tid_ >> 6, lane = tid_ & 63;
  for (int row = blockIdx.x * 8 + wid; row < LT; row += gridDim.x * 8) {
    if (row < L) norm_mod_row(P.x + (size_t)row * D, P.norm1_g, P.mod, P.mod + 1024, P.hx + (size_t)row * D, lane);
    else norm_mod_row(P.ctx + (size_t)(row - L) * D, P.norm1_g, P.modc, P.modc + 1024, P.hx + (size_t)row * D, lane);
  }
}
DI void phase7(const Params& P) {
  const int tid_ = fresh_tid();
  const int wid = tid_ >> 6, lane = tid_ & 63;
  for (int row = blockIdx.x * 8 + wid; row < L; row += gridDim.x * 8)
    norm_mod_row(P.x1 + (size_t)row * D, P.norm2_g, P.mod + 3072, P.mod + 4096, P.h2 + (size_t)row * D, lane);
}


DI void prep_dense(const Params& P, char* smem) {
  constexpr int T_WIN = (PIN / 64) * 16, T_WOUT = 16 * 16, T_RS = 12 * 16, T_G = 16;
  for (int u = blockIdx.x; u < T_WIN + T_WOUT + T_RS + T_G; u += gridDim.x) {
    if (u < T_WIN) {
      const int rt = u >> 4, kt = u & 15;
      transpose_tile(smem, PINW, P.winT, D, kt * 64, rt * 64, [&](int rho) -> const float* { return rho < PINW ? P.w_in + (rho & ~31) + perm32(rho & 31) : nullptr; });
    } else if (u < T_WIN + T_WOUT) {
      const int v = u - T_WIN, rt = v >> 4, kt = v & 15;
      transpose_tile(smem, D, P.woutT, D, kt * 64, rt * 64, [&](int rho) -> const float* { return P.w_out + rho; });
    } else if (u >= T_WIN + T_WOUT + T_RS) {
      const int v = u - T_WIN - T_WOUT - T_RS, rt = v >> 1, kt = v & 1;
      transpose_tile(smem, 512, P.gateT, 128, kt * 64, rt * 64, [&](int rho) -> const float* { return P.gate_up + rho; });
    } else {
      const int v = u - T_WIN - T_WOUT, rt = v >> 4, kt = v & 15;
      transpose_tile(smem, 256, P.rsT, D, kt * 64, rt * 64, [&](int rho) -> const float* {
        if (rho < 256) return P.router_w + rho;
        int z; const int col = swiglu_col(rho - 256, z);
        return (z ? P.sh_w3 : P.sh_w1) + col;
      });
    }
  }
}

struct SchedP2 : g8::DenseOrder {
  static constexpr int PF_LINES = 0;
  DI void pf(const g8::Unit2&, LAS unsigned char*, int) const {}
  DI void aoffs_late(const g8::Unit2& u, LAS unsigned char*, int, int R0, int R1, int C0, int C1, unsigned (&o)[2][2]) const { aoffs(u, R0, R1, C0, C1, o); }
  const Params* P;
  DI const char* abase() const { return (const char*)P->hx; }
  DI const char* bbase(const g8::Unit2& u) const { return (const char*)(P->winT + (size_t)u.pn * 256 * D); }
  DI void aoffs(const g8::Unit2& u, int R0, int R1, int C0, int C1, unsigned (&o)[2][2]) const {
#pragma unroll
    for (int h = 0; h < 2; ++h) {
      o[h][0] = (unsigned)(((u.pm * 256 + h * 128 + R0) * D + C0) * 2);
      o[h][1] = (unsigned)(((u.pm * 256 + h * 128 + R1) * D + C1) * 2);
    }
  }
};
DI void phase2(const Params& P, char* smem) {
  if ((int)blockIdx.x >= (int)gridDim.x - NW2) { prep_dyn(P, smem, B2); return; }
  SchedP2 S; S.init(LT / 256, PIN / 256, gridDim.x - NW2, blockIdx.x); S.P = &P;
  g8::gemm<g8::Unit2>((LAS unsigned char*)smem, S,
      [&](const g8::Acc& acc, const g8::Unit2& u, int wr, int wc, int fr, int fq, int) {
#pragma unroll
        for (int ai = 0; ai < 2; ++ai)
#pragma unroll
          for (int m = 0; m < 4; ++m) {
            bf16_t* rowp = P.p + (size_t)(u.pm * 256 + ai * 128 + wr * 64 + m * 16 + fr) * PIN + u.pn * 256 + wc * 32 + 8 * fq;
#pragma unroll
            for (int bj = 0; bj < 2; ++bj) {
              const f32x4 v0 = acc[ai][bj][m][0], v1 = acc[ai][bj][m][1];
              u32x4 w;
              w[0] = pack2(v0[0], v0[1]); w[1] = pack2(v0[2], v0[3]); w[2] = pack2(v1[0], v1[1]); w[3] = pack2(v1[2], v1[3]);
              *(u32x4*)(rowp + bj * 128) = w;
            }
          }
      }, D);
}

DI void load_shift16(const Params& P, int t, int lo, int hi, int col, float* o) {
  const bf16_t* pc = P.p + (size_t)t * PIN + col;
  u32x4 c0 = *(const u32x4*)pc, c1 = *(const u32x4*)(pc + 8);
  u32x4 p0 = (u32x4){0, 0, 0, 0}, p1 = p0, n0 = p0, n1 = p0;
  if (t - 1 >= lo) { p0 = *(const u32x4*)(pc - PIN); p1 = *(const u32x4*)(pc - PIN + 8); }
  if (t + 1 < hi) { n0 = *(const u32x4*)(pc + PIN); n1 = *(const u32x4*)(pc + PIN + 8); }
  const float* mu0 = P.shift_mu + (col - PRW0);
  const float* mu1 = P.shift_mu + 1920 + (col - PRW0);
#pragma unroll
  for (int i = 0; i < 16; ++i) {
    const unsigned cw = (i < 8) ? c0[(i & 7) >> 1] : c1[(i & 7) >> 1];
    const unsigned pw = (i < 8) ? p0[(i & 7) >> 1] : p1[(i & 7) >> 1];
    const unsigned nw = (i < 8) ? n0[(i & 7) >> 1] : n1[(i & 7) >> 1];
    const float cv = (i & 1) ? __uint_as_float(cw & 0xFFFF0000u) : __uint_as_float(cw << 16);
    const float pv = (i & 1) ? __uint_as_float(pw & 0xFFFF0000u) : __uint_as_float(pw << 16);
    const float nv = (i & 1) ? __uint_as_float(nw & 0xFFFF0000u) : __uint_as_float(nw << 16);
    o[i] = cv + mu0[i] * (pv - cv) + mu1[i] * (nv - cv);
  }
}


DI void st16_bf16(bf16_t* dst, const float* v) {
  u32x4 a, b;
#pragma unroll
  for (int i = 0; i < 4; ++i) { a[i] = pack2(v[2 * i], v[2 * i + 1]); b[i] = pack2(v[8 + 2 * i], v[8 + 2 * i + 1]); }
  *(u32x4*)dst = a;
  *(u32x4*)(dst + 8) = b;
}

struct ShiftRaw { u32x4 c0, c1, p0, p1, n0, n1; };
DI void shift_raw(const Params& P, int t, int lo, int hi, int col, ShiftRaw& R) {
  const bf16_t* pc = P.p + (size_t)t * PIN + col;
  R.c0 = *(const u32x4*)pc; R.c1 = *(const u32x4*)(pc + 8);
  R.p0 = (u32x4){0, 0, 0, 0}; R.p1 = R.p0; R.n0 = R.p0; R.n1 = R.p0;
  if (t - 1 >= lo) { R.p0 = *(const u32x4*)(pc - PIN); R.p1 = *(const u32x4*)(pc - PIN + 8); }
  if (t + 1 < hi) { R.n0 = *(const u32x4*)(pc + PIN); R.n1 = *(const u32x4*)(pc + PIN + 8); }
}
DI void shift_finish(const Params& P, const ShiftRaw& R, int col, float* o) {
  const float* mu0 = P.shift_mu + (col - PRW0);
  const float* mu1 = P.shift_mu + 1920 + (col - PRW0);
#pragma unroll
  for (int i = 0; i < 16; ++i) {
    const unsigned cw = (i < 8) ? R.c0[(i & 7) >> 1] : R.c1[(i & 7) >> 1];
    const unsigned pw = (i < 8) ? R.p0[(i & 7) >> 1] : R.p1[(i & 7) >> 1];
    const unsigned nw = (i < 8) ? R.n0[(i & 7) >> 1] : R.n1[(i & 7) >> 1];
    const float cv = (i & 1) ? __uint_as_float(cw & 0xFFFF0000u) : __uint_as_float(cw << 16);
    const float pv = (i & 1) ? __uint_as_float(pw & 0xFFFF0000u) : __uint_as_float(pw << 16);
    const float nv = (i & 1) ? __uint_as_float(nw & 0xFFFF0000u) : __uint_as_float(nw << 16);
    o[i] = cv + mu0[i] * (pv - cv) + mu1[i] * (nv - cv);
  }
}


DI void half_barrier(LAS unsigned* ctr, unsigned& gen, int lt) {
  ++gen;
  asm volatile("s_waitcnt lgkmcnt(0)" ::: "memory");
  if ((lt & 63) == 0) (void)__hip_atomic_fetch_add(ctr, 1u, __ATOMIC_RELAXED, __HIP_MEMORY_SCOPE_WORKGROUP);
  const unsigned want = 4u * gen;
  while (__hip_atomic_load(ctr, __ATOMIC_RELAXED, __HIP_MEMORY_SCOPE_WORKGROUP) < want) __builtin_amdgcn_s_sleep(1);
  asm volatile("" ::: "memory");
}
DI void phase3_task(const Params& P, char* hs, int task, int lt, LAS unsigned* hctr, unsigned& hgen, LAS unsigned* hq, int fidx) {
#define HALF_BARRIER() half_barrier(hctr, hgen, lt)
  asm volatile("" : "+v"(lt));
  const int lw = lt >> 6, lane = lt & 63;
  const int cc = task >> 4, dir = (task >> 3) & 1, hd = task & 7;
  const int rb = cc * 64;
  const int lo = (rb < L) ? 0 : L, hi = (rb < L) ? L : LT;
  const int sr = lt >> 2, q4 = lt & 3, cseg = q4 * 16;
  const int trow = rb + (dir ? 63 - sr : sr);
  const int ti = lw >> 1, tj = lw & 1;
  bf16_t* slot[8];
#pragma unroll
  for (int i = 0; i < 8; ++i) slot[i] = (bf16_t*)(hs + i * SLOT);
  float* gC = (float*)(hs + 8 * SLOT);
  float* Dout = (float*)(hs + 4 * SLOT);
  float* Aout = (float*)(hs + 6 * SLOT);
  float* Wl = (float*)(hs);

  {
    ShiftRaw rw, ra;
    shift_raw(P, trow, lo, hi, 3072 + 64 * dir + cseg, rw);
    shift_raw(P, trow, lo, hi, 3200 + 64 * dir + cseg, ra);
    const float* du = P.decay_up + ((size_t)(dir * 64 + sr)) * 512 + 64 * hd + cseg;
    const float* iu = P.iclr_up + ((size_t)(dir * 64 + sr)) * 512 + 64 * hd + cseg;
    f32x4 dq[4], iq[4];
#pragma unroll
    for (int i = 0; i < 4; ++i) { dq[i] = *(const f32x4*)(du + 4 * i); iq[i] = *(const f32x4*)(iu + 4 * i); }
    float tmp[16];
    shift_finish(P, rw, 3072 + 64 * dir + cseg, tmp);
#pragma unroll
    for (int i = 0; i < 16; ++i) tmp[i] = tanh_(tmp[i]);
    st16_bf16(slot[0] + sr * LD + cseg, tmp);
    shift_finish(P, ra, 3200 + 64 * dir + cseg, tmp);
    st16_bf16(slot[1] + sr * LD + cseg, tmp);
#pragma unroll
    for (int i = 0; i < 4; ++i) { tmp[4 * i] = dq[i][0]; tmp[4 * i + 1] = dq[i][1]; tmp[4 * i + 2] = dq[i][2]; tmp[4 * i + 3] = dq[i][3]; }
    st16_bf16(slot[2] + sr * LD + cseg, tmp);
#pragma unroll
    for (int i = 0; i < 4; ++i) { tmp[4 * i] = iq[i][0]; tmp[4 * i + 1] = iq[i][1]; tmp[4 * i + 2] = iq[i][2]; tmp[4 * i + 3] = iq[i][3]; }
    st16_bf16(slot[3] + sr * LD + cseg, tmp);
  }
  HALF_BARRIER();
  {
    f32x16 a1 = mm_tile<true, false>(slot[0], slot[2], ti, tj, lane, zero16());
    f32x16 a2 = mm_tile<true, false>(slot[1], slot[3], ti, tj, lane, zero16());
    const int c = tj * 32 + (lane & 31), h = lane >> 5;
#pragma unroll
    for (int g = 0; g < 16; ++g) {
      Dout[(ti * 32 + crow(g, h)) * 65 + c] = a1[g];
      Aout[(ti * 32 + crow(g, h)) * 65 + c] = a2[g];
    }
  }
  HALF_BARRIER();
  float aa[16];
#pragma unroll
  for (int i = 0; i < 16; ++i) {
    const int ch = dir * 512 + 64 * hd + cseg + i;
    const float d = P.decay_w0[ch] + Dout[sr * 65 + cseg + i];
    Wl[sr * 65 + cseg + i] = __expf(-0.6065306597126334f * sigm(d));
    aa[i] = sigm(P.iclr_a0[ch] + Aout[sr * 65 + cseg + i]);
  }
  HALF_BARRIER();
  ShiftRaw rk, rr_;
  shift_raw(P, trow, lo, hi, PRW0 + 512 + 64 * hd + cseg, rk);
  shift_raw(P, trow, lo, hi, PRW0 + 64 * hd + cseg, rr_);
  {
    const int c = lt >> 2, seg = lt & 3;
    float w[16];
#pragma unroll
    for (int i = 0; i < 16; ++i) w[i] = Wl[(seg * 16 + i) * 65 + c];
#pragma unroll
    for (int i = 1; i < 16; ++i) w[i] *= w[i - 1];
    const float tot = w[15];
    const float t0 = __shfl(tot, (lt & 63 & ~3) + 0), t1 = __shfl(tot, (lt & 63 & ~3) + 1), t2 = __shfl(tot, (lt & 63 & ~3) + 2);
    const float pre = (seg == 0) ? 1.f : (seg == 1) ? t0 : (seg == 2) ? t0 * t1 : t0 * t1 * t2;
    HALF_BARRIER();
#pragma unroll
    for (int i = 0; i < 16; ++i) Wl[(seg * 16 + i) * 65 + c] = w[i] * pre;
  }
  HALF_BARRIER();
  {
    float rr[16], kk[16], vv[16];
    shift_finish(P, rk, PRW0 + 512 + 64 * hd + cseg, kk);
    shift_finish(P, rr_, PRW0 + 64 * hd + cseg, rr);
    load_shift16(P, trow, lo, hi, PRW0 + 1024 + 64 * hd + cseg, vv);
    float nrm = 0.f, bsum = 0.f;
#pragma unroll
    for (int i = 0; i < 16; ++i) {
      const float kap = kk[i] * P.key_xi[dir * 512 + 64 * hd + cseg + i];
      nrm += kap * kap;
    }
    nrm += __shfl_xor(nrm, 1);
    nrm += __shfl_xor(nrm, 2);
    const float rn = __builtin_amdgcn_rsqf(nrm + 1e-12f);
    {
      const int o = sr * LD + cseg;
#pragma unroll
      for (int h8 = 0; h8 < 2; ++h8) {
        float xi[8], al[8], rho[8];
#pragma unroll
        for (int i = 0; i < 2; ++i) {
          const f32x4 a = *(const f32x4*)(P.key_xi + dir * 512 + 64 * hd + cseg + 8 * h8 + 4 * i);
          const f32x4 b = *(const f32x4*)(P.key_alpha + dir * 512 + 64 * hd + cseg + 8 * h8 + 4 * i);
          const f32x4 c = *(const f32x4*)(P.bonus_rho + 64 * hd + cseg + 8 * h8 + 4 * i);
#pragma unroll
          for (int j = 0; j < 4; ++j) { xi[4 * i + j] = a[j]; al[4 * i + j] = b[j]; rho[4 * i + j] = c[j]; }
        }
        u32x4 wKp, wBp, wKt, wRp, wV;
#pragma unroll
        for (int p2 = 0; p2 < 4; ++p2) {
          float vKp[2], vBp[2], vKt[2], vRp[2];
#pragma unroll
          for (int e2 = 0; e2 < 2; ++e2) {
            const int i8 = 2 * p2 + e2, i = 8 * h8 + i8;
            const float gsv = Wl[sr * 65 + cseg + i];
            const float gpv = (sr > 0) ? Wl[(sr - 1) * 65 + cseg + i] : 1.f;
            const float kh = kk[i] * xi[i8] * rn;
            const float kt = kk[i] * (1.f + (aa[i] - 1.f) * al[i8]);
            const float bq = aa[i] * kh;
            const float ig = __builtin_amdgcn_rcpf(gsv);
            bsum += rr[i] * rho[i8] * kt;
            vKp[e2] = gpv * kh; vBp[e2] = bq * ig; vKt[e2] = kt * ig; vRp[e2] = gsv * rr[i];
            if (sr == 63) gC[cseg + i] = gsv;
          }
          wKp[p2] = pack2(vKp[0], vKp[1]); wBp[p2] = pack2(vBp[0], vBp[1]); wKt[p2] = pack2(vKt[0], vKt[1]); wRp[p2] = pack2(vRp[0], vRp[1]);
          wV[p2] = pack2(vv[8 * h8 + 2 * p2], vv[8 * h8 + 2 * p2 + 1]);
        }
        *(u32x4*)(slot[2] + o + 8 * h8) = wKp;
        *(u32x4*)(slot[3] + o + 8 * h8) = wBp;
        *(u32x4*)(slot[4] + o + 8 * h8) = wKt;
        *(u32x4*)(slot[5] + o + 8 * h8) = wRp;
        *(u32x4*)(slot[6] + o + 8 * h8) = wV;
      }
    }
    bsum += __shfl_xor(bsum, 1);
    bsum += __shfl_xor(bsum, 2);
    if (q4 == 0 && cc < 256) P.bon[((size_t)dir * L + trow) * 8 + hd] = bsum;
  }
  HALF_BARRIER();
  {
    f32x16 m2 = mm_tile<true, true>(slot[2], slot[3], ti, tj, lane, zero16());
    f32x16 m1 = mm_tile<true, true>(slot[2], slot[4], ti, tj, lane, zero16());
    const int c = tj * 32 + (lane & 31), h = lane >> 5;
#pragma unroll
    for (int g = 0; g < 16; ++g) {
      const int r = ti * 32 + crow(g, h);
      m2[g] = (r > c) ? m2[g] : 0.f;
      m1[g] = (r > c) ? m1[g] : 0.f;
    }
    store_rm_bf16(slot[0], m2, ti, tj, lane);
    store_rm_bf16(slot[7], m1, ti, tj, lane);
  }
  HALF_BARRIER();
  f32x16 x1 = mm_tile<true, false>(slot[7], slot[6], ti, tj, lane, zero16());
  HALF_BARRIER();
  store_tr_bf16(slot[7], x1, ti, tj, lane);
  if (lw == 0) {
    const int hb = lane >> 5, j = lane & 31, o = hb * 32;
    const bf16_t* M2b = slot[0];
    bf16_t* Tb = slot[1];
    float t[32];
#pragma unroll
    for (int s = 0; s < 32; ++s) {
      float a = (s == j) ? 1.f : 0.f;
#pragma unroll
      for (int i = 0; i < s; ++i) a -= bf2f(M2b[(o + s) * LD + o + i]) * t[i];
      t[s] = a;
    }
#pragma unroll
    for (int s = 0; s < 32; ++s) Tb[(o + s) * LD + o + j] = f2bf(t[s]);
    f32x16 xx = zero16();
    {
      const int r = lane & 31, h = lane >> 5;
#pragma unroll
      for (int ks = 0; ks < 2; ++ks) {
        const int k = ks * 16 + 8 * h;
        xx = mfma32(frag_c(M2b, 32 + r, k), frag_s(Tb, k, r), xx);
      }
#pragma unroll
      for (int g = 0; g < 4; ++g) {
        u32x2 v;
        v[0] = pack2(xx[4 * g], xx[4 * g + 1]);
        v[1] = pack2(xx[4 * g + 2], xx[4 * g + 3]);
        *(u32x2*)(Tb + r * LD + 32 + 8 * g + 4 * h) = v;
      }
      f32x16 t21 = zero16();
#pragma unroll
      for (int ks = 0; ks < 2; ++ks) {
        const int k = ks * 16 + 8 * h;
        t21 = mfma32(frag_c(Tb, 32 + r, 32 + k), frag_c(Tb, r, 32 + k), t21);
      }
#pragma unroll
      for (int g = 0; g < 16; ++g) Tb[(32 + crow(g, h)) * LD + r] = f2bf(-t21[g]);
#pragma unroll
      for (int g = 0; g < 16; ++g) Tb[(g + 16 * h) * LD + 32 + r] = 0;
    }
  }
  HALF_BARRIER();
  f32x16 wm = mm_tile<true, false>(slot[1], slot[2], ti, tj, lane, zero16());
  f32x16 uu = mm_tile<true, true>(slot[1], slot[7], ti, tj, lane, zero16());
  HALF_BARRIER();
  {
    store_tr_bf16(slot[2], wm, ti, tj, lane);
    store_tr_bf16(slot[7], uu, ti, tj, lane);
    f32x16 q1 = mm_tile<true, true>(slot[5], slot[4], ti, tj, lane, zero16());
    f32x16 q2 = mm_tile<true, true>(slot[5], slot[3], ti, tj, lane, zero16());
    const int c = tj * 32 + (lane & 31), h = lane >> 5;
#pragma unroll
    for (int g = 0; g < 16; ++g) {
      const int r = ti * 32 + crow(g, h);
      q1[g] = (r >= c) ? q1[g] : 0.f;
      q2[g] = (r >= c) ? q2[g] : 0.f;
    }
    store_rm_bf16(slot[0], q1, ti, tj, lane);
    store_rm_bf16(slot[1], q2, ti, tj, lane);
  }
  HALF_BARRIER();
  {
    unsigned nxt = 0;
    if (lt == 0) nxt = (unsigned)TASK_Q0 + __hip_atomic_fetch_add((GAS unsigned*)P.qh, 1u, __ATOMIC_RELAXED, __HIP_MEMORY_SCOPE_AGENT);
    const int c = tj * 32 + (lane & 31), h = lane >> 5;
    {
      f32x16 gacc = mm_tile<true, false>(slot[2], slot[3], ti, tj, lane, zero16());
      const float gk = gC[c];
      u32x4 w0, w1;
#pragma unroll
      for (int i = 0; i < 4; ++i) {
        const int ga = 2 * i, gb = 2 * i + 1;
        w0[i] = pack2(gk * (((ti * 32 + crow(ga, h) == c) ? 1.f : 0.f) - gacc[ga]), gk * (((ti * 32 + crow(gb, h) == c) ? 1.f : 0.f) - gacc[gb]));
        w1[i] = pack2(gk * (((ti * 32 + crow(8 + ga, h) == c) ? 1.f : 0.f) - gacc[8 + ga]), gk * (((ti * 32 + crow(8 + gb, h) == c) ? 1.f : 0.f) - gacc[8 + gb]));
      }
      const __amdgpu_buffer_rsrc_t gr = __builtin_amdgcn_make_buffer_rsrc((void*)P.gt, 0, NTASK * 8192, 0x00020000);
      const unsigned o = (unsigned)task * 8192u + (unsigned)(((tj * 4 + 2 * ti) * 64 + lane) * 16);
      __builtin_amdgcn_raw_buffer_store_b128(w0, gr, (int)o, 0, 16);
      __builtin_amdgcn_raw_buffer_store_b128(w1, gr, (int)(o + 1024u), 0, 16);
    }
    __builtin_amdgcn_sched_barrier(0);
    {
      f32x16 h1 = mm_tile<false, false>(slot[4], slot[6], ti, tj, lane, zero16());
      f32x16 h2 = mm_tile<false, true>(slot[3], slot[7], ti, tj, lane, zero16());
      const __amdgpu_buffer_rsrc_t hr = __builtin_amdgcn_make_buffer_rsrc((void*)P.ht, 0, NTASK * 16384, 0x00020000);
      const unsigned o = (unsigned)task * 16384u + (unsigned)((((ti * 2 + tj) * 4) * 64 + lane) * 16);
#pragma unroll
      for (int q = 0; q < 4; ++q) {
        f32x4 v;
#pragma unroll
        for (int e = 0; e < 4; ++e) v[e] = gC[ti * 32 + crow(4 * q + e, h)] * (h1[4 * q + e] - h2[4 * q + e]);
        __builtin_amdgcn_raw_buffer_store_b128(__builtin_bit_cast(u32x4, v), hr, (int)(o + 1024u * q), 0, 16);
      }
    }
    __builtin_amdgcn_sched_barrier(0);
    f32x16 acc = mm_tile<true, true>(slot[1], slot[2], ti, tj, lane, zero16());
    bf16_t* rpp = P.rpp + (size_t)task * 4096;
#pragma unroll
    for (int g = 0; g < 16; ++g) {
      const int r = ti * 32 + crow(g, h);
      const int tt = dir ? 63 - r : r;
      rpp[tt * 64 + c] = f2bf(bf2f(slot[5][r * LD + c]) - acc[g]);
    }
    __builtin_amdgcn_sched_barrier(0);
    f32x16 y1 = mm_tile<true, false>(slot[0], slot[6], ti, tj, lane, zero16());
    f32x16 y2 = mm_tile<true, true>(slot[1], slot[7], ti, tj, lane, zero16());
    float* yl = P.yl + (size_t)task * 4096;
#pragma unroll
    for (int g = 0; g < 16; ++g) {
      const int r = ti * 32 + crow(g, h);
      const int tt = dir ? 63 - r : r;
      yl[tt * 64 + c] = y1[g] - y2[g];
    }
    asm volatile("s_waitcnt vmcnt(0)" ::: "memory");
    if (lt == 0) *hq = nxt;
  }
  HALF_BARRIER();
  if (lt == 0) __hip_atomic_store((GAS unsigned*)(P.flags + fidx), 1u, __ATOMIC_RELAXED, __HIP_MEMORY_SCOPE_AGENT);
}

#undef HALF_BARRIER
DI int p4_task(int n, int dir, int hd) {
  int cc;
  if (dir == 0) cc = (n < 4) ? 256 + n : n - 4;
  else cc = 259 - n;
  return cc * 16 + dir * 8 + hd;
}
DI void p3_dyn(const Params& P, char* smem, int first_q) {
  const int half = __builtin_amdgcn_readfirstlane(fresh_tid() >> 8);
  char* hs = smem + half * (8 * SLOT + 256);
  LAS unsigned* hctr = (LAS unsigned*)(smem + 2 * (8 * SLOT + 256) + 64 * half);
  LAS unsigned* hq = hctr + 4;
  if ((fresh_tid() & 255) == 0) {
    *hctr = 0u;
    *hq = (first_q >= 0) ? (unsigned)(first_q + half) : (unsigned)TASK_Q0 + __hip_atomic_fetch_add((GAS unsigned*)P.qh, 1u, __ATOMIC_RELAXED, __HIP_MEMORY_SCOPE_AGENT);
  }
  unsigned hgen = 0;
  __syncthreads();
  unsigned cur = __builtin_amdgcn_readfirstlane(*hq);
  while (cur < (unsigned)NTASK) {
    const int n = (int)(cur >> 4), combo = (int)(cur & 15u);
    phase3_task(P, hs, p4_task(n, combo >> 3, combo & 7), fresh_tid() & 255, hctr, hgen, hq, combo * FSTR + n);
    cur = __builtin_amdgcn_readfirstlane(*hq);
  }
  __syncthreads();
}

struct P4Buf { bf16x8 g[4]; f32x16 h; unsigned pend; int pbase; };
struct P4Poll { int ready; unsigned spins; };
DI void p4_poll_take(P4Poll& Q, unsigned pend, int pbase, int lane) {
  const unsigned long long m = __ballot(pend != 0u && pbase + lane < NCH);
  const int cnt = (~m == 0ull) ? 64 : (__ffsll((long long)~m) - 1);
  const int r = __builtin_amdgcn_readfirstlane(pbase + cnt);
  if (r > Q.ready) Q.ready = r;
}
DI void p4_load(const Params& P, P4Buf& B, P4Poll& Q, int n, int chain, int ti, int tj, int lane) {
  B.pend = 0u; B.pbase = 0;
  if (n >= NCH) return;
  const int task = p4_task(n, chain >> 3, chain & 7);
  const GAS unsigned* fl = (const GAS unsigned*)(P.flags + chain * FSTR) + lane;
  while (Q.ready <= n) {
    const int pb = Q.ready;
    const unsigned pend = __hip_atomic_load(fl + pb, __ATOMIC_RELAXED, __HIP_MEMORY_SCOPE_AGENT);
    p4_poll_take(Q, pend, pb, lane);
    if (Q.ready > n) break;
    if (++Q.spins > (1u << 21)) break;
    __builtin_amdgcn_s_sleep(2);
  }
  asm volatile("" ::: "memory");
  B.pbase = Q.ready;
  B.pend = __hip_atomic_load(fl + Q.ready, __ATOMIC_RELAXED, __HIP_MEMORY_SCOPE_AGENT);
  const __amdgpu_buffer_rsrc_t gr = __builtin_amdgcn_make_buffer_rsrc((void*)P.gt, 0, NTASK * 8192, 0x00020000);
  const __amdgpu_buffer_rsrc_t hr = __builtin_amdgcn_make_buffer_rsrc((void*)P.ht, 0, NTASK * 16384, 0x00020000);
  const unsigned og = (unsigned)task * 8192u + (unsigned)(((ti * 4) * 64 + lane) * 16);
  const unsigned oh = (unsigned)task * 16384u + (unsigned)((((ti * 2 + tj) * 4) * 64 + lane) * 16);
#pragma unroll
  for (int ks = 0; ks < 4; ++ks) B.g[ks] = __builtin_bit_cast(bf16x8, __builtin_amdgcn_raw_buffer_load_b128(gr, (int)(og + 1024u * ks), 0, 16));
#pragma unroll
  for (int q = 0; q < 4; ++q) {
    const f32x4 v = __builtin_bit_cast(f32x4, __builtin_amdgcn_raw_buffer_load_b128(hr, (int)(oh + 1024u * q), 0, 16));
    B.h[4 * q] = v[0]; B.h[4 * q + 1] = v[1]; B.h[4 * q + 2] = v[2]; B.h[4 * q + 3] = v[3];
  }
}
DI void p4_step(const Params& P, const P4Buf& B, P4Poll& Q, bf16_t* Scur, bf16_t* Snext, int n, int dir, int hd, int tid, int ti, int tj, int lane) {
  const int task = p4_task(n, dir, hd);
  const int r = lane & 31, h = lane >> 5;
  {
    const int v = tid >> 2, sg = (tid & 3) * 16;
    u32x4 a = *(const u32x4*)(Scur + v * LD + sg), b = *(const u32x4*)(Scur + v * LD + sg + 8);
    bf16_t* dst = P.s0 + (size_t)task * 4096 + v * 64 + sg;
    *(u32x4*)dst = a;
    *(u32x4*)(dst + 8) = b;
  }
  f32x16 acc = B.h;
#pragma unroll
  for (int ks = 0; ks < 4; ++ks) {
    const bf16_t* sp = Scur + (tj * 32 + r) * LD + 16 * ks + 4 * h;
    const u32x2 lo = *(const u32x2*)sp, hi = *(const u32x2*)(sp + 8);
    u32x4 bb; bb[0] = lo[0]; bb[1] = lo[1]; bb[2] = hi[0]; bb[3] = hi[1];
    acc = mfma32(B.g[ks], __builtin_bit_cast(bf16x8, bb), acc);
  }
  store_tr_bf16(Snext, acc, ti, tj, lane);
  p4_poll_take(Q, B.pend, B.pbase, lane);
}
DI void scan_chains(const Params& P, char* smem) {
  const int tid = fresh_tid();
  const int chain = blockIdx.x, dir = chain >> 3, hd = chain & 7;
  bf16_t* S0b = (bf16_t*)smem;
  bf16_t* S1b = (bf16_t*)(smem + SLOT);
  const int lw = tid >> 6, lane = tid & 63, ti = lw >> 1, tj = lw & 1;
  const bool work = tid < 256;
  P4Poll Q; Q.ready = 0; Q.spins = 0u;
  if (work) {
    for (int i = tid; i < 64 * LD; i += 256) S0b[i] = 0;
  }
  P4Buf B0, B1, B2, B3;
  if (work) {
    p4_load(P, B0, Q, 0, chain, ti, tj, lane);
    p4_load(P, B1, Q, 1, chain, ti, tj, lane);
    p4_load(P, B2, Q, 2, chain, ti, tj, lane);
    p4_load(P, B3, Q, 3, chain, ti, tj, lane);
  }
  __syncthreads();
  for (int n = 0; n < NCH; n += 4) {
    if (work) { p4_step(P, B0, Q, S0b, S1b, n, dir, hd, tid, ti, tj, lane); p4_load(P, B0, Q, n + 4, chain, ti, tj, lane); }
    __syncthreads();
    if (work) { p4_step(P, B1, Q, S1b, S0b, n + 1, dir, hd, tid, ti, tj, lane); p4_load(P, B1, Q, n + 5, chain, ti, tj, lane); }
    __syncthreads();
    if (work) { p4_step(P, B2, Q, S0b, S1b, n + 2, dir, hd, tid, ti, tj, lane); p4_load(P, B2, Q, n + 6, chain, ti, tj, lane); }
    __syncthreads();
    if (work) { p4_step(P, B3, Q, S1b, S0b, n + 3, dir, hd, tid, ti, tj, lane); p4_load(P, B3, Q, n + 7, chain, ti, tj, lane); }
    __syncthreads();
  }
}

DI void phase34(const Params& P, char* smem) {
  const int b = blockIdx.x;
  if (b < 16) {
    scan_chains(P, smem);
    prep_dyn(P, smem, 1 << 20);
  } else if (b < 16 + NPREPB) {
    prep_dyn(P, smem, 1 << 20);
    p3_dyn(P, smem, -1);
  } else {
    p3_dyn(P, smem, (b - 16 - NPREPB) * 2);
    prep_dyn(P, smem, 1 << 20);
  }
}

DI void unpack8(const u32x4& w, float* o) {
#pragma unroll
  for (int i = 0; i < 4; ++i) { o[2 * i] = __uint_as_float(w[i] << 16); o[2 * i + 1] = __uint_as_float(w[i] & 0xFFFF0000u); }
}
DI void phase5(const Params& P, char* smem) {
  bf16_t* SG = (bf16_t*)smem;
  bf16_t* VS = (bf16_t*)(smem + 17408);
  float* BON = (float*)(smem + 17408 + 66560);
  constexpr int LG = 136, LV = 520;
  for (int cc = blockIdx.x; cc < 256; cc += gridDim.x) {
    const int tid = fresh_tid();
    const int wid = __builtin_amdgcn_readfirstlane(tid >> 6);
    const int rb = cc * 64;
    {
      const int c = (tid & 63) * 8, t0 = (tid >> 6) * 8;
      float z[10][8];
#pragma unroll
      for (int i = 0; i < 10; ++i) {
        const int t = t0 - 1 + i;
        if (t >= 0 && t < 64) {
          const bf16_t* pr = P.p + (size_t)(rb + t) * PIN + c;
          float cg[8], vv[8];
          unpack8(*(const u32x4*)(pr + 512), cg);
          unpack8(*(const u32x4*)(pr + 1024), vv);
#pragma unroll
          for (int j = 0; j < 8; ++j) z[i][j] = cg[j] * vv[j];
        } else {
#pragma unroll
          for (int j = 0; j < 8; ++j) z[i][j] = 0.f;
        }
      }
      float w0[8], w1[8], w2[8];
#pragma unroll
      for (int j = 0; j < 8; ++j) { w0[j] = P.conv_w[c + j]; w1[j] = P.conv_w[512 + c + j]; w2[j] = P.conv_w[1024 + c + j]; }
#pragma unroll
      for (int i = 0; i < 8; ++i) {
        float bg[8];
        unpack8(*(const u32x4*)(P.p + (size_t)(rb + t0 + i) * PIN + c), bg);
        u32x4 o;
#pragma unroll
        for (int j = 0; j < 4; ++j) {
          const float y0 = bg[2 * j] * (w0[2 * j] * z[i][2 * j] + w1[2 * j] * z[i + 1][2 * j] + w2[2 * j] * z[i + 2][2 * j]);
          const float y1 = bg[2 * j + 1] * (w0[2 * j + 1] * z[i][2 * j + 1] + w1[2 * j + 1] * z[i + 1][2 * j + 1] + w2[2 * j + 1] * z[i + 2][2 * j + 1]);
          o[j] = pack2(y0, y1);
        }
        *(u32x4*)(P.mixin + (size_t)(rb + t0 + i) * D + c) = o;
      }
    }
    {
      float tmp[16];
      const int row = tid >> 3, cs = (tid & 7) * 16;
      ShiftRaw rg, rq[4];
      shift_raw(P, rb + row, 0, L, 3328 + cs, rg);
#pragma unroll
      for (int q = 0; q < 4; ++q) shift_raw(P, rb + row, 0, L, PRW0 + 1024 + (tid & 7) * 64 + q * 16, rq[q]);
      shift_finish(P, rg, 3328 + cs, tmp);
#pragma unroll
      for (int i = 0; i < 16; ++i) tmp[i] = sigm(tmp[i]);
      st16_bf16(SG + row * LG + cs, tmp);
#pragma unroll
      for (int q = 0; q < 4; ++q) {
        const int vc = (tid & 7) * 64 + q * 16;
        shift_finish(P, rq[q], PRW0 + 1024 + vc, tmp);
        st16_bf16(VS + row * LV + vc, tmp);
      }
      const int t = tid >> 3, hd = tid & 7;
      BON[t * 8 + hd] = P.bon[(size_t)(rb + t) * 8 + hd] + P.bon[((size_t)L + rb + t) * 8 + hd];
    }
    __syncthreads();
    const int hd = wid;
#pragma unroll 1
    for (int ti = 0; ti < 2; ++ti) {
      int lane = tid & 63;
      asm volatile("" : "+v"(lane));
      const int r = lane & 31, h = lane >> 5;
      f32x16 y[2], gg[2];
#pragma unroll
      for (int tj = 0; tj < 2; ++tj) {
        f32x16 acc;
        const int c = tj * 32 + r;
        const float* yl0 = P.yl + (size_t)(cc * 16 + hd) * 4096;
        const float* yl1 = P.yl + (size_t)(cc * 16 + 8 + hd) * 4096;
#pragma unroll
        for (int g = 0; g < 16; ++g) {
          const int row = ti * 32 + crow(g, h);
          acc[g] = yl0[row * 64 + c] + yl1[row * 64 + c];
        }
#pragma unroll
        for (int d = 0; d < 2; ++d) {
          const size_t task = (size_t)cc * 16 + d * 8 + hd;
          const bf16_t* rp = P.rpp + task * 4096;
          const bf16_t* s0 = P.s0 + task * 4096;
#pragma unroll
          for (int ks = 0; ks < 4; ++ks) {
            const int k = ks * 16 + 8 * h;
            bf16x8 a = *(const bf16x8*)(rp + (ti * 32 + r) * 64 + k);
            bf16x8 b = *(const bf16x8*)(s0 + (tj * 32 + r) * 64 + k);
            acc = mfma32(a, b, acc);
          }
        }
        y[tj] = acc;
        gg[tj] = zero16();
      }
#pragma unroll
      for (int ks = 0; ks < 8; ++ks) {
        const int k = ks * 16 + 8 * h;
        bf16x8 a = frag_c(SG, ti * 32 + r, k, LG);
#pragma unroll
        for (int tj = 0; tj < 2; ++tj) {
          bf16x8 bfr = *(const bf16x8*)(P.gateT + (size_t)(64 * hd + tj * 32 + r) * 128 + k);
          gg[tj] = mfma32(a, bfr, gg[tj]);
        }
      }
      float gw[2], gb[2];
#pragma unroll
      for (int tj = 0; tj < 2; ++tj) {
        const int ch = 64 * hd + tj * 32 + r;
        gw[tj] = P.gn_w[ch];
        gb[tj] = P.gn_b[ch];
      }
#pragma unroll
      for (int g = 0; g < 16; ++g) {
        float sacc = y[0][g] + y[1][g];
#pragma unroll
        for (int o = 16; o > 0; o >>= 1) sacc += __shfl_xor(sacc, o);
        const float mean = sacc * (1.f / 64.f);
        const float d0 = y[0][g] - mean, d1 = y[1][g] - mean;
        float v = d0 * d0 + d1 * d1;
#pragma unroll
        for (int o = 16; o > 0; o >>= 1) v += __shfl_xor(v, o);
        const float rstd = __builtin_amdgcn_rsqf(v * (1.f / 64.f) + 64e-5f);
        const int tl = ti * 32 + crow(g, h);
        const float bonus = BON[tl * 8 + hd];
#pragma unroll
        for (int tj = 0; tj < 2; ++tj) {
          const int ch = 64 * hd + tj * 32 + r;
          const float vs = bf2f(VS[tl * LV + ch]);
          const float dn = (tj ? d1 : d0) * rstd * gw[tj] + gb[tj];
          P.mixin[(size_t)(rb + tl) * D + 512 + ch] = f2bf((dn + bonus * vs) * gg[tj][g]);
        }
      }
    }
    __syncthreads();
  }
}

struct SchedRows : g8::DenseOrder {
  static constexpr int PF_LINES = 0;
  DI void pf(const g8::Unit2&, LAS unsigned char*, int) const {}
  DI void aoffs_late(const g8::Unit2& u, LAS unsigned char*, int, int R0, int R1, int C0, int C1, unsigned (&o)[2][2]) const { aoffs(u, R0, R1, C0, C1, o); }
  const bf16_t* A; const bf16_t* Bt;
  DI const char* abase() const { return (const char*)A; }
  DI const char* bbase(const g8::Unit2& u) const { return (const char*)(Bt + (size_t)u.pn * 256 * D); }
  DI void aoffs(const g8::Unit2& u, int R0, int R1, int C0, int C1, unsigned (&o)[2][2]) const {
#pragma unroll
    for (int h = 0; h < 2; ++h) {
      o[h][0] = (unsigned)(((u.pm * 256 + h * 128 + R0) * D + C0) * 2);
      o[h][1] = (unsigned)(((u.pm * 256 + h * 128 + R1) * D + C1) * 2);
    }
  }
};
DI void phase6(const Params& P, char* smem) {
  SchedRows S; S.init(L / 256, D / 256, gridDim.x, blockIdx.x); S.A = P.mixin; S.Bt = P.woutT;
  g8::gemm<g8::Unit2>((LAS unsigned char*)smem, S,
      [&](const g8::Acc& acc, const g8::Unit2& u, int wr, int wc, int fr, int fq, int) {
        const float* g1 = P.mod + 2048 + u.pn * 256 + wc * 32 + 4 * fq;
#pragma unroll
        for (int ai = 0; ai < 2; ++ai)
#pragma unroll
          for (int m = 0; m < 4; ++m) {
            const size_t ro = (size_t)(u.pm * 256 + ai * 128 + wr * 64 + m * 16 + fr) * D + u.pn * 256 + wc * 32 + 4 * fq;
#pragma unroll
            for (int bj = 0; bj < 2; ++bj)
#pragma unroll
              for (int n = 0; n < 2; ++n) {
                const f32x4 gv = *(const f32x4*)(g1 + bj * 128 + n * 16);
                const f32x4 xv = *(const f32x4*)(P.x + ro + bj * 128 + n * 16);
                *(f32x4*)(P.x1 + ro + bj * 128 + n * 16) = xv + gv * acc[ai][bj][m][n];
              }
          }
      }, D);
}

DI void phase8(const Params& P, char* smem) {
  if (blockIdx.x >= 192) { prep_dyn(P, smem, B8); return; }
  SchedRows S; S.init(L / 256, 3, gridDim.x, blockIdx.x); S.A = P.h2; S.Bt = P.rsT;
  g8::gemm<g8::Unit2>((LAS unsigned char*)smem, S,
      [&](const g8::Acc& acc, const g8::Unit2& u, int wr, int wc, int fr, int fq, int) {
#pragma unroll
        for (int ai = 0; ai < 2; ++ai)
#pragma unroll
          for (int m = 0; m < 4; ++m) {
            const int row = u.pm * 256 + ai * 128 + wr * 64 + m * 16 + fr;
            if (u.pn == 0) {
              float* rp = P.logits + (size_t)row * NE + wc * 32 + 4 * fq;
#pragma unroll
              for (int bj = 0; bj < 2; ++bj)
#pragma unroll
                for (int n = 0; n < 2; ++n) *(f32x4*)(rp + bj * 128 + n * 16) = acc[ai][bj][m][n];
            } else {
              bf16_t* ap = P.act + ((size_t)row * NSLOT + 8) * DE + (u.pn - 1) * 128 + 4 * fq;
#pragma unroll
              for (int bj = 0; bj < 2; ++bj) {
                const f32x4 a = acc[ai][bj][m][0], bb = acc[ai][bj][m][1];
                u32x2 w;
                w[0] = pack2(siluf(a[0]) * bb[0], siluf(a[1]) * bb[1]);
                w[1] = pack2(siluf(a[2]) * bb[2], siluf(a[3]) * bb[3]);
                *(u32x2*)(ap + 16 * (4 * bj + wc)) = w;
              }
            }
          }
      }, D);
}

DI void phase9(const Params& P) {
  const int tid_ = fresh_tid();
  const int wid = tid_ >> 6, lane = tid_ & 63;
  for (int tok = blockIdx.x * 8 + wid; tok < L; tok += gridDim.x * 8) {
    float sc[4], bs[4];
#pragma unroll
    for (int q = 0; q < 4; ++q) {
      sc[q] = sigm(P.logits[(size_t)tok * NE + q * 64 + lane]);
      bs[q] = sc[q] + P.router_bias[q * 64 + lane];
    }
    int sel_i[8];
    float sel_s[8], ssum = 0.f;
#pragma unroll
    for (int j = 0; j < 8; ++j) {
      float best = bs[0];
      int bq = 0;
#pragma unroll
      for (int q = 1; q < 4; ++q)
        if (bs[q] > best) { best = bs[q]; bq = q; }
      float m = best;
#pragma unroll
      for (int o = 32; o > 0; o >>= 1) m = fmaxf(m, __shfl_xor(m, o));
      const unsigned long long msk = __ballot(best == m);
      const int ol = __ffsll((long long)msk) - 1;
      const int q = __shfl(bq, ol);
      const float cand = (q == 0) ? sc[0] : (q == 1) ? sc[1] : (q == 2) ? sc[2] : sc[3];
      const float s = __shfl(cand, ol);
#pragma unroll
      for (int qq = 0; qq < 4; ++qq) bs[qq] = (lane == ol && q == qq) ? -1e30f : bs[qq];
      sel_i[j] = q * 64 + ol;
      sel_s[j] = s;
      ssum += s;
    }
    const float inv = 2.5f / ssum;
    int my_e = 0;
    float my_g = 0.f;
#pragma unroll
    for (int j = 0; j < 8; ++j)
      if (lane == j) { my_e = sel_i[j]; my_g = sel_s[j] * inv; }
    if (lane < 8) {
      const int pos = atomicAdd(&P.cnt[my_e], 1);
      P.lid[(size_t)my_e * L + pos] = tok * NSLOT + lane;
      P.lgate[(size_t)my_e * L + pos] = my_g;
    }
  }
}

DI int moe_prefix(const Params& P, int* pre, int tid) {
  if (tid == 0) {
    int s = 0;
    for (int e = 0; e < 257; ++e) {
      pre[e] = s;
      const int c = (e < 256) ? P.cnt[e] : L;
      s += (c + 255) >> 8;
    }
    pre[257] = s;
  }
  __syncthreads();
  return pre[257];
}
DI int find_expert(const int* pre, int mt) {
  int lo = 0, hi = 256;
  while (lo < hi) {
    const int mid = (lo + hi + 1) >> 1;
    if (pre[mid] <= mt) lo = mid; else hi = mid - 1;
  }
  return lo;
}
DI int row_id(const Params& P, int e, int gi, int cnt) {
  const int g = gi < cnt ? gi : cnt - 1;
  return (e < 256) ? P.lid[(size_t)e * L + g] : g * NSLOT + 8;
}

struct UnitM { int e, mt, nt, cnt; };
template <int NN, int NEXP, int KD>
struct SchedMoe {
  static constexpr int PF_LINES = 0;
  const Params* P; const int* pre; int total, G, c;
  const bf16_t* A; const bf16_t* Bt;
  DI bool compute(int i, UnitM& u) const {
    const int U = total * NN, CH = (U + 7) >> 3;
    const int k = (c >> 3) + (G >> 3) * i;
    if (k >= CH) return false;
    const long Lx = (long)(c & 7) * CH + k; if (Lx >= U) return false;
    const int mtg = (int)(Lx / NN); u.nt = (int)(Lx % NN);
    u.e = find_expert(pre, mtg);
    u.mt = mtg - pre[u.e];
    u.cnt = pre[260 + u.e];
    return true;
  }
  DI void tabulate(int tid) const {
    if (tid < 16) {
      UnitM u; u.e = -1; u.mt = 0; u.nt = 0; u.cnt = 0;
      (void)compute(tid, u);
      int* tb = const_cast<int*>(pre) + 800 + tid * 4;
      tb[0] = u.e; tb[1] = u.mt; tb[2] = u.nt; tb[3] = u.cnt;
    }
    __syncthreads();
  }
  DI bool next(int i, UnitM& u) const {
    if (i >= 16) return false;
    const int* tb = pre + 800 + i * 4;
    u.e = __builtin_amdgcn_readfirstlane(tb[0]);
    if (u.e < 0) return false;
    u.mt = __builtin_amdgcn_readfirstlane(tb[1]);
    u.nt = __builtin_amdgcn_readfirstlane(tb[2]);
    u.cnt = __builtin_amdgcn_readfirstlane(tb[3]);
    return true;
  }
  static constexpr int IDS_OFF = 144384;
  DI void pf(const UnitM& u, LAS unsigned char* lds, int buf) const {
    const int tid = fresh_tid(), wid = __builtin_amdgcn_readfirstlane(tid >> 6);
    if (tid < 256) {
      const int gi = u.mt * 256 + tid, gc = gi < u.cnt ? gi : u.cnt - 1;
      const int* src = (u.e < 256) ? P->lid + (size_t)u.e * L + gc : P->ident + gc;
      __builtin_amdgcn_global_load_lds((const unsigned*)src, (LAS unsigned*)(lds + IDS_OFF + buf * 2048 + wid * 256), 4, 0, 0);
      if (KD != D) {
        const float* gs = (u.e < 256) ? P->lgate + (size_t)u.e * L + gc : P->ones;
        __builtin_amdgcn_global_load_lds((const unsigned*)gs, (LAS unsigned*)(lds + IDS_OFF + buf * 2048 + 1024 + wid * 256), 4, 0, 0);
      }
    }
  }
  DI void aoffs_late(const UnitM& u, LAS unsigned char* lds, int buf, int R0, int R1, int C0, int C1, unsigned (&o)[2][2]) const {
    const LAS int* ids = (const LAS int*)(lds + IDS_OFF + buf * 2048);
#pragma unroll
    for (int h = 0; h < 2; ++h) {
      const int i0 = ids[h * 128 + R0], i1 = ids[h * 128 + R1];
      o[h][0] = (unsigned)((KD == D) ? (i0 / NSLOT) : i0) * (unsigned)(KD * 2) + C0 * 2;
      o[h][1] = (unsigned)((KD == D) ? (i1 / NSLOT) : i1) * (unsigned)(KD * 2) + C1 * 2;
    }
  }
  DI const char* abase() const { return (const char*)A; }
  DI const char* bbase(const UnitM& u) const { return (const char*)(Bt + ((size_t)u.e * NN + u.nt) * 256 * KD); }
  DI unsigned arow(const UnitM& u, int r) const {
    const int id = row_id(*P, u.e, u.mt * 256 + r, u.cnt);
    return (unsigned)((KD == D) ? (id / NSLOT) : id) * (unsigned)(KD * 2);
  }
  DI void aoffs(const UnitM& u, int R0, int R1, int C0, int C1, unsigned (&o)[2][2]) const {
#pragma unroll
    for (int h = 0; h < 2; ++h) { o[h][0] = arow(u, h * 128 + R0) + C0 * 2; o[h][1] = arow(u, h * 128 + R1) + C1 * 2; }
  }
};
DI int moe_prefix_n(const Params& P, int* pre, int tid, int nexp) {
  int* tl = pre + 520;
  if (tid < 258) {
    const int c = (tid < 256) ? P.cnt[tid] : L;
    pre[260 + tid] = c;
    tl[tid] = (tid < nexp) ? ((c + 255) >> 8) : 0;
  }
  __syncthreads();
  if (tid < 258) {
    int sacc = 0;
    for (int e = 0; e < tid; ++e) sacc += tl[e];
    pre[tid] = sacc;
  }
  __syncthreads();
  return __builtin_amdgcn_readfirstlane(pre[257]);
}
DI void phase10(const Params& P, char* smem) {
  int* pre = (int*)(smem + 137216);
  SchedMoe<2, 256, D> S;
  S.total = moe_prefix_n(P, pre, fresh_tid(), 256);
  S.P = &P; S.pre = pre; S.G = gridDim.x; S.c = blockIdx.x; S.A = P.h2; S.Bt = P.w13T;
  S.tabulate(fresh_tid());
  g8::gemm<UnitM>((LAS unsigned char*)smem, S,
      [&](const g8::Acc& acc, const UnitM& u, int wr, int wc, int fr, int fq, int buf) {
        const int* IDS = (const int*)(smem + 144384 + buf * 2048);
#pragma unroll
        for (int ai = 0; ai < 2; ++ai)
#pragma unroll
          for (int m = 0; m < 4; ++m) {
            const int gi = u.mt * 256 + ai * 128 + wr * 64 + m * 16 + fr;
            if (gi < u.cnt) {
              bf16_t* ap = P.act + (size_t)IDS[ai * 128 + wr * 64 + m * 16 + fr] * DE + u.nt * 128 + 4 * fq;
#pragma unroll
              for (int bj = 0; bj < 2; ++bj) {
                const f32x4 a = acc[ai][bj][m][0], bb = acc[ai][bj][m][1];
                u32x2 w;
                w[0] = pack2(siluf(a[0]) * bb[0], siluf(a[1]) * bb[1]);
                w[1] = pack2(siluf(a[2]) * bb[2], siluf(a[3]) * bb[3]);
                *(u32x2*)(ap + 16 * (4 * bj + wc)) = w;
              }
            }
          }
      }, D);
}

DI void phase11(const Params& P, char* smem) {
  int* pre = (int*)(smem + 137216);
  SchedMoe<4, 257, DE> S;
  S.total = moe_prefix_n(P, pre, fresh_tid(), 257);
  S.P = &P; S.pre = pre; S.G = gridDim.x; S.c = blockIdx.x; S.A = P.act; S.Bt = P.w2T;
  S.tabulate(fresh_tid());
  g8::gemm<UnitM>((LAS unsigned char*)smem, S,
      [&](const g8::Acc& acc, const UnitM& u, int wr, int wc, int fr, int fq, int buf) {
        const int* IDS = (const int*)(smem + 144384 + buf * 2048);
        const float* GTS = (const float*)(smem + 144384 + buf * 2048 + 1024);
#pragma unroll
        for (int ai = 0; ai < 2; ++ai)
#pragma unroll
          for (int m = 0; m < 4; ++m) {
            const int gi = u.mt * 256 + ai * 128 + wr * 64 + m * 16 + fr;
            if (gi < u.cnt) {
              const int row = ai * 128 + wr * 64 + m * 16 + fr;
              const float gate = GTS[row] * SLAB_SCALE;
              unsigned char* sp = P.slab + (size_t)IDS[row] * D + u.nt * 256 + wc * 64 + 16 * fq;
              u32x4 w;
#pragma unroll
              for (int bj = 0; bj < 2; ++bj)
#pragma unroll
                for (int n = 0; n < 2; ++n) {
                  const f32x4 v = acc[ai][bj][m][n];
                  int q = 0;
                  q = __builtin_amdgcn_cvt_pk_fp8_f32(__builtin_amdgcn_fmed3f(gate * v[0], -440.f, 440.f), __builtin_amdgcn_fmed3f(gate * v[1], -440.f, 440.f), q, false);
                  q = __builtin_amdgcn_cvt_pk_fp8_f32(__builtin_amdgcn_fmed3f(gate * v[2], -440.f, 440.f), __builtin_amdgcn_fmed3f(gate * v[3], -440.f, 440.f), q, true);
                  w[2 * bj + n] = (unsigned)q;
                }
              *(u32x4*)sp = w;
            }
          }
      }, DE);
}

DI void phase12(const Params& P) {
  const int tid_ = fresh_tid();
  const int wid = tid_ >> 6, lane = tid_ & 63;
  const float* g2 = P.mod + 5120;
  for (int row = blockIdx.x * 8 + wid; row < L; row += gridDim.x * 8) {
    float v[2][8];
    float ss = 0.f;
#pragma unroll
    for (int i = 0; i < 2; ++i) {
      const int c = i * 512 + lane * 8;
      float sacc[8];
#pragma unroll
      for (int j = 0; j < 8; ++j) sacc[j] = 0.f;
#pragma unroll
      for (int j = 0; j < NSLOT; ++j) {
        const u32x2 w = __builtin_nontemporal_load((const u32x2*)(P.slab + ((size_t)row * NSLOT + j) * D + c));
#pragma unroll
        for (int e = 0; e < 2; ++e) {
          const f32x2v lo = __builtin_amdgcn_cvt_pk_f32_fp8((int)w[e], false), hi = __builtin_amdgcn_cvt_pk_f32_fp8((int)w[e], true);
          sacc[4 * e] += lo[0]; sacc[4 * e + 1] += lo[1]; sacc[4 * e + 2] += hi[0]; sacc[4 * e + 3] += hi[1];
        }
      }
      const f32x4 x0 = *(const f32x4*)(P.x1 + (size_t)row * D + c), x1v = *(const f32x4*)(P.x1 + (size_t)row * D + c + 4);
      const f32x4 g0 = *(const f32x4*)(g2 + c), g1v = *(const f32x4*)(g2 + c + 4);
#pragma unroll
      for (int j = 0; j < 4; ++j) {
        v[i][j] = x0[j] + g0[j] * (sacc[j] * (1.f / SLAB_SCALE));
        v[i][4 + j] = x1v[j] + g1v[j] * (sacc[4 + j] * (1.f / SLAB_SCALE));
        ss += v[i][j] * v[i][j] + v[i][4 + j] * v[i][4 + j];
      }
    }
    ss = wave_sum(ss);
    const float rs = __builtin_amdgcn_rsqf(ss * (1.f / 1024.f) + 1e-6f);
#pragma unroll
    for (int i = 0; i < 2; ++i) {
      const int c = i * 512 + lane * 8;
      const f32x4 f0 = *(const f32x4*)(P.final_g + c), f1 = *(const f32x4*)(P.final_g + c + 4);
      f32x4 o0, o1;
#pragma unroll
      for (int j = 0; j < 4; ++j) { o0[j] = v[i][j] * rs * f0[j]; o1[j] = v[i][4 + j] * rs * f1[j]; }
      __builtin_nontemporal_store(o0, (f32x4*)(P.out + (size_t)row * D + c));
      __builtin_nontemporal_store(o1, (f32x4*)(P.out + (size_t)row * D + c + 4));
    }
  }
}

__global__ void __launch_bounds__(NTHR) mega(Params P) {
  cg::grid_group grid = cg::this_grid();
  extern __shared__ __attribute__((aligned(16))) char smem[];
  volatile LAS unsigned* xst = (volatile LAS unsigned*)(smem + kDynLds - 16);
  if (threadIdx.x < 4) xst[threadIdx.x] = 0u;
  __syncthreads();
  XcdBarrier xb = xcd_barrier_post(P.bar, xst);
  prep_dense(P, smem);
  phase0(P, smem);
  if (P.coop_probe) grid.sync();
  xcd_barrier(xb);
  phase1(P);
  xcd_barrier(xb);
  phase2(P, smem);
  xcd_barrier(xb);
  phase34(P, smem);
  xcd_barrier(xb);
  phase5(P, smem);
  xcd_barrier(xb);
  phase6(P, smem);
  xcd_barrier(xb);
  phase7(P);
  xcd_barrier(xb);
  phase8(P, smem);
  xcd_barrier(xb);
  phase9(P);
  xcd_barrier(xb);
  phase10(P, smem);
  xcd_barrier(xb);
  phase11(P, smem);
  xcd_barrier(xb);
  phase12(P);
}

extern "C" void kernel_launch(void* const* d_in, const int* in_sizes, int n_in, void* d_out, int out_size, void* d_ws,
                              size_t ws_size, hipStream_t stream) {
  static int grid_blocks = 0;
  if (!grid_blocks) {
    int dev = 0, cus = 0, per_cu = 0;
    (void)hipGetDevice(&dev);
    (void)hipDeviceGetAttribute(&cus, hipDeviceAttributeMultiprocessorCount, dev);
    (void)hipFuncSetAttribute((const void*)mega, hipFuncAttributeMaxDynamicSharedMemorySize, (int)kDynLds);
    (void)hipOccupancyMaxActiveBlocksPerMultiprocessor(&per_cu, mega, NTHR, kDynLds);
    if (per_cu > 1) per_cu = 1;
    grid_blocks = cus * per_cu;
  }
  Params P{};
  const float* const* in = (const float* const*)d_in;
  P.x = in[0]; P.c = in[1]; P.ctx = in[2]; P.c_ctx = in[3]; P.ada_w = in[4]; P.ada_b = in[5]; P.norm1_g = in[6]; P.norm2_g = in[7];
  P.w_in = in[8]; P.conv_w = in[9]; P.shift_mu = in[10]; P.decay_w0 = in[11]; P.decay_up = in[12]; P.iclr_a0 = in[13];
  P.iclr_up = in[14]; P.key_xi = in[15]; P.key_alpha = in[16]; P.bonus_rho = in[17]; P.gate_up = in[18]; P.gn_w = in[19];
  P.gn_b = in[20]; P.w_out = in[21]; P.router_w = in[22]; P.router_bias = in[23]; P.exp_w1 = in[24]; P.exp_w3 = in[25];
  P.exp_w2 = in[26]; P.sh_w1 = in[27]; P.sh_w3 = in[28]; P.sh_w2 = in[29]; P.final_g = in[30];
  P.out = (float*)d_out;
  char* w = (char*)d_ws;
  size_t off = 0;
  auto take = [&](size_t bytes) { char* r = w + off; off += (bytes + 255) & ~(size_t)255; return r; };
  P.mod = (float*)take(6144 * 4);
  P.modc = (float*)take(6144 * 4);
  P.cnt = (int*)take(272 * 4);
  P.bar = (unsigned*)take((XCD_BAR_WORDS + 64 + 16 * FSTR) * 4);
  P.qh = P.bar + XCD_BAR_WORDS;
  P.flags = P.qh + 64;
  P.ident = (int*)take((size_t)L * 4);
  P.ones = (float*)take(1024);
  P.winT = (bf16_t*)take((size_t)PIN * D * 2);
  P.woutT = (bf16_t*)take((size_t)D * D * 2);
  P.rsT = (bf16_t*)take((size_t)768 * D * 2);
  P.gateT = (bf16_t*)take((size_t)512 * 128 * 2);
  P.bon = (float*)take((size_t)2 * L * 8 * 4);
  P.mixin = (bf16_t*)take((size_t)L * D * 2);
  P.w2T = (bf16_t*)take((size_t)257 * D * DE * 2);
  {
    const size_t r1 = off;
    P.hx = (bf16_t*)take((size_t)LT * D * 2);
    P.p = (bf16_t*)take((size_t)LT * PIN * 2 + 65536);
    const size_t r1_end = off;
    off = r1;
    P.x1 = (float*)take((size_t)L * D * 4);
    if (off < r1_end) off = r1_end;
  }
  {
    const size_t r2 = off;
    P.rpp = (bf16_t*)take((size_t)NTASK * 4096 * 2);
    P.yl = (float*)take((size_t)NTASK * 4096 * 4);
    P.gt = (bf16_t*)take((size_t)NTASK * 4096 * 2);
    P.ht = (float*)take((size_t)NTASK * 4096 * 4);
    P.s0 = (bf16_t*)take((size_t)NTASK * 4096 * 2);
    const size_t r2_end = off;
    off = r2;
    P.h2 = (bf16_t*)take((size_t)L * D * 2);
    P.logits = (float*)take((size_t)L * NE * 4);
    P.lid = (int*)take((size_t)NE * L * 4);
    P.lgate = (float*)take((size_t)NE * L * 4);
    P.act = (bf16_t*)take((size_t)L * NSLOT * DE * 2);
    if (off < r2_end) off = r2_end;
  }
  {
    const size_t r4 = off;
    P.w13T = (bf16_t*)take((size_t)256 * 512 * D * 2);
    const size_t r4_end = off;
    off = r4;
    P.slab = (unsigned char*)take((size_t)L * NSLOT * D);
    if (off < r4_end) off = r4_end;
  }
  if (off > ws_size) fprintf(stderr, "workspace too small: need %zu have %zu\n", off, ws_size);
  (void)hipMemsetAsync(P.bar, 0, (XCD_BAR_WORDS + 64 + 16 * FSTR) * 4, stream);
  void* args[] = {&P};
  hipError_t e = hipLaunchCooperativeKernel((void*)mega, dim3(grid_blocks), dim3(NTHR), args, kDynLds, stream);
  if (e != hipSuccess) fprintf(stderr, "cooperative launch failed: %s (grid %d)\n", hipGetErrorString(e), grid_blocks);
}
```

```cpp
#include <hip/hip_runtime.h>
#include <hip/hip_cooperative_groups.h>
#include <cstdio>
#include <cstdint>
namespace cg = cooperative_groups;

#define DI __device__ __forceinline__
__device__ __forceinline__ int fresh_tid() { int t = threadIdx.x; asm volatile("" : "+v"(t)); return t; }
typedef unsigned short bf16_t;
typedef short bf16x8 __attribute__((ext_vector_type(8)));
typedef float f32x4 __attribute__((ext_vector_type(4)));
typedef float f32x16 __attribute__((ext_vector_type(16)));
typedef unsigned u32x4 __attribute__((ext_vector_type(4)));
typedef unsigned u32x2 __attribute__((ext_vector_type(2)));

constexpr int D = 1024, L = 16384, LC = 256, LT = L + LC;
constexpr int PINW = 3456;
constexpr int PIN = 3584, PRW0 = 1536;
constexpr int NE = 256, TOPK = 8, DE = 256;
constexpr int NCH = LT / 64;
constexpr int NTASK = NCH * 16;
constexpr int NSLOT = 9;
constexpr int NTHR = 512;
constexpr size_t kDynLds = 152 * 1024;
constexpr float SLAB_SCALE = 8.f;


struct Params {
  const float *x, *c, *ctx, *c_ctx, *ada_w, *ada_b, *norm1_g, *norm2_g, *w_in, *conv_w, *shift_mu, *decay_w0, *decay_up,
      *iclr_a0, *iclr_up, *key_xi, *key_alpha, *bonus_rho, *gate_up, *gn_w, *gn_b, *w_out, *router_w, *router_bias, *exp_w1,
      *exp_w3, *exp_w2, *sh_w1, *sh_w3, *sh_w2, *final_g;
  float* out;
  float *mod, *modc;
  int* cnt;
  int coop_probe, pad0;
  int* ident; float* ones;
  unsigned* bar;
  unsigned* qh;
  unsigned* flags;
  bf16_t* hx;
  bf16_t *winT, *woutT, *rsT, *w13T, *w2T, *gateT;
  bf16_t* p;
  bf16_t* rpp;
  float* yl;
  bf16_t* gt;
  bf16_t* ht;
  bf16_t* s0;
  float* bon;
  bf16_t* mixin;
  float* x1;
  bf16_t* h2;
  float* logits;
  int* lid;
  float* lgate;
  bf16_t* act;
  unsigned char* slab;
};

DI float bf2f(bf16_t h) { return __uint_as_float(((unsigned)h) << 16); }
typedef float f32x2v __attribute__((ext_vector_type(2)));
typedef __bf16 bf16x2v __attribute__((ext_vector_type(2)));
DI bf16_t f2bf(float f) { return __builtin_bit_cast(unsigned short, (__bf16)f); }
DI unsigned pack2(float lo, float hi) {
  f32x2v v = {lo, hi};
  return __builtin_bit_cast(unsigned, __builtin_convertvector(v, bf16x2v));
}
DI float sigm(float x) { return __builtin_amdgcn_rcpf(1.f + __expf(-x)); }
DI float siluf(float x) { return x * sigm(x); }
DI float tanh_(float x) { return 1.f - 2.f * __builtin_amdgcn_rcpf(1.f + __expf(2.f * x)); }
DI float wave_sum(float v) {
#pragma unroll
  for (int o = 32; o > 0; o >>= 1) v += __shfl_xor(v, o);
  return v;
}


#define XB_TMO      128
#define XB_XCNT(j)  (256  + 64 * (j))
#define XB_XSUB(j)  (1280 + 64 * (j))
#define XB_XGEN(j)  (2304 + 64 * (j))
#define XB_TOP      3328
#define XB_TOPGEN   3392
#define XCD_BAR_WORDS 3456
#define XB_SPIN_CAP (1u << 22)
#define LAS __attribute__((address_space(3)))
#define GAS __attribute__((address_space(1)))
DI unsigned xb_ld(unsigned* p) { return __hip_atomic_load(p, __ATOMIC_RELAXED, __HIP_MEMORY_SCOPE_AGENT); }
DI unsigned xb_add(unsigned* p, unsigned v) { return __hip_atomic_fetch_add(p, v, __ATOMIC_RELAXED, __HIP_MEMORY_SCOPE_AGENT); }
DI unsigned xb_xcc_id() { return (unsigned)__builtin_amdgcn_s_getreg((3 << 11) | 20) & 0xFu; }
#define XB_SPIN(cond, bar) do { unsigned _sp = 0; while (cond) { __builtin_amdgcn_s_sleep(1); \
    if ((++_sp & 255u) == 0u) { if (xb_ld(&(bar)[XB_TMO])) break; if (_sp > XB_SPIN_CAP) { atomicAdd(&(bar)[XB_TMO], 1u); break; } } } } while (0)
struct XcdBarrier { unsigned* bar; unsigned x; volatile LAS unsigned* st; };
DI XcdBarrier xcd_barrier_post(unsigned* bar, volatile LAS unsigned* st) {
  XcdBarrier b; b.bar = bar; b.x = xb_xcc_id(); b.st = st;
  if (threadIdx.x == 0) (void)xb_add(&bar[XB_XCNT(b.x)], 1u);
  return b;
}
DI void xcd_barrier_complete(unsigned* bar, unsigned x, unsigned& nloc, unsigned& nx) {
  const unsigned G = gridDim.x * gridDim.y * gridDim.z;
  unsigned sum, cnt, mine, sp = 0u;
  for (;;) {
    sum = 0u; cnt = 0u; mine = 0u;
#pragma unroll
    for (unsigned j = 0; j < 16; ++j) { const unsigned c = xb_ld(&bar[XB_XCNT(j)]); sum += c; cnt += (c > 0u) ? 1u : 0u; mine = (j == x) ? c : mine; }
    if (sum == G) break;
    __builtin_amdgcn_s_sleep(1);
    if ((++sp & 255u) == 0u) { if (xb_ld(&bar[XB_TMO])) break; if (sp > XB_SPIN_CAP) { atomicAdd(&bar[XB_TMO], 1u); break; } }
  }
  nloc = mine > 0u ? mine : 1u; nx = cnt > 0u ? cnt : 1u;
}
DI void xcd_barrier(const XcdBarrier& b) {
  asm volatile("s_waitcnt vmcnt(0)" ::: "memory");
  __syncthreads();
  if (threadIdx.x == 0) {
    unsigned* bar = b.bar;
    __builtin_amdgcn_s_waitcnt(0);
    unsigned nloc = b.st[0], nx = b.st[1];
    if (nloc == 0u) { xcd_barrier_complete(bar, b.x, nloc, nx); b.st[0] = nloc; b.st[1] = nx; }
    const unsigned old = xb_add(&bar[XB_XSUB(b.x)], 1u);
    const unsigned gen = old / nloc;
    if (old + 1u == (gen + 1u) * nloc) {
      __builtin_amdgcn_fence(__ATOMIC_RELEASE, "agent");
      asm volatile("s_waitcnt vmcnt(0)" ::: "memory");
      const unsigned og = xb_add(&bar[XB_TOP], 1u);
      const unsigned tg = og / nx;
      if (og + 1u == (tg + 1u) * nx) xb_add(&bar[XB_TOPGEN], 1u);
      else XB_SPIN(xb_ld(&bar[XB_TOPGEN]) == tg, bar);
      __builtin_amdgcn_fence(__ATOMIC_ACQUIRE, "agent");
      xb_add(&bar[XB_XGEN(b.x)], 1u);
      asm volatile("s_waitcnt vmcnt(0)" ::: "memory");
    } else {
      XB_SPIN(xb_ld(&bar[XB_XGEN(b.x)]) == gen, bar);
      __builtin_amdgcn_fence(__ATOMIC_ACQUIRE, "agent");
      asm volatile("s_waitcnt vmcnt(0)" ::: "memory");
    }
  }
  __syncthreads();
}

struct GemmAcc { f32x4 a[4][4]; };

struct GStage { u32x4 a0, a1; f32x4 b0, b1; };
DI void g_load(GStage& S, const bf16_t* ap0, const bf16_t* ap1, const float* bp, int ldb, int t, int nt) {
  if (t < nt) {
    S.a0 = *(const u32x4*)(ap0 + t * 32);
    S.a1 = *(const u32x4*)(ap1 + t * 32);
    const float* bn = bp + (size_t)t * 32 * ldb;
    S.b0 = *(const f32x4*)(bn);
    S.b1 = *(const f32x4*)(bn + ldb);
  }
}
DI int swz4(int row) { return (0x78 >> (((row >> 2) & 3) * 2)) & 3; }
DI void g_write(const GStage& S, char* st, int tid, int kq, int ng) {
  {
    const int row = tid >> 2, ch = (tid & 3) ^ swz4(row);
    *(u32x4*)(st + row * 64 + ch * 16) = S.a0;
    *(u32x4*)(st + 8192 + row * 64 + ch * 16) = S.a1;
  }
  const int pc = ((kq >> 2) ^ swz4(4 * ng)) * 4 + (kq & 3);
  unsigned* dst = (unsigned*)(st + 16384) + (4 * ng) * 16 + pc;
  dst[0] = pack2(S.b0[0], S.b1[0]);
  dst[16] = pack2(S.b0[1], S.b1[1]);
  dst[32] = pack2(S.b0[2], S.b1[2]);
  dst[48] = pack2(S.b0[3], S.b1[3]);
}
DI void g_compute(GemmAcc& acc, const char* st, int wr, int wc, int fr, int fq) {
  bf16x8 At[4], Bt[4];
  const int pch = (fq ^ swz4(fr)) * 16;
#pragma unroll
  for (int m = 0; m < 4; ++m) At[m] = *(const bf16x8*)(st + (wr * 64 + m * 16 + fr) * 64 + pch);
#pragma unroll
  for (int n = 0; n < 4; ++n) Bt[n] = *(const bf16x8*)(st + 16384 + (wc * 64 + n * 16 + fr) * 64 + pch);
#pragma unroll
  for (int m = 0; m < 4; ++m)
#pragma unroll
    for (int n = 0; n < 4; ++n) acc.a[m][n] = __builtin_amdgcn_mfma_f32_16x16x32_bf16(At[m], Bt[n], acc.a[m][n], 0, 0, 0);
}
template <class ARow, class BCol, class Epi>
DI void gemm_tile(char* smem, const ARow& arow, const BCol& bcol, int ldb, int K, const Epi& epi) {
  const int tid = fresh_tid(), wid = tid >> 6, lane = tid & 63, wr = wid >> 1, wc = wid & 1, fr = lane & 15, fq = lane >> 4;
  const int ar0 = tid >> 2, ac0 = (tid & 3) * 8;
  const bf16_t* ap0 = arow(ar0) + ac0;
  const bf16_t* ap1 = arow(ar0 + 128) + ac0;
  const int kq = tid & 15, ng = tid >> 4;
  const float* bp = bcol(ng) + (size_t)(2 * kq) * ldb;
  GemmAcc acc;
#pragma unroll
  for (int m = 0; m < 4; ++m)
#pragma unroll
    for (int n = 0; n < 4; ++n) acc.a[m][n] = (f32x4){0.f, 0.f, 0.f, 0.f};
  const int nt = K / 32;
  char* st0 = smem;
  char* st1 = smem + 24576;
  GStage S0, S1, S2;
  g_load(S0, ap0, ap1, bp, ldb, 0, nt);
  g_load(S1, ap0, ap1, bp, ldb, 1, nt);
  g_load(S2, ap0, ap1, bp, ldb, 2, nt);
  g_write(S0, st0, tid, kq, ng);
  g_load(S0, ap0, ap1, bp, ldb, 3, nt);
  __syncthreads();
  for (int t = 0; t < nt; t += 3) {
    {
      char* cur = (t & 1) ? st1 : st0; char* nxt = (t & 1) ? st0 : st1;
      g_compute(acc, cur, wr, wc, fr, fq);
      if (t + 1 < nt) g_write(S1, nxt, tid, kq, ng);
      g_load(S1, ap0, ap1, bp, ldb, t + 4, nt);
      __syncthreads();
    }
    if (t + 1 < nt) {
      char* cur = ((t + 1) & 1) ? st1 : st0; char* nxt = ((t + 1) & 1) ? st0 : st1;
      g_compute(acc, cur, wr, wc, fr, fq);
      if (t + 2 < nt) g_write(S2, nxt, tid, kq, ng);
      g_load(S2, ap0, ap1, bp, ldb, t + 5, nt);
      __syncthreads();
    }
    if (t + 2 < nt) {
      char* cur = ((t + 2) & 1) ? st1 : st0; char* nxt = ((t + 2) & 1) ? st0 : st1;
      g_compute(acc, cur, wr, wc, fr, fq);
      if (t + 3 < nt) g_write(S0, nxt, tid, kq, ng);
      g_load(S0, ap0, ap1, bp, ldb, t + 6, nt);
      __syncthreads();
    }
  }
  epi(acc, wr, wc, fr, fq);
}


template <int NC, class Val, class RowPtr>
DI void epi_bf16_lds(char* smem, int wr, int wc, int fr, int fq, const Val& val, const RowPtr& rowptr) {
  constexpr int LDC = NC + 8;
  bf16_t* T = (bf16_t*)smem;
#pragma unroll
  for (int m = 0; m < 4; ++m)
#pragma unroll
    for (int n = 0; n < NC / 32; ++n)
#pragma unroll
      for (int j = 0; j < 4; ++j) T[(wr * 64 + m * 16 + fq * 4 + j) * LDC + wc * (NC / 2) + n * 16 + fr] = f2bf(val(m, n, j));
  __syncthreads();
  constexpr int CPR = NC / 8;
  constexpr int RPI = NTHR / CPR;
  const int tid = fresh_tid(), ch = tid % CPR, r0 = tid / CPR;
#pragma unroll 4
  for (int it = 0; it < 256 / RPI; ++it) {
    const int r = it * RPI + r0;
    bf16_t* dst = rowptr(r);
    if (dst) *(u32x4*)(dst + ch * 8) = *(const u32x4*)(T + r * LDC + ch * 8);
  }
  __syncthreads();
}


struct Acc256 { f32x4 a[8][4]; };
struct GStage2 { u32x4 a0, a1; f32x4 b00, b01, b10, b11; };
template <class BP>
DI void g2_load(GStage2& S, const bf16_t* ap0, const bf16_t* ap1, const BP& bp0, const BP& bp1, int ldb, int t, int nt) {
  if (t < nt) {
    S.a0 = *(const u32x4*)(ap0 + t * 32);
    S.a1 = *(const u32x4*)(ap1 + t * 32);
    const size_t o = (size_t)t * 32 * ldb;
    S.b00 = *(const f32x4*)(bp0 + o);
    S.b01 = *(const f32x4*)(bp0 + o + ldb);
    S.b10 = *(const f32x4*)(bp1 + o);
    S.b11 = *(const f32x4*)(bp1 + o + ldb);
  }
}
DI void g2_write(const GStage2& S, char* st, int tid, int kq, int ng) {
  {
    const int row = tid >> 2, ch = (tid & 3) ^ swz4(row);
    *(u32x4*)(st + row * 64 + ch * 16) = S.a0;
    *(u32x4*)(st + 8192 + row * 64 + ch * 16) = S.a1;
  }
  const int pc = ((kq >> 2) ^ swz4(4 * ng)) * 4 + (kq & 3);
  unsigned* dst = (unsigned*)(st + 16384) + (4 * ng) * 16 + pc;
  dst[0] = pack2(S.b00[0], S.b01[0]);
  dst[16] = pack2(S.b00[1], S.b01[1]);
  dst[32] = pack2(S.b00[2], S.b01[2]);
  dst[48] = pack2(S.b00[3], S.b01[3]);
  dst[2048 + 0] = pack2(S.b10[0], S.b11[0]);
  dst[2048 + 16] = pack2(S.b10[1], S.b11[1]);
  dst[2048 + 32] = pack2(S.b10[2], S.b11[2]);
  dst[2048 + 48] = pack2(S.b10[3], S.b11[3]);
}
DI void g2_compute(Acc256& acc, const char* st, int wr, int wc, int fr, int fq) {
  bf16x8 Bt[4];
  const int pch = (fq ^ swz4(fr)) * 16;
#pragma unroll
  for (int n = 0; n < 4; ++n) Bt[n] = *(const bf16x8*)(st + 16384 + (wc * 64 + n * 16 + fr) * 64 + pch);
#pragma unroll
  for (int m = 0; m < 8; ++m) {
    const bf16x8 At = *(const bf16x8*)(st + (wr * 128 + m * 16 + fr) * 64 + pch);
#pragma unroll
    for (int n = 0; n < 4; ++n) acc.a[m][n] = __builtin_amdgcn_mfma_f32_16x16x32_bf16(At, Bt[n], acc.a[m][n], 0, 0, 0);
  }
}
template <class ARow, class BCol, class Epi>
DI void gemm256(char* smem, const ARow& arow, const BCol& bcol, int ldb, int K, const Epi& epi) {
  const int tid = fresh_tid(), wid = tid >> 6, lane = tid & 63, wr = wid >> 2, wc = wid & 3, fr = lane & 15, fq = lane >> 4;
  const int ar0 = tid >> 2, ac0 = (tid & 3) * 8;
  const bf16_t* ap0 = arow(ar0) + ac0;
  const bf16_t* ap1 = arow(ar0 + 128) + ac0;
  const int kq = tid & 15, ng = tid >> 4;
  const float* bp0 = bcol(ng) + (size_t)(2 * kq) * ldb;
  const float* bp1 = bcol(ng + 32) + (size_t)(2 * kq) * ldb;
  Acc256 acc;
#pragma unroll
  for (int m = 0; m < 8; ++m)
#pragma unroll
    for (int n = 0; n < 4; ++n) acc.a[m][n] = (f32x4){0.f, 0.f, 0.f, 0.f};
  const int nt = K / 32;
  char* st0 = smem;
  char* st1 = smem + 32768;
  GStage2 S0, S1;
  g2_load(S0, ap0, ap1, bp0, bp1, ldb, 0, nt);
  g2_load(S1, ap0, ap1, bp0, bp1, ldb, 1, nt);
  g2_write(S0, st0, tid, kq, ng);
  g2_load(S0, ap0, ap1, bp0, bp1, ldb, 2, nt);
  __syncthreads();
  for (int t = 0; t < nt; t += 2) {
    g2_compute(acc, st0, wr, wc, fr, fq);
    g2_write(S1, st1, tid, kq, ng);
    g2_load(S1, ap0, ap1, bp0, bp1, ldb, t + 3, nt);
    __syncthreads();
    g2_compute(acc, st1, wr, wc, fr, fq);
    if (t + 2 < nt) g2_write(S0, st0, tid, kq, ng);
    g2_load(S0, ap0, ap1, bp0, bp1, ldb, t + 4, nt);
    __syncthreads();
  }
  epi(acc, wr, wc, fr, fq);
}
template <int NC, class Val, class RowPtr>
DI void epi256_bf16(char* smem, int wr, int wc, int fr, int fq, const Val& val, const RowPtr& rowptr, int ncv = 1 << 30) {
  constexpr int LDC = NC + 8;
  bf16_t* T = (bf16_t*)smem;
#pragma unroll
  for (int m = 0; m < 8; ++m)
#pragma unroll
    for (int n = 0; n < NC / 64; ++n)
#pragma unroll
      for (int j = 0; j < 4; ++j) T[(wr * 128 + m * 16 + fq * 4 + j) * LDC + wc * (NC / 4) + n * 16 + fr] = f2bf(val(m, n, j));
  __syncthreads();
  constexpr int CPR = NC / 8, RPI = NTHR / CPR;
  const int tid = fresh_tid(), ch = tid % CPR, r0 = tid / CPR;
#pragma unroll 4
  for (int it = 0; it < 256 / RPI; ++it) {
    const int r = it * RPI + r0;
    bf16_t* dst = rowptr(r);
    if (dst && ch * 8 < ncv) *(u32x4*)(dst + ch * 8) = *(const u32x4*)(T + r * LDC + ch * 8);
  }
  __syncthreads();
}


namespace g8 {
constexpr int BK = 64, HALF = 128, HTB = HALF * BK * 2;
DI int lds_byte(int r, int c) { const int st = (r >> 4) * 2 + (c >> 5), rr = r & 15, cc = c & 31, ob = rr * 64 + cc * 2; return st * 1024 + (ob ^ (((ob >> 9) & 1) << 5)); }
DI void stage_rc(int b, int& R, int& C) { const int st = b / 1024, sb = b % 1024, swz = sb ^ (((sb >> 9) & 1) << 5); R = (st >> 1) * 16 + swz / 64; C = (st & 1) * 32 + (swz % 64) / 2; }
typedef f32x4 Acc[2][2][4][2];
template <class Unit, class Sched, class Epi>
DI void gemm(LAS unsigned char* lds, const Sched& S, const Epi& E, int K) {
  asm volatile("" : "+s"(K));
  const int tid = fresh_tid(), wid = __builtin_amdgcn_readfirstlane(tid >> 6), lane = tid & 63, wr = wid >> 2, wc = wid & 3, fr = lane & 15, fq = lane >> 4;
  const int nt = K / BK;
  int R[2], C[2];
  unsigned voffB[2];
#pragma unroll
  for (int i = 0; i < 2; ++i) { stage_rc(tid * 16 + i * 8192, R[i], C[i]); voffB[i] = (unsigned)(R[i] * K + C[i]) * 2u; }
  const size_t kstep = (size_t)(BK * 2);
  const size_t hstep = (size_t)HALF * K * 2;
  const unsigned ldsw = (unsigned)wid * 1024u;
  const int aoff = lds_byte(wr * 64 + fr, fq * 8), boff = lds_byte(wc * 32 + fr, fq * 8);
#define G8_SA(b, h) (((b) * 2 + (h)) * HTB)
#define G8_SB(b, h) ((4 + (b) * 2 + (h)) * HTB)
#define G8_STAGEB(bufoff, gbase) do { _Pragma("unroll") for (int _i = 0; _i < 2; ++_i) \
    __builtin_amdgcn_global_load_lds((const unsigned*)((const char*)(gbase) + voffB[_i]), (LAS unsigned*)(lds + (bufoff) + ldsw + _i * 8192), 16, 0, 0); } while (0)
#define G8_STAGEA(bufoff, offs, h, kb) do { _Pragma("unroll") for (int _i = 0; _i < 2; ++_i) \
    __builtin_amdgcn_global_load_lds((const unsigned*)(abase + (size_t)(offs)[h][_i] + (kb)), (LAS unsigned*)(lds + (bufoff) + ldsw + _i * 8192), 16, 0, 0); } while (0)
#define G8_LDA(dst, b, h) do { _Pragma("unroll") for (int m = 0; m < 4; ++m) _Pragma("unroll") for (int k = 0; k < 2; ++k) dst[m][k] = *(const LAS bf16x8*)(lds + G8_SA(b, h) + aoff + m * 2048 + k * 1024); } while (0)
#define G8_LDB(dst, b, h) do { _Pragma("unroll") for (int n = 0; n < 2; ++n) _Pragma("unroll") for (int k = 0; k < 2; ++k) dst[n][k] = *(const LAS bf16x8*)(lds + G8_SB(b, h) + boff + n * 2048 + k * 1024); } while (0)
#define G8_MMA(ai, bj, At, Bt) do { __builtin_amdgcn_s_setprio(1); _Pragma("unroll") for (int m = 0; m < 4; ++m) _Pragma("unroll") for (int n = 0; n < 2; ++n) _Pragma("unroll") for (int k = 0; k < 2; ++k) \
    acc[ai][bj][m][n] = __builtin_amdgcn_mfma_f32_16x16x32_bf16(Bt[n][k], At[m][k], acc[ai][bj][m][n], 0, 0, 0); __builtin_amdgcn_s_setprio(0); } while (0)
#define G8_WAIT_V(n) asm volatile("s_waitcnt vmcnt(" #n ")" ::: "memory")
#define G8_WAIT_L(n) asm volatile("s_waitcnt lgkmcnt(" #n ")" ::: "memory")
#define G8_BAR __builtin_amdgcn_s_barrier()
#define G8_SCHED __builtin_amdgcn_sched_barrier(0)
  Unit cur, nxt; int ui = 0;
  if (!S.next(0, cur)) return;
  const char* abase = S.abase();
  Acc acc;
#pragma unroll
  for (int a = 0; a < 2; ++a)
#pragma unroll
    for (int b = 0; b < 2; ++b)
#pragma unroll
      for (int m = 0; m < 4; ++m)
#pragma unroll
        for (int n = 0; n < 2; ++n) acc[a][b][m][n] = (f32x4){0.f, 0.f, 0.f, 0.f};
  bf16x8 At[4][2], B0[2][2], B1[2][2];
  unsigned co[2][2], no[2][2];
  S.pf(cur, lds, 0);
  S.aoffs(cur, R[0], R[1], C[0], C[1], co);
  const char* cB = S.bbase(cur);
  G8_STAGEB(G8_SB(0, 0), cB); G8_STAGEA(G8_SA(0, 0), co, 0, 0); G8_STAGEB(G8_SB(0, 1), cB + hstep); G8_STAGEA(G8_SA(0, 1), co, 1, 0);
  if (wr == 1) G8_BAR;
  G8_WAIT_V(4); G8_BAR;
  G8_STAGEB(G8_SB(1, 0), cB + kstep); G8_STAGEA(G8_SA(1, 0), co, 0, kstep); G8_STAGEB(G8_SB(1, 1), cB + hstep + kstep);
  G8_WAIT_V(6); G8_BAR;
  for (;;) {
    const bool has_next = S.next(ui + 1, nxt);
    const char* nB = cB;
    if (has_next) { nB = S.bbase(nxt); S.pf(nxt, lds, (ui + 1) % 3); }
    for (int t = 0; t < nt; t += 2) {
      const bool last = (t == nt - 2);
      const size_t k1 = (size_t)(t + 1) * kstep;
      const size_t k2 = last ? 0 : (size_t)(t + 2) * kstep;
      const size_t k3 = k2 + kstep;
      const char* b2 = (last ? nB : cB) + k2;
      const char* b3 = b2 + kstep;
      if (last) {
        if (has_next) S.aoffs_late(nxt, lds, (ui + 1) % 3, R[0], R[1], C[0], C[1], no);
        else {
#pragma unroll
          for (int h = 0; h < 2; ++h)
#pragma unroll
            for (int i = 0; i < 2; ++i) no[h][i] = co[h][i];
        }
      }
      G8_LDB(B0, 0, 0); G8_SCHED; G8_LDA(At, 0, 0); G8_STAGEA(G8_SA(1, 1), co, 1, k1);
      G8_WAIT_L(8); G8_BAR; G8_WAIT_L(0); G8_MMA(0, 0, At, B0); G8_BAR; G8_SCHED;
      G8_LDB(B1, 0, 1); G8_STAGEB(G8_SB(0, 0), b2);
      G8_BAR; G8_WAIT_L(0); G8_MMA(0, 1, At, B1); G8_BAR;
      G8_LDA(At, 0, 1);
      if (last) { G8_STAGEA(G8_SA(0, 0), no, 0, k2); } else { G8_STAGEA(G8_SA(0, 0), co, 0, k2); }
      G8_BAR; G8_WAIT_L(0); G8_MMA(1, 0, At, B0); G8_BAR; G8_SCHED;
      G8_STAGEB(G8_SB(0, 1), b2 + hstep);
      G8_WAIT_V(6); G8_BAR; G8_MMA(1, 1, At, B1); G8_BAR;
      G8_LDB(B0, 1, 0); G8_SCHED; G8_LDA(At, 1, 0);
      if (last) { G8_STAGEA(G8_SA(0, 1), no, 1, k2); } else { G8_STAGEA(G8_SA(0, 1), co, 1, k2); }
      G8_WAIT_L(8); G8_BAR; G8_WAIT_L(0); G8_MMA(0, 0, At, B0); G8_BAR; G8_SCHED;
      G8_LDB(B1, 1, 1); G8_STAGEB(G8_SB(1, 0), b3);
      G8_BAR; G8_WAIT_L(0); G8_MMA(0, 1, At, B1); G8_BAR;
      G8_LDA(At, 1, 1);
      if (last) { G8_STAGEA(G8_SA(1, 0), no, 0, k3); } else { G8_STAGEA(G8_SA(1, 0), co, 0, k3); }
      G8_BAR; G8_WAIT_L(0); G8_MMA(1, 0, At, B0); G8_BAR; G8_SCHED;
      G8_STAGEB(G8_SB(1, 1), b3 + hstep);
      G8_WAIT_V(6); G8_BAR; G8_MMA(1, 1, At, B1); G8_BAR;
    }
    E(acc, cur, wr, wc, fr, fq, ui % 3);
    if (!has_next) break;
#pragma unroll
    for (int a = 0; a < 2; ++a)
#pragma unroll
      for (int b = 0; b < 2; ++b)
#pragma unroll
        for (int m = 0; m < 4; ++m)
#pragma unroll
          for (int n = 0; n < 2; ++n) acc[a][b][m][n] = (f32x4){0.f, 0.f, 0.f, 0.f};
    cur = nxt; cB = nB; ++ui;
#pragma unroll
    for (int h = 0; h < 2; ++h)
#pragma unroll
      for (int i = 0; i < 2; ++i) co[h][i] = no[h][i];
  }
  G8_WAIT_V(0);
  if (wr == 0) G8_BAR;
  G8_BAR;
#undef G8_SA
#undef G8_SB
#undef G8_STAGEA
#undef G8_STAGEB
#undef G8_LDA
#undef G8_LDB
#undef G8_MMA
#undef G8_WAIT_V
#undef G8_WAIT_L
#undef G8_BAR
#undef G8_SCHED
}
struct Unit2 { int pm, pn; };
struct DenseOrder {
  int nM, nN, nwg, G, c;
  DI void init(int nM_, int nN_, int G_, int c_) { nM = nM_; nN = nN_; nwg = nM * nN; G = G_; c = c_; }
  DI bool next(int i, Unit2& u) const {
    const long Lx = (long)i * G + c; if (Lx >= nwg) return false;
    int wgid = (int)Lx; { const int q = nwg / 8, r = nwg % 8, xcd = wgid % 8, off = wgid / 8; wgid = (xcd < r ? xcd * (q + 1) : r * (q + 1) + (xcd - r) * q) + off; }
    const int nig = 8 * nN, gid = wgid / nig, fm = gid * 8, gsz = (nM - fm) < 8 ? (nM - fm) : 8;
    u.pm = fm + ((wgid % nig) % gsz); u.pn = (wgid % nig) / gsz; return true;
  }
};
}

template <class ColPtr>
DI void transpose_tile(char* smem, int ld, bf16_t* dst, int Kdim, int k0, int rho0, const ColPtr& colptr) {
  bf16_t* T = (bf16_t*)smem;
  const int tid = fresh_tid();
  {
    const int kk = tid >> 3, g = tid & 7;
    const int rho = rho0 + g * 8;
    const float* cp = colptr(rho);
    const float* cp2 = colptr(rho + 4);
    f32x4 v0, v1;
    if (cp) { v0 = *(const f32x4*)(cp + (size_t)(k0 + kk) * ld); v1 = *(const f32x4*)(cp2 + (size_t)(k0 + kk) * ld); }
    else { v0 = (f32x4){0.f, 0.f, 0.f, 0.f}; v1 = v0; }
#pragma unroll
    for (int j = 0; j < 4; ++j) { T[(g * 8 + j) * 72 + kk] = f2bf(v0[j]); T[(g * 8 + 4 + j) * 72 + kk] = f2bf(v1[j]); }
  }
  __syncthreads();
  {
    const int r = tid >> 3, ch = tid & 7;
    *(u32x4*)(dst + (size_t)(rho0 + r) * Kdim + k0 + ch * 8) = *(const u32x4*)(T + r * 72 + ch * 8);
  }
  __syncthreads();
}

DI int swiglu_col(int rho, int& z);
struct PrepTile { const float* src[4]; const float* src2[4]; bf16_t* dst; int ld, Kdim, perm; };
DI int w2_row(int c) { const int wc = c >> 6, fq = (c >> 4) & 3, bj = (c >> 3) & 1, n = (c >> 2) & 1, e = c & 3; return 128 * bj + 32 * wc + 16 * n + 4 * fq + e; }
DI int w2_col(int rho) { const int bj = rho >> 7, wc = (rho >> 5) & 3, n = (rho >> 4) & 1, fq = (rho >> 2) & 3, e = rho & 3; return 64 * wc + 16 * fq + 8 * bj + 4 * n + e; }
DI int perm32(int rho) { const int n = rho >> 4, i = rho & 15; return 8 * (i >> 2) + 4 * n + (i & 3); }
DI void prep_tile_desc(const Params& P, int u, int ch, int r, PrepTile& t) {
  constexpr int PER_E = 32 + 16;
  const int e = u / PER_E, v = u % PER_E;
  if (e < 256 && v < 32) {
    const int pn = v >> 4, kt = v & 15;
    const float* W1 = P.exp_w1 + (size_t)e * D * DE;
    const float* W3 = P.exp_w3 + (size_t)e * D * DE;
    t.ld = DE; t.Kdim = D; t.perm = 0;
    t.dst = P.w13T + ((size_t)e * 512 + pn * 256) * D + kt * 64;
#pragma unroll
    for (int sb = 0; sb < 4; ++sb) {
      int z; const int col = swiglu_col(pn * 256 + sb * 64 + ch * 4, z);
      t.src[sb] = (z ? W3 : W1) + col + (size_t)(kt * 64 + 2 * r) * DE;
      t.src2[sb] = t.src[sb] + DE;
    }
  } else {
    const int w = (e < 256) ? v - 32 : v;
    const int pn = w >> 2, kt = w & 3;
    const float* W2 = (e < 256) ? P.exp_w2 + (size_t)e * DE * D : P.sh_w2;
    t.ld = D; t.Kdim = DE;
    t.dst = P.w2T + ((size_t)e * D + pn * 256) * DE + kt * 64;
    t.perm = 1;
#pragma unroll
    for (int sb = 0; sb < 4; ++sb) {
      t.src[sb] = W2 + pn * 256 + sb * 64 + ch * 4 + (size_t)(kt * 64 + 2 * r) * D;
      t.src2[sb] = t.src[sb] + D;
    }
  }
}
constexpr int PREP_TOTAL = 256 * 48 + 16;
constexpr int NPREPB = 80;
constexpr int NW2 = 72, B2 = 64;
constexpr int B8 = 20;
constexpr int PREP_Q0 = NW2 * B2 + 64 * B8;
constexpr int TASK_Q0 = (256 - 16 - NPREPB) * 2;
constexpr int FSTR = 384;
struct PrepSet { f32x4 v[4][2]; bf16_t* dst; int Kdim, perm; };
DI void prep_issue(const Params& P, PrepSet& S, int u, int ch, int r2) {
  const bool ok = u < PREP_TOTAL;
  PrepTile t;
  prep_tile_desc(P, ok ? u : 0, ch, r2, t);
#pragma unroll
  for (int sb = 0; sb < 4; ++sb) {
    S.v[sb][0] = __builtin_nontemporal_load((const f32x4*)(ok ? t.src[sb] : P.ones));
    S.v[sb][1] = __builtin_nontemporal_load((const f32x4*)(ok ? t.src2[sb] : P.ones));
  }
  S.dst = t.dst; S.Kdim = t.Kdim; S.perm = t.perm;
}
#define PREP_BODY(S)                                                                                                   \
  {                                                                                                                    \
    unsigned* T = (unsigned*)(smem + par * 33792);                                                                     \
    par ^= 1;                                                                                                          \
    _Pragma("unroll") for (int sb = 0; sb < 4; ++sb)                                                                   \
      _Pragma("unroll") for (int j = 0; j < 4; ++j) {                                                                  \
        const int c = sb * 64 + ch * 4 + j;                                                                            \
        T[(S.perm ? w2_row(c) : c) * 33 + r2] = pack2(S.v[sb][0][j], S.v[sb][1][j]);                                   \
      }                                                                                                                \
    bf16_t* dst = S.dst; const int Kdim = S.Kdim;                                                                      \
    prep_issue(P, S, (k + 3 < n) ? base + k + 3 : PREP_TOTAL, ch, r2);                                                 \
    __syncthreads();                                                                                                   \
    _Pragma("unroll") for (int it = 0; it < 4; ++it) {                                                                 \
      const int ro = it * 64 + (tid >> 3), co = tid & 7;                                                               \
      const unsigned* tp = T + ro * 33 + co * 4;                                                                       \
      u32x4 o; o[0] = tp[0]; o[1] = tp[1]; o[2] = tp[2]; o[3] = tp[3];                                                 \
      __builtin_nontemporal_store(o, (u32x4*)(dst + (size_t)ro * Kdim + co * 8));                                      \
    }                                                                                                                  \
    if (++k >= n) break;                                                                                               \
  }
DI void prep_range(const Params& P, char* smem, int base, int n) {
  const int tid = fresh_tid();
  const int ch = tid & 15, r2 = tid >> 4;
  int par = 0;
  if (n <= 0) return;
  PrepSet R0, R1, R2;
  prep_issue(P, R0, base, ch, r2);
  prep_issue(P, R1, (1 < n) ? base + 1 : PREP_TOTAL, ch, r2);
  prep_issue(P, R2, (2 < n) ? base + 2 : PREP_TOTAL, ch, r2);
  int k = 0;
  do {
    PREP_BODY(R0)
    for (;;) {
      PREP_BODY(R1) PREP_BODY(R2) PREP_BODY(R0)
      PREP_BODY(R1) PREP_BODY(R2) PREP_BODY(R0)
      PREP_BODY(R1) PREP_BODY(R2) PREP_BODY(R0)
      PREP_BODY(R1) PREP_BODY(R2) PREP_BODY(R0)
    }
  } while (0);
  __syncthreads();
}
constexpr int PB = 24, PBS = 6, PREP_TAIL = 1920;
constexpr int PREP_NBIG = (PREP_TOTAL - PREP_Q0 - PREP_TAIL) / PB;
constexpr int PREP_QS = PREP_Q0 + PREP_NBIG * PB;
DI void prep_ticket(unsigned t, int& base, int& n) {
  if ((int)t < PREP_NBIG) { base = PREP_Q0 + (int)t * PB; n = PB; }
  else { base = PREP_QS + ((int)t - PREP_NBIG) * PBS; n = PBS; }
  if (base > PREP_TOTAL) base = PREP_TOTAL;
  if (n > PREP_TOTAL - base) n = PREP_TOTAL - base;
}
DI void prep_queue(const Params& P, char* smem) {
  LAS unsigned* qw = (LAS unsigned*)(smem + 69632);
  unsigned* qp = P.qh + 32;
  const int tid = fresh_tid();
  unsigned nb = 0;
  if (tid == 0) nb = __builtin_amdgcn_atomic_inc32(qp, 0xFFFFFFFFu, __ATOMIC_RELAXED, "agent");
  for (;;) {
    if (tid == 0) qw[0] = nb;
    __syncthreads();
    int base, n;
    prep_ticket(__builtin_amdgcn_readfirstlane(qw[0]), base, n);
    if (n <= 0) break;
    if (tid == 0) nb = __builtin_amdgcn_atomic_inc32(qp, 0xFFFFFFFFu, __ATOMIC_RELAXED, "agent");
    prep_range(P, smem, base, n);
  }
}

DI int swiglu_col(int rho, int& z) { const int kap = rho & 255, pn = rho >> 8; z = (kap >> 4) & 1; return pn * 128 + (kap >> 5) * 16 + (kap & 15); }

constexpr int LD = 72;
constexpr int SLOT = 64 * LD * 2;
DI f32x16 mfma32(bf16x8 a, bf16x8 b, f32x16 c) { return __builtin_amdgcn_mfma_f32_32x32x16_bf16(a, b, c, 0, 0, 0); }
DI f32x16 zero16() {
  f32x16 z;
#pragma unroll
  for (int i = 0; i < 16; ++i) z[i] = 0.f;
  return z;
}
DI bf16x8 frag_c(const bf16_t* M, int row, int k, int ld = LD) { return *(const bf16x8*)(M + row * ld + k); }
DI bf16x8 frag_s(const bf16_t* M, int k, int col, int ld = LD) {
  bf16x8 v;
#pragma unroll
  for (int j = 0; j < 8; ++j) v[j] = (short)M[(k + j) * ld + col];
  return v;
}
DI int crow(int reg, int half) { return (reg & 3) + 8 * (reg >> 2) + 4 * half; }
template <bool AC, bool BC>
DI f32x16 mm_tile(const bf16_t* A, const bf16_t* B, int ti, int tj, int lane, f32x16 acc) {
  const int r = lane & 31, h = lane >> 5;
#pragma unroll
  for (int ks = 0; ks < 4; ++ks) {
    const int k = ks * 16 + 8 * h;
    bf16x8 a = AC ? frag_c(A, ti * 32 + r, k) : frag_s(A, k, ti * 32 + r);
    bf16x8 b = BC ? frag_c(B, tj * 32 + r, k) : frag_s(B, k, tj * 32 + r);
    acc = mfma32(a, b, acc);
    __builtin_amdgcn_sched_barrier(0);
  }
  return acc;
}
DI void store_rm_bf16(bf16_t* M, const f32x16& acc, int ti, int tj, int lane) {
  const int c = tj * 32 + (lane & 31), h = lane >> 5;
#pragma unroll
  for (int g = 0; g < 16; ++g) M[(ti * 32 + crow(g, h)) * LD + c] = f2bf(acc[g]);
}
DI void store_tr_bf16(bf16_t* Mt, const f32x16& acc, int ti, int tj, int lane, int ld = LD) {
  const int c = tj * 32 + (lane & 31), h = lane >> 5;
#pragma unroll
  for (int g = 0; g < 4; ++g) {
    u32x2 v;
    v[0] = pack2(acc[4 * g], acc[4 * g + 1]);
    v[1] = pack2(acc[4 * g + 2], acc[4 * g + 3]);
    *(u32x2*)(Mt + c * ld + ti * 32 + 8 * g + 4 * h) = v;
  }
}

DI void phase0(const Params& P, char* smem) {
  const int tid = fresh_tid();
  if (blockIdx.x == 0 && tid < 272) P.cnt[tid] = 0;
  if (blockIdx.x == 1 && tid < 256) P.ones[tid] = 1.f;
  for (int i = blockIdx.x * NTHR + tid; i < L; i += gridDim.x * NTHR) P.ident[i] = i * NSLOT + 8;
  float* red = (float*)smem;
  for (int cb = blockIdx.x; cb < 6144 / 24; cb += gridDim.x) {
    const int n0 = cb * 24;
    if (tid < 504) {
      const int col = tid % 24, ks = tid / 24;
      const int k0 = ks * 49, k1 = (k0 + 49 < 1024) ? k0 + 49 : 1024;
      float s0 = 0.f, s1 = 0.f;
      for (int k = k0; k < k1; ++k) {
        const float w = P.ada_w[(size_t)k * 6144 + n0 + col];
        s0 += siluf(P.c[k]) * w;
        s1 += siluf(P.c_ctx[k]) * w;
      }
      red[(ks * 24 + col) * 2] = s0;
      red[(ks * 24 + col) * 2 + 1] = s1;
    }
    __syncthreads();
    if (tid < 48) {
      const int col = tid >> 1, z = tid & 1;
      float s = 0.f;
      for (int ks = 0; ks < 21; ++ks) s += red[(ks * 24 + col) * 2 + z];
      s += P.ada_b[n0 + col];
      (z ? P.modc : P.mod)[n0 + col] = s;
    }
    __syncthreads();
  }
}

DI void norm_mod_row(const float* src, const float* g, const float* shift, const float* scale, bf16_t* dst, int lane) {
  f32x4 v[4];
  float ss = 0.f;
#pragma unroll
  for (int i = 0; i < 4; ++i) {
    v[i] = *(const f32x4*)(src + i * 256 + lane * 4);
    ss += v[i][0] * v[i][0] + v[i][1] * v[i][1] + v[i][2] * v[i][2] + v[i][3] * v[i][3];
  }
  ss = wave_sum(ss);
  const float rs = __builtin_amdgcn_rsqf(ss * (1.f / 1024.f) + 1e-6f);
#pragma unroll
  for (int i = 0; i < 4; ++i) {
    const int c = i * 256 + lane * 4;
    const f32x4 gg = *(const f32x4*)(g + c), sh = *(const f32x4*)(shift + c), sc = *(const f32x4*)(scale + c);
    float o[4];
#pragma unroll
    for (int j = 0; j < 4; ++j) o[j] = v[i][j] * rs * gg[j] * (1.f + sc[j]) + sh[j];
    u32x2 w;
    w[0] = pack2(o[0], o[1]);
    w[1] = pack2(o[2], o[3]);
    *(u32x2*)(dst + c) = w;
  }
}
DI void phase1(const Params& P) {
  const int tid_ = fresh_tid();
  const int wid = tid_ >> 6, lane = tid_ & 63;
  for (int row = blockIdx.x * 8 + wid; row < LT; row += gridDim.x * 8) {
    if (row < L) norm_mod_row(P.x + (size_t)row * D, P.norm1_g, P.mod, P.mod + 1024, P.hx + (size_t)row * D, lane);
    else norm_mod_row(P.ctx + (size_t)(row - L) * D, P.norm1_g, P.modc, P.modc + 1024, P.hx + (size_t)row * D, lane);
  }
}
DI void phase7(const Params& P) {
  const int tid_ = fresh_tid();
  const int wid = tid_ >> 6, lane = tid_ & 63;
  for (int row = blockIdx.x * 8 + wid; row < L; row += gridDim.x * 8)
    norm_mod_row(P.x1 + (size_t)row * D, P.norm2_g, P.mod + 3072, P.mod + 4096, P.h2 + (size_t)row * D, lane);
}


DI void prep_dense(const Params& P, char* smem) {
  constexpr int T_WIN = (PIN / 64) * 16, T_WOUT = 16 * 16, T_RS = 12 * 16, T_G = 16;
  for (int u = blockIdx.x; u < T_WIN + T_WOUT + T_RS + T_G; u += gridDim.x) {
    if (u < T_WIN) {
      const int rt = u >> 4, kt = u & 15;
      transpose_tile(smem, PINW, P.winT, D, kt * 64, rt * 64, [&](int rho) -> const float* { return rho < PINW ? P.w_in + (rho & ~31) + perm32(rho & 31) : nullptr; });
    } else if (u < T_WIN + T_WOUT) {
      const int v = u - T_WIN, rt = v >> 4, kt = v & 15;
      transpose_tile(smem, D, P.woutT, D, kt * 64, rt * 64, [&](int rho) -> const float* { return P.w_out + rho; });
    } else if (u >= T_WIN + T_WOUT + T_RS) {
      const int v = u - T_WIN - T_WOUT - T_RS, rt = v >> 1, kt = v & 1;
      transpose_tile(smem, 512, P.gateT, 128, kt * 64, rt * 64, [&](int rho) -> const float* { return P.gate_up + rho; });
    } else {
      const int v = u - T_WIN - T_WOUT, rt = v >> 4, kt = v & 15;
      transpose_tile(smem, 256, P.rsT, D, kt * 64, rt * 64, [&](int rho) -> const float* {
        if (rho < 256) return P.router_w + rho;
        int z; const int col = swiglu_col(rho - 256, z);
        return (z ? P.sh_w3 : P.sh_w1) + col;
      });
    }
  }
}

struct SchedP2 : g8::DenseOrder {
  static constexpr int PF_LINES = 0;
  DI void pf(const g8::Unit2&, LAS unsigned char*, int) const {}
  DI void aoffs_late(const g8::Unit2& u, LAS unsigned char*, int, int R0, int R1, int C0, int C1, unsigned (&o)[2][2]) const { aoffs(u, R0, R1, C0, C1, o); }
  const Params* P;
  DI const char* abase() const { return (const char*)P->hx; }
  DI const char* bbase(const g8::Unit2& u) const { return (const char*)(P->winT + (size_t)u.pn * 256 * D); }
  DI void aoffs(const g8::Unit2& u, int R0, int R1, int C0, int C1, unsigned (&o)[2][2]) const {
#pragma unroll
    for (int h = 0; h < 2; ++h) {
      o[h][0] = (unsigned)(((u.pm * 256 + h * 128 + R0) * D + C0) * 2);
      o[h][1] = (unsigned)(((u.pm * 256 + h * 128 + R1) * D + C1) * 2);
    }
  }
};
DI void phase2(const Params& P, char* smem) {
  if ((int)blockIdx.x >= (int)gridDim.x - NW2) { prep_range(P, smem, ((int)blockIdx.x - ((int)gridDim.x - NW2)) * B2, B2); return; }
  SchedP2 S; S.init(LT / 256, PIN / 256, gridDim.x - NW2, blockIdx.x); S.P = &P;
  g8::gemm<g8::Unit2>((LAS unsigned char*)smem, S,
      [&](const g8::Acc& acc, const g8::Unit2& u, int wr, int wc, int fr, int fq, int) {
#pragma unroll
        for (int ai = 0; ai < 2; ++ai)
#pragma unroll
          for (int m = 0; m < 4; ++m) {
            bf16_t* rowp = P.p + (size_t)(u.pm * 256 + ai * 128 + wr * 64 + m * 16 + fr) * PIN + u.pn * 256 + wc * 32 + 8 * fq;
#pragma unroll
            for (int bj = 0; bj < 2; ++bj) {
              const f32x4 v0 = acc[ai][bj][m][0], v1 = acc[ai][bj][m][1];
              u32x4 w;
              w[0] = pack2(v0[0], v0[1]); w[1] = pack2(v0[2], v0[3]); w[2] = pack2(v1[0], v1[1]); w[3] = pack2(v1[2], v1[3]);
              *(u32x4*)(rowp + bj * 128) = w;
            }
          }
      }, D);
}

DI void load_shift16(const Params& P, int t, int lo, int hi, int col, float* o) {
  const bf16_t* pc = P.p + (size_t)t * PIN + col;
  u32x4 c0 = *(const u32x4*)pc, c1 = *(const u32x4*)(pc + 8);
  u32x4 p0 = (u32x4){0, 0, 0, 0}, p1 = p0, n0 = p0, n1 = p0;
  if (t - 1 >= lo) { p0 = *(const u32x4*)(pc - PIN); p1 = *(const u32x4*)(pc - PIN + 8); }
  if (t + 1 < hi) { n0 = *(const u32x4*)(pc + PIN); n1 = *(const u32x4*)(pc + PIN + 8); }
  const float* mu0 = P.shift_mu + (col - PRW0);
  const float* mu1 = P.shift_mu + 1920 + (col - PRW0);
#pragma unroll
  for (int i = 0; i < 16; ++i) {
    const unsigned cw = (i < 8) ? c0[(i & 7) >> 1] : c1[(i & 7) >> 1];
    const unsigned pw = (i < 8) ? p0[(i & 7) >> 1] : p1[(i & 7) >> 1];
    const unsigned nw = (i < 8) ? n0[(i & 7) >> 1] : n1[(i & 7) >> 1];
    const float cv = (i & 1) ? __uint_as_float(cw & 0xFFFF0000u) : __uint_as_float(cw << 16);
    const float pv = (i & 1) ? __uint_as_float(pw & 0xFFFF0000u) : __uint_as_float(pw << 16);
    const float nv = (i & 1) ? __uint_as_float(nw & 0xFFFF0000u) : __uint_as_float(nw << 16);
    o[i] = cv + mu0[i] * (pv - cv) + mu1[i] * (nv - cv);
  }
}


DI void st16_bf16(bf16_t* dst, const float* v) {
  u32x4 a, b;
#pragma unroll
  for (int i = 0; i < 4; ++i) { a[i] = pack2(v[2 * i], v[2 * i + 1]); b[i] = pack2(v[8 + 2 * i], v[8 + 2 * i + 1]); }
  *(u32x4*)dst = a;
  *(u32x4*)(dst + 8) = b;
}

struct ShiftRaw { u32x4 c0, c1, p0, p1, n0, n1; };
DI void shift_raw(const Params& P, int t, int lo, int hi, int col, ShiftRaw& R) {
  const bf16_t* pc = P.p + (size_t)t * PIN + col;
  R.c0 = *(const u32x4*)pc; R.c1 = *(const u32x4*)(pc + 8);
  R.p0 = (u32x4){0, 0, 0, 0}; R.p1 = R.p0; R.n0 = R.p0; R.n1 = R.p0;
  if (t - 1 >= lo) { R.p0 = *(const u32x4*)(pc - PIN); R.p1 = *(const u32x4*)(pc - PIN + 8); }
  if (t + 1 < hi) { R.n0 = *(const u32x4*)(pc + PIN); R.n1 = *(const u32x4*)(pc + PIN + 8); }
}
DI void shift_finish(const Params& P, const ShiftRaw& R, int col, float* o) {
  const float* mu0 = P.shift_mu + (col - PRW0);
  const float* mu1 = P.shift_mu + 1920 + (col - PRW0);
#pragma unroll
  for (int i = 0; i < 16; ++i) {
    const unsigned cw = (i < 8) ? R.c0[(i & 7) >> 1] : R.c1[(i & 7) >> 1];
    const unsigned pw = (i < 8) ? R.p0[(i & 7) >> 1] : R.p1[(i & 7) >> 1];
    const unsigned nw = (i < 8) ? R.n0[(i & 7) >> 1] : R.n1[(i & 7) >> 1];
    const float cv = (i & 1) ? __uint_as_float(cw & 0xFFFF0000u) : __uint_as_float(cw << 16);
    const float pv = (i & 1) ? __uint_as_float(pw & 0xFFFF0000u) : __uint_as_float(pw << 16);
    const float nv = (i & 1) ? __uint_as_float(nw & 0xFFFF0000u) : __uint_as_float(nw << 16);
    o[i] = cv + mu0[i] * (pv - cv) + mu1[i] * (nv - cv);
  }
}


DI void half_barrier(LAS unsigned* ctr, unsigned& gen, int lt) {
  ++gen;
  asm volatile("s_waitcnt lgkmcnt(0)" ::: "memory");
  if ((lt & 63) == 0) (void)__hip_atomic_fetch_add(ctr, 1u, __ATOMIC_RELAXED, __HIP_MEMORY_SCOPE_WORKGROUP);
  const unsigned want = 4u * gen;
  while (__hip_atomic_load(ctr, __ATOMIC_RELAXED, __HIP_MEMORY_SCOPE_WORKGROUP) < want) __builtin_amdgcn_s_sleep(1);
  asm volatile("" ::: "memory");
}
DI void phase3_task(const Params& P, char* hs, int task, int lt, LAS unsigned* hctr, unsigned& hgen, LAS unsigned* hq, int fidx) {
#define HALF_BARRIER() half_barrier(hctr, hgen, lt)
  asm volatile("" : "+v"(lt));
  const int lw = lt >> 6, lane = lt & 63;
  const int cc = task >> 4, dir = (task >> 3) & 1, hd = task & 7;
  const int rb = cc * 64;
  const int lo = (rb < L) ? 0 : L, hi = (rb < L) ? L : LT;
  const int sr = lt >> 2, q4 = lt & 3, cseg = q4 * 16;
  const int trow = rb + (dir ? 63 - sr : sr);
  const int ti = lw >> 1, tj = lw & 1;
  bf16_t* slot[8];
#pragma unroll
  for (int i = 0; i < 8; ++i) slot[i] = (bf16_t*)(hs + i * SLOT);
  float* gC = (float*)(hs + 8 * SLOT);
  float* Dout = (float*)(hs + 4 * SLOT);
  float* Aout = (float*)(hs + 6 * SLOT);
  float* Wl = (float*)(hs);

  {
    ShiftRaw rw, ra;
    shift_raw(P, trow, lo, hi, 3072 + 64 * dir + cseg, rw);
    shift_raw(P, trow, lo, hi, 3200 + 64 * dir + cseg, ra);
    const float* du = P.decay_up + ((size_t)(dir * 64 + sr)) * 512 + 64 * hd + cseg;
    const float* iu = P.iclr_up + ((size_t)(dir * 64 + sr)) * 512 + 64 * hd + cseg;
    f32x4 dq[4], iq[4];
#pragma unroll
    for (int i = 0; i < 4; ++i) { dq[i] = *(const f32x4*)(du + 4 * i); iq[i] = *(const f32x4*)(iu + 4 * i); }
    float tmp[16];
    shift_finish(P, rw, 3072 + 64 * dir + cseg, tmp);
#pragma unroll
    for (int i = 0; i < 16; ++i) tmp[i] = tanh_(tmp[i]);
    st16_bf16(slot[0] + sr * LD + cseg, tmp);
    shift_finish(P, ra, 3200 + 64 * dir + cseg, tmp);
    st16_bf16(slot[1] + sr * LD + cseg, tmp);
#pragma unroll
    for (int i = 0; i < 4; ++i) { tmp[4 * i] = dq[i][0]; tmp[4 * i + 1] = dq[i][1]; tmp[4 * i + 2] = dq[i][2]; tmp[4 * i + 3] = dq[i][3]; }
    st16_bf16(slot[2] + sr * LD + cseg, tmp);
#pragma unroll
    for (int i = 0; i < 4; ++i) { tmp[4 * i] = iq[i][0]; tmp[4 * i + 1] = iq[i][1]; tmp[4 * i + 2] = iq[i][2]; tmp[4 * i + 3] = iq[i][3]; }
    st16_bf16(slot[3] + sr * LD + cseg, tmp);
  }
  HALF_BARRIER();
  {
    f32x16 a1 = mm_tile<true, false>(slot[0], slot[2], ti, tj, lane, zero16());
    f32x16 a2 = mm_tile<true, false>(slot[1], slot[3], ti, tj, lane, zero16());
    const int c = tj * 32 + (lane & 31), h = lane >> 5;
#pragma unroll
    for (int g = 0; g < 16; ++g) {
      Dout[(ti * 32 + crow(g, h)) * 65 + c] = a1[g];
      Aout[(ti * 32 + crow(g, h)) * 65 + c] = a2[g];
    }
  }
  HALF_BARRIER();
  float aa[16];
#pragma unroll
  for (int i = 0; i < 16; ++i) {
    const int ch = dir * 512 + 64 * hd + cseg + i;
    const float d = P.decay_w0[ch] + Dout[sr * 65 + cseg + i];
    Wl[sr * 65 + cseg + i] = __expf(-0.6065306597126334f * sigm(d));
    aa[i] = sigm(P.iclr_a0[ch] + Aout[sr * 65 + cseg + i]);
  }
  HALF_BARRIER();
  ShiftRaw rk, rr_;
  shift_raw(P, trow, lo, hi, PRW0 + 512 + 64 * hd + cseg, rk);
  shift_raw(P, trow, lo, hi, PRW0 + 64 * hd + cseg, rr_);
  {
    const int c = lt >> 2, seg = lt & 3;
    float w[16];
#pragma unroll
    for (int i = 0; i < 16; ++i) w[i] = Wl[(seg * 16 + i) * 65 + c];
#pragma unroll
    for (int i = 1; i < 16; ++i) w[i] *= w[i - 1];
    const float tot = w[15];
    const float t0 = __shfl(tot, (lt & 63 & ~3) + 0), t1 = __shfl(tot, (lt & 63 & ~3) + 1), t2 = __shfl(tot, (lt & 63 & ~3) + 2);
    const float pre = (seg == 0) ? 1.f : (seg == 1) ? t0 : (seg == 2) ? t0 * t1 : t0 * t1 * t2;
    HALF_BARRIER();
#pragma unroll
    for (int i = 0; i < 16; ++i) Wl[(seg * 16 + i) * 65 + c] = w[i] * pre;
  }
  HALF_BARRIER();
  {
    float rr[16], kk[16], vv[16];
    shift_finish(P, rk, PRW0 + 512 + 64 * hd + cseg, kk);
    shift_finish(P, rr_, PRW0 + 64 * hd + cseg, rr);
    load_shift16(P, trow, lo, hi, PRW0 + 1024 + 64 * hd + cseg, vv);
    float nrm = 0.f, bsum = 0.f;
#pragma unroll
    for (int i = 0; i < 16; ++i) {
      const float kap = kk[i] * P.key_xi[dir * 512 + 64 * hd + cseg + i];
      nrm += kap * kap;
    }
    nrm += __shfl_xor(nrm, 1);
    nrm += __shfl_xor(nrm, 2);
    const float rn = __builtin_amdgcn_rsqf(nrm + 1e-12f);
    {
      const int o = sr * LD + cseg;
#pragma unroll
      for (int h8 = 0; h8 < 2; ++h8) {
        float xi[8], al[8], rho[8];
#pragma unroll
        for (int i = 0; i < 2; ++i) {
          const f32x4 a = *(const f32x4*)(P.key_xi + dir * 512 + 64 * hd + cseg + 8 * h8 + 4 * i);
          const f32x4 b = *(const f32x4*)(P.key_alpha + dir * 512 + 64 * hd + cseg + 8 * h8 + 4 * i);
          const f32x4 c = *(const f32x4*)(P.bonus_rho + 64 * hd + cseg + 8 * h8 + 4 * i);
#pragma unroll
          for (int j = 0; j < 4; ++j) { xi[4 * i + j] = a[j]; al[4 * i + j] = b[j]; rho[4 * i + j] = c[j]; }
        }
        u32x4 wKp, wBp, wKt, wRp, wV;
#pragma unroll
        for (int p2 = 0; p2 < 4; ++p2) {
          float vKp[2], vBp[2], vKt[2], vRp[2];
#pragma unroll
          for (int e2 = 0; e2 < 2; ++e2) {
            const int i8 = 2 * p2 + e2, i = 8 * h8 + i8;
            const float gsv = Wl[sr * 65 + cseg + i];
            const float gpv = (sr > 0) ? Wl[(sr - 1) * 65 + cseg + i] : 1.f;
            const float kh = kk[i] * xi[i8] * rn;
            const float kt = kk[i] * (1.f + (aa[i] - 1.f) * al[i8]);
            const float bq = aa[i] * kh;
            const float ig = __builtin_amdgcn_rcpf(gsv);
            bsum += rr[i] * rho[i8] * kt;
            vKp[e2] = gpv * kh; vBp[e2] = bq * ig; vKt[e2] = kt * ig; vRp[e2] = gsv * rr[i];
            if (sr == 63) gC[cseg + i] = gsv;
          }
          wKp[p2] = pack2(vKp[0], vKp[1]); wBp[p2] = pack2(vBp[0], vBp[1]); wKt[p2] = pack2(vKt[0], vKt[1]); wRp[p2] = pack2(vRp[0], vRp[1]);
          wV[p2] = pack2(vv[8 * h8 + 2 * p2], vv[8 * h8 + 2 * p2 + 1]);
        }
        *(u32x4*)(slot[2] + o + 8 * h8) = wKp;
        *(u32x4*)(slot[3] + o + 8 * h8) = wBp;
        *(u32x4*)(slot[4] + o + 8 * h8) = wKt;
        *(u32x4*)(slot[5] + o + 8 * h8) = wRp;
        *(u32x4*)(slot[6] + o + 8 * h8) = wV;
      }
    }
    bsum += __shfl_xor(bsum, 1);
    bsum += __shfl_xor(bsum, 2);
    if (q4 == 0 && cc < 256) P.bon[((size_t)dir * L + trow) * 8 + hd] = bsum;
  }
  HALF_BARRIER();
  {
    f32x16 m2 = mm_tile<true, true>(slot[2], slot[3], ti, tj, lane, zero16());
    f32x16 m1 = mm_tile<true, true>(slot[2], slot[4], ti, tj, lane, zero16());
    const int c = tj * 32 + (lane & 31), h = lane >> 5;
#pragma unroll
    for (int g = 0; g < 16; ++g) {
      const int r = ti * 32 + crow(g, h);
      m2[g] = (r > c) ? m2[g] : 0.f;
      m1[g] = (r > c) ? m1[g] : 0.f;
    }
    store_rm_bf16(slot[0], m2, ti, tj, lane);
    store_rm_bf16(slot[7], m1, ti, tj, lane);
  }
  HALF_BARRIER();
  f32x16 x1 = mm_tile<true, false>(slot[7], slot[6], ti, tj, lane, zero16());
  HALF_BARRIER();
  store_tr_bf16(slot[7], x1, ti, tj, lane);
  if (lw == 0) {
    const int hb = lane >> 5, j = lane & 31, o = hb * 32;
    const bf16_t* M2b = slot[0];
    bf16_t* Tb = slot[1];
    float t[32];
#pragma unroll
    for (int s = 0; s < 32; ++s) {
      float a = (s == j) ? 1.f : 0.f;
#pragma unroll
      for (int i = 0; i < s; ++i) a -= bf2f(M2b[(o + s) * LD + o + i]) * t[i];
      t[s] = a;
    }
#pragma unroll
    for (int s = 0; s < 32; ++s) Tb[(o + s) * LD + o + j] = f2bf(t[s]);
    f32x16 xx = zero16();
    {
      const int r = lane & 31, h = lane >> 5;
#pragma unroll
      for (int ks = 0; ks < 2; ++ks) {
        const int k = ks * 16 + 8 * h;
        xx = mfma32(frag_c(M2b, 32 + r, k), frag_s(Tb, k, r), xx);
      }
#pragma unroll
      for (int g = 0; g < 4; ++g) {
        u32x2 v;
        v[0] = pack2(xx[4 * g], xx[4 * g + 1]);
        v[1] = pack2(xx[4 * g + 2], xx[4 * g + 3]);
        *(u32x2*)(Tb + r * LD + 32 + 8 * g + 4 * h) = v;
      }
      f32x16 t21 = zero16();
#pragma unroll
      for (int ks = 0; ks < 2; ++ks) {
        const int k = ks * 16 + 8 * h;
        t21 = mfma32(frag_c(Tb, 32 + r, 32 + k), frag_c(Tb, r, 32 + k), t21);
      }
#pragma unroll
      for (int g = 0; g < 16; ++g) Tb[(32 + crow(g, h)) * LD + r] = f2bf(-t21[g]);
#pragma unroll
      for (int g = 0; g < 16; ++g) Tb[(g + 16 * h) * LD + 32 + r] = 0;
    }
  }
  HALF_BARRIER();
  f32x16 wm = mm_tile<true, false>(slot[1], slot[2], ti, tj, lane, zero16());
  f32x16 uu = mm_tile<true, true>(slot[1], slot[7], ti, tj, lane, zero16());
  HALF_BARRIER();
  {
    store_tr_bf16(slot[2], wm, ti, tj, lane);
    store_tr_bf16(slot[7], uu, ti, tj, lane);
    f32x16 q1 = mm_tile<true, true>(slot[5], slot[4], ti, tj, lane, zero16());
    f32x16 q2 = mm_tile<true, true>(slot[5], slot[3], ti, tj, lane, zero16());
    const int c = tj * 32 + (lane & 31), h = lane >> 5;
#pragma unroll
    for (int g = 0; g < 16; ++g) {
      const int r = ti * 32 + crow(g, h);
      q1[g] = (r >= c) ? q1[g] : 0.f;
      q2[g] = (r >= c) ? q2[g] : 0.f;
    }
    store_rm_bf16(slot[0], q1, ti, tj, lane);
    store_rm_bf16(slot[1], q2, ti, tj, lane);
  }
  HALF_BARRIER();
  {
    unsigned nxt = 0;
    if (lt == 0) nxt = (unsigned)TASK_Q0 + __hip_atomic_fetch_add((GAS unsigned*)P.qh, 1u, __ATOMIC_RELAXED, __HIP_MEMORY_SCOPE_AGENT);
    const int c = tj * 32 + (lane & 31), h = lane >> 5;
    {
      f32x16 gacc = mm_tile<true, false>(slot[2], slot[3], ti, tj, lane, zero16());
      const float gk = gC[c];
      u32x4 w0, w1;
#pragma unroll
      for (int i = 0; i < 4; ++i) {
        const int ga = 2 * i, gb = 2 * i + 1;
        w0[i] = pack2(gk * (((ti * 32 + crow(ga, h) == c) ? 1.f : 0.f) - gacc[ga]), gk * (((ti * 32 + crow(gb, h) == c) ? 1.f : 0.f) - gacc[gb]));
        w1[i] = pack2(gk * (((ti * 32 + crow(8 + ga, h) == c) ? 1.f : 0.f) - gacc[8 + ga]), gk * (((ti * 32 + crow(8 + gb, h) == c) ? 1.f : 0.f) - gacc[8 + gb]));
      }
      const __amdgpu_buffer_rsrc_t gr = __builtin_amdgcn_make_buffer_rsrc((void*)P.gt, 0, NTASK * 8192, 0x00020000);
      const unsigned o = (unsigned)task * 8192u + (unsigned)(((tj * 4 + 2 * ti) * 64 + lane) * 16);
      __builtin_amdgcn_raw_buffer_store_b128(w0, gr, (int)o, 0, 16);
      __builtin_amdgcn_raw_buffer_store_b128(w1, gr, (int)(o + 1024u), 0, 16);
    }
    __builtin_amdgcn_sched_barrier(0);
    {
      f32x16 h1 = mm_tile<false, false>(slot[4], slot[6], ti, tj, lane, zero16());
      f32x16 h2 = mm_tile<false, true>(slot[3], slot[7], ti, tj, lane, zero16());
      const __amdgpu_buffer_rsrc_t hr = __builtin_amdgcn_make_buffer_rsrc((void*)P.ht, 0, NTASK * 8192, 0x00020000);
      const unsigned o = (unsigned)task * 8192u + (unsigned)((((ti * 2 + tj) * 2) * 64 + lane) * 16);
#pragma unroll
      for (int q = 0; q < 2; ++q) {
        u32x4 w;
#pragma unroll
        for (int e = 0; e < 4; ++e) {
          const int ga = 8 * q + 2 * e, gb = ga + 1;
          w[e] = pack2(gC[ti * 32 + crow(ga, h)] * (h1[ga] - h2[ga]), gC[ti * 32 + crow(gb, h)] * (h1[gb] - h2[gb]));
        }
        __builtin_amdgcn_raw_buffer_store_b128(w, hr, (int)(o + 1024u * q), 0, 16);
      }
    }
    __builtin_amdgcn_sched_barrier(0);
    f32x16 acc = mm_tile<true, true>(slot[1], slot[2], ti, tj, lane, zero16());
    bf16_t* rpp = P.rpp + (size_t)task * 4096;
#pragma unroll
    for (int g = 0; g < 16; ++g) {
      const int r = ti * 32 + crow(g, h);
      const int tt = dir ? 63 - r : r;
      rpp[tt * 64 + c] = f2bf(bf2f(slot[5][r * LD + c]) - acc[g]);
    }
    __builtin_amdgcn_sched_barrier(0);
    f32x16 y1 = mm_tile<true, false>(slot[0], slot[6], ti, tj, lane, zero16());
    f32x16 y2 = mm_tile<true, true>(slot[1], slot[7], ti, tj, lane, zero16());
    float* yl = P.yl + (size_t)task * 4096;
#pragma unroll
    for (int g = 0; g < 16; ++g) {
      const int r = ti * 32 + crow(g, h);
      const int tt = dir ? 63 - r : r;
      yl[tt * 64 + c] = y1[g] - y2[g];
    }
    asm volatile("s_waitcnt vmcnt(0)" ::: "memory");
    if (lt == 0) *hq = nxt;
  }
  HALF_BARRIER();
  if (lt == 0) __hip_atomic_store((GAS unsigned*)(P.flags + fidx), 1u, __ATOMIC_RELAXED, __HIP_MEMORY_SCOPE_AGENT);
}

#undef HALF_BARRIER
DI int p4_task(int n, int dir, int hd) {
  int cc;
  if (dir == 0) cc = (n < 4) ? 256 + n : n - 4;
  else cc = 259 - n;
  return cc * 16 + dir * 8 + hd;
}
DI void p3_dyn(const Params& P, char* smem, int first_q) {
  const int half = __builtin_amdgcn_readfirstlane(fresh_tid() >> 8);
  char* hs = smem + half * (8 * SLOT + 256);
  LAS unsigned* hctr = (LAS unsigned*)(smem + 2 * (8 * SLOT + 256) + 64 * half);
  LAS unsigned* hq = hctr + 4;
  if ((fresh_tid() & 255) == 0) {
    *hctr = 0u;
    *hq = (first_q >= 0) ? (unsigned)(first_q + half) : (unsigned)TASK_Q0 + __hip_atomic_fetch_add((GAS unsigned*)P.qh, 1u, __ATOMIC_RELAXED, __HIP_MEMORY_SCOPE_AGENT);
  }
  unsigned hgen = 0;
  __syncthreads();
  unsigned cur = __builtin_amdgcn_readfirstlane(*hq);
  while (cur < (unsigned)NTASK) {
    const int n = (int)(cur >> 4), combo = (int)(cur & 15u);
    phase3_task(P, hs, p4_task(n, combo >> 3, combo & 7), fresh_tid() & 255, hctr, hgen, hq, combo * FSTR + n);
    cur = __builtin_amdgcn_readfirstlane(*hq);
  }
  __syncthreads();
}

struct P4Buf { bf16x8 g[4]; u32x4 hp[2]; unsigned pend; int pbase; };
struct P4Poll { int ready; unsigned spins; };
DI void p4_poll_take(P4Poll& Q, unsigned pend, int pbase, int lane) {
  const unsigned long long m = __ballot(pend != 0u && pbase + lane < NCH);
  const int cnt = (~m == 0ull) ? 64 : (__ffsll((long long)~m) - 1);
  const int r = __builtin_amdgcn_readfirstlane(pbase + cnt);
  if (r > Q.ready) Q.ready = r;
}
DI void p4_load(const Params& P, P4Buf& B, P4Poll& Q, int n, int chain, int ti, int tj, int lane) {
  B.pend = 0u; B.pbase = 0;
  if (n >= NCH) return;
  const int task = p4_task(n, chain >> 3, chain & 7);
  const GAS unsigned* fl = (const GAS unsigned*)(P.flags + chain * FSTR) + lane;
  while (Q.ready <= n) {
    const int pb = Q.ready;
    const unsigned pend = __hip_atomic_load(fl + pb, __ATOMIC_RELAXED, __HIP_MEMORY_SCOPE_AGENT);
    p4_poll_take(Q, pend, pb, lane);
    if (Q.ready > n) break;
    if (++Q.spins > (1u << 21)) break;
    __builtin_amdgcn_s_sleep(2);
  }
  asm volatile("" ::: "memory");
  B.pbase = Q.ready;
  B.pend = __hip_atomic_load(fl + Q.ready, __ATOMIC_RELAXED, __HIP_MEMORY_SCOPE_AGENT);
  const __amdgpu_buffer_rsrc_t gr = __builtin_amdgcn_make_buffer_rsrc((void*)P.gt, 0, NTASK * 8192, 0x00020000);
  const __amdgpu_buffer_rsrc_t hr = __builtin_amdgcn_make_buffer_rsrc((void*)P.ht, 0, NTASK * 8192, 0x00020000);
  const unsigned og = (unsigned)task * 8192u + (unsigned)(((ti * 4) * 64 + lane) * 16);
  const unsigned oh = (unsigned)task * 8192u + (unsigned)((((ti * 2 + tj) * 2) * 64 + lane) * 16);
#pragma unroll
  for (int ks = 0; ks < 4; ++ks) B.g[ks] = __builtin_bit_cast(bf16x8, __builtin_amdgcn_raw_buffer_load_b128(gr, (int)(og + 1024u * ks), 0, 16));
#pragma unroll
  for (int q = 0; q < 2; ++q) B.hp[q] = __builtin_amdgcn_raw_buffer_load_b128(hr, (int)(oh + 1024u * q), 0, 16);
}
DI void p4_step(const Params& P, const P4Buf& B, P4Poll& Q, bf16_t* Scur, bf16_t* Snext, int n, int dir, int hd, int tid, int ti, int tj, int lane) {
  const int task = p4_task(n, dir, hd);
  const int r = lane & 31, h = lane >> 5;
  {
    const int v = tid >> 2, sg = (tid & 3) * 16;
    u32x4 a = *(const u32x4*)(Scur + v * LD + sg), b = *(const u32x4*)(Scur + v * LD + sg + 8);
    bf16_t* dst = P.s0 + (size_t)task * 4096 + v * 64 + sg;
    *(u32x4*)dst = a;
    *(u32x4*)(dst + 8) = b;
  }
  f32x16 acc;
#pragma unroll
  for (int q = 0; q < 2; ++q)
#pragma unroll
    for (int e = 0; e < 4; ++e) { acc[8 * q + 2 * e] = __uint_as_float(B.hp[q][e] << 16); acc[8 * q + 2 * e + 1] = __uint_as_float(B.hp[q][e] & 0xFFFF0000u); }
#pragma unroll
  for (int ks = 0; ks < 4; ++ks) {
    const bf16_t* sp = Scur + (tj * 32 + r) * LD + 16 * ks + 4 * h;
    const u32x2 lo = *(const u32x2*)sp, hi = *(const u32x2*)(sp + 8);
    u32x4 bb; bb[0] = lo[0]; bb[1] = lo[1]; bb[2] = hi[0]; bb[3] = hi[1];
    acc = mfma32(B.g[ks], __builtin_bit_cast(bf16x8, bb), acc);
  }
  store_tr_bf16(Snext, acc, ti, tj, lane);
  p4_poll_take(Q, B.pend, B.pbase, lane);
}
DI void scan_chains(const Params& P, char* smem) {
  const int tid = fresh_tid();
  const int chain = blockIdx.x, dir = chain >> 3, hd = chain & 7;
  bf16_t* S0b = (bf16_t*)smem;
  bf16_t* S1b = (bf16_t*)(smem + SLOT);
  const int lw = tid >> 6, lane = tid & 63, ti = lw >> 1, tj = lw & 1;
  const bool work = tid < 256;
  P4Poll Q; Q.ready = 0; Q.spins = 0u;
  if (work) {
    for (int i = tid; i < 64 * LD; i += 256) S0b[i] = 0;
  }
  P4Buf B0, B1, B2, B3;
  if (work) {
    p4_load(P, B0, Q, 0, chain, ti, tj, lane);
    p4_load(P, B1, Q, 1, chain, ti, tj, lane);
    p4_load(P, B2, Q, 2, chain, ti, tj, lane);
    p4_load(P, B3, Q, 3, chain, ti, tj, lane);
  }
  __syncthreads();
  for (int n = 0; n < NCH; n += 4) {
    if (work) { p4_step(P, B0, Q, S0b, S1b, n, dir, hd, tid, ti, tj, lane); p4_load(P, B0, Q, n + 4, chain, ti, tj, lane); }
    __syncthreads();
    if (work) { p4_step(P, B1, Q, S1b, S0b, n + 1, dir, hd, tid, ti, tj, lane); p4_load(P, B1, Q, n + 5, chain, ti, tj, lane); }
    __syncthreads();
    if (work) { p4_step(P, B2, Q, S0b, S1b, n + 2, dir, hd, tid, ti, tj, lane); p4_load(P, B2, Q, n + 6, chain, ti, tj, lane); }
    __syncthreads();
    if (work) { p4_step(P, B3, Q, S1b, S0b, n + 3, dir, hd, tid, ti, tj, lane); p4_load(P, B3, Q, n + 7, chain, ti, tj, lane); }
    __syncthreads();
  }
}

DI void phase34(const Params& P, char* smem) {
  const int b = blockIdx.x;
  if (b < 16) {
    scan_chains(P, smem);
    prep_queue(P, smem);
  } else if (b < 16 + NPREPB) {
    prep_queue(P, smem);
    p3_dyn(P, smem, -1);
  } else {
    p3_dyn(P, smem, (b - 16 - NPREPB) * 2);
    prep_queue(P, smem);
  }
}

DI void unpack8(const u32x4& w, float* o) {
#pragma unroll
  for (int i = 0; i < 4; ++i) { o[2 * i] = __uint_as_float(w[i] << 16); o[2 * i + 1] = __uint_as_float(w[i] & 0xFFFF0000u); }
}
DI void phase5(const Params& P, char* smem) {
  bf16_t* SG = (bf16_t*)smem;
  bf16_t* VS = (bf16_t*)(smem + 17408);
  float* BON = (float*)(smem + 17408 + 66560);
  constexpr int LG = 136, LV = 520;
  for (int cc = blockIdx.x; cc < 256; cc += gridDim.x) {
    const int tid = fresh_tid();
    const int wid = __builtin_amdgcn_readfirstlane(tid >> 6);
    const int rb = cc * 64;
    {
      const int c = (tid & 63) * 8, t0 = (tid >> 6) * 8;
      float z[10][8];
#pragma unroll
      for (int i = 0; i < 10; ++i) {
        const int t = t0 - 1 + i;
        if (t >= 0 && t < 64) {
          const bf16_t* pr = P.p + (size_t)(rb + t) * PIN + c;
          float cg[8], vv[8];
          unpack8(*(const u32x4*)(pr + 512), cg);
          unpack8(*(const u32x4*)(pr + 1024), vv);
#pragma unroll
          for (int j = 0; j < 8; ++j) z[i][j] = cg[j] * vv[j];
        } else {
#pragma unroll
          for (int j = 0; j < 8; ++j) z[i][j] = 0.f;
        }
      }
      float w0[8], w1[8], w2[8];
#pragma unroll
      for (int j = 0; j < 8; ++j) { w0[j] = P.conv_w[c + j]; w1[j] = P.conv_w[512 + c + j]; w2[j] = P.conv_w[1024 + c + j]; }
#pragma unroll
      for (int i = 0; i < 8; ++i) {
        float bg[8];
        unpack8(*(const u32x4*)(P.p + (size_t)(rb + t0 + i) * PIN + c), bg);
        u32x4 o;
#pragma unroll
        for (int j = 0; j < 4; ++j) {
          const float y0 = bg[2 * j] * (w0[2 * j] * z[i][2 * j] + w1[2 * j] * z[i + 1][2 * j] + w2[2 * j] * z[i + 2][2 * j]);
          const float y1 = bg[2 * j + 1] * (w0[2 * j + 1] * z[i][2 * j + 1] + w1[2 * j + 1] * z[i + 1][2 * j + 1] + w2[2 * j + 1] * z[i + 2][2 * j + 1]);
          o[j] = pack2(y0, y1);
        }
        *(u32x4*)(P.mixin + (size_t)(rb + t0 + i) * D + c) = o;
      }
    }
    {
      float tmp[16];
      const int row = tid >> 3, cs = (tid & 7) * 16;
      ShiftRaw rg, rq[4];
      shift_raw(P, rb + row, 0, L, 3328 + cs, rg);
#pragma unroll
      for (int q = 0; q < 4; ++q) shift_raw(P, rb + row, 0, L, PRW0 + 1024 + (tid & 7) * 64 + q * 16, rq[q]);
      shift_finish(P, rg, 3328 + cs, tmp);
#pragma unroll
      for (int i = 0; i < 16; ++i) tmp[i] = sigm(tmp[i]);
      st16_bf16(SG + row * LG + cs, tmp);
#pragma unroll
      for (int q = 0; q < 4; ++q) {
        const int vc = (tid & 7) * 64 + q * 16;
        shift_finish(P, rq[q], PRW0 + 1024 + vc, tmp);
        st16_bf16(VS + row * LV + vc, tmp);
      }
      const int t = tid >> 3, hd = tid & 7;
      BON[t * 8 + hd] = P.bon[(size_t)(rb + t) * 8 + hd] + P.bon[((size_t)L + rb + t) * 8 + hd];
    }
    __syncthreads();
    const int hd = wid;
#pragma unroll 1
    for (int ti = 0; ti < 2; ++ti) {
      int lane = tid & 63;
      asm volatile("" : "+v"(lane));
      const int r = lane & 31, h = lane >> 5;
      f32x16 y[2], gg[2];
#pragma unroll
      for (int tj = 0; tj < 2; ++tj) {
        f32x16 acc;
        const int c = tj * 32 + r;
        const float* yl0 = P.yl + (size_t)(cc * 16 + hd) * 4096;
        const float* yl1 = P.yl + (size_t)(cc * 16 + 8 + hd) * 4096;
#pragma unroll
        for (int g = 0; g < 16; ++g) {
          const int row = ti * 32 + crow(g, h);
          acc[g] = yl0[row * 64 + c] + yl1[row * 64 + c];
        }
#pragma unroll
        for (int d = 0; d < 2; ++d) {
          const size_t task = (size_t)cc * 16 + d * 8 + hd;
          const bf16_t* rp = P.rpp + task * 4096;
          const bf16_t* s0 = P.s0 + task * 4096;
#pragma unroll
          for (int ks = 0; ks < 4; ++ks) {
            const int k = ks * 16 + 8 * h;
            bf16x8 a = *(const bf16x8*)(rp + (ti * 32 + r) * 64 + k);
            bf16x8 b = *(const bf16x8*)(s0 + (tj * 32 + r) * 64 + k);
            acc = mfma32(a, b, acc);
          }
        }
        y[tj] = acc;
        gg[tj] = zero16();
      }
#pragma unroll
      for (int ks = 0; ks < 8; ++ks) {
        const int k = ks * 16 + 8 * h;
        bf16x8 a = frag_c(SG, ti * 32 + r, k, LG);
#pragma unroll
        for (int tj = 0; tj < 2; ++tj) {
          bf16x8 bfr = *(const bf16x8*)(P.gateT + (size_t)(64 * hd + tj * 32 + r) * 128 + k);
          gg[tj] = mfma32(a, bfr, gg[tj]);
        }
      }
      float gw[2], gb[2];
#pragma unroll
      for (int tj = 0; tj < 2; ++tj) {
        const int ch = 64 * hd + tj * 32 + r;
        gw[tj] = P.gn_w[ch];
        gb[tj] = P.gn_b[ch];
      }
#pragma unroll
      for (int g = 0; g < 16; ++g) {
        float sacc = y[0][g] + y[1][g];
#pragma unroll
        for (int o = 16; o > 0; o >>= 1) sacc += __shfl_xor(sacc, o);
        const float mean = sacc * (1.f / 64.f);
        const float d0 = y[0][g] - mean, d1 = y[1][g] - mean;
        float v = d0 * d0 + d1 * d1;
#pragma unroll
        for (int o = 16; o > 0; o >>= 1) v += __shfl_xor(v, o);
        const float rstd = __builtin_amdgcn_rsqf(v * (1.f / 64.f) + 64e-5f);
        const int tl = ti * 32 + crow(g, h);
        const float bonus = BON[tl * 8 + hd];
#pragma unroll
        for (int tj = 0; tj < 2; ++tj) {
          const int ch = 64 * hd + tj * 32 + r;
          const float vs = bf2f(VS[tl * LV + ch]);
          const float dn = (tj ? d1 : d0) * rstd * gw[tj] + gb[tj];
          P.mixin[(size_t)(rb + tl) * D + 512 + ch] = f2bf((dn + bonus * vs) * gg[tj][g]);
        }
      }
    }
    __syncthreads();
  }
}

struct SchedRows : g8::DenseOrder {
  static constexpr int PF_LINES = 0;
  DI void pf(const g8::Unit2&, LAS unsigned char*, int) const {}
  DI void aoffs_late(const g8::Unit2& u, LAS unsigned char*, int, int R0, int R1, int C0, int C1, unsigned (&o)[2][2]) const { aoffs(u, R0, R1, C0, C1, o); }
  const bf16_t* A; const bf16_t* Bt;
  DI const char* abase() const { return (const char*)A; }
  DI const char* bbase(const g8::Unit2& u) const { return (const char*)(Bt + (size_t)u.pn * 256 * D); }
  DI void aoffs(const g8::Unit2& u, int R0, int R1, int C0, int C1, unsigned (&o)[2][2]) const {
#pragma unroll
    for (int h = 0; h < 2; ++h) {
      o[h][0] = (unsigned)(((u.pm * 256 + h * 128 + R0) * D + C0) * 2);
      o[h][1] = (unsigned)(((u.pm * 256 + h * 128 + R1) * D + C1) * 2);
    }
  }
};
DI void phase6(const Params& P, char* smem) {
  SchedRows S; S.init(L / 256, D / 256, gridDim.x, blockIdx.x); S.A = P.mixin; S.Bt = P.woutT;
  g8::gemm<g8::Unit2>((LAS unsigned char*)smem, S,
      [&](const g8::Acc& acc, const g8::Unit2& u, int wr, int wc, int fr, int fq, int) {
        const float* g1 = P.mod + 2048 + u.pn * 256 + wc * 32 + 4 * fq;
#pragma unroll
        for (int ai = 0; ai < 2; ++ai)
#pragma unroll
          for (int m = 0; m < 4; ++m) {
            const size_t ro = (size_t)(u.pm * 256 + ai * 128 + wr * 64 + m * 16 + fr) * D + u.pn * 256 + wc * 32 + 4 * fq;
#pragma unroll
            for (int bj = 0; bj < 2; ++bj)
#pragma unroll
              for (int n = 0; n < 2; ++n) {
                const f32x4 gv = *(const f32x4*)(g1 + bj * 128 + n * 16);
                const f32x4 xv = *(const f32x4*)(P.x + ro + bj * 128 + n * 16);
                *(f32x4*)(P.x1 + ro + bj * 128 + n * 16) = xv + gv * acc[ai][bj][m][n];
              }
          }
      }, D);
}

DI void phase8(const Params& P, char* smem) {
  if (blockIdx.x >= 192) { prep_range(P, smem, NW2 * B2 + ((int)blockIdx.x - 192) * B8, B8); return; }
  SchedRows S; S.init(L / 256, 3, gridDim.x, blockIdx.x); S.A = P.h2; S.Bt = P.rsT;
  g8::gemm<g8::Unit2>((LAS unsigned char*)smem, S,
      [&](const g8::Acc& acc, const g8::Unit2& u, int wr, int wc, int fr, int fq, int) {
#pragma unroll
        for (int ai = 0; ai < 2; ++ai)
#pragma unroll
          for (int m = 0; m < 4; ++m) {
            const int row = u.pm * 256 + ai * 128 + wr * 64 + m * 16 + fr;
            if (u.pn == 0) {
              float* rp = P.logits + (size_t)row * NE + wc * 32 + 4 * fq;
#pragma unroll
              for (int bj = 0; bj < 2; ++bj)
#pragma unroll
                for (int n = 0; n < 2; ++n) *(f32x4*)(rp + bj * 128 + n * 16) = acc[ai][bj][m][n];
            } else {
              bf16_t* ap = P.act + ((size_t)row * NSLOT + 8) * DE + (u.pn - 1) * 128 + 4 * fq;
#pragma unroll
              for (int bj = 0; bj < 2; ++bj) {
                const f32x4 a = acc[ai][bj][m][0], bb = acc[ai][bj][m][1];
                u32x2 w;
                w[0] = pack2(siluf(a[0]) * bb[0], siluf(a[1]) * bb[1]);
                w[1] = pack2(siluf(a[2]) * bb[2], siluf(a[3]) * bb[3]);
                *(u32x2*)(ap + 16 * (4 * bj + wc)) = w;
              }
            }
          }
      }, D);
}

DI void phase9(const Params& P) {
  const int tid_ = fresh_tid();
  const int wid = tid_ >> 6, lane = tid_ & 63;
  for (int tok = blockIdx.x * 8 + wid; tok < L; tok += gridDim.x * 8) {
    float sc[4], bs[4];
#pragma unroll
    for (int q = 0; q < 4; ++q) {
      sc[q] = sigm(P.logits[(size_t)tok * NE + q * 64 + lane]);
      bs[q] = sc[q] + P.router_bias[q * 64 + lane];
    }
    int sel_i[8];
    float sel_s[8], ssum = 0.f;
#pragma unroll
    for (int j = 0; j < 8; ++j) {
      float best = bs[0];
      int bq = 0;
#pragma unroll
      for (int q = 1; q < 4; ++q)
        if (bs[q] > best) { best = bs[q]; bq = q; }
      float m = best;
#pragma unroll
      for (int o = 32; o > 0; o >>= 1) m = fmaxf(m, __shfl_xor(m, o));
      const unsigned long long msk = __ballot(best == m);
      const int ol = __ffsll((long long)msk) - 1;
      const int q = __shfl(bq, ol);
      const float cand = (q == 0) ? sc[0] : (q == 1) ? sc[1] : (q == 2) ? sc[2] : sc[3];
      const float s = __shfl(cand, ol);
#pragma unroll
      for (int qq = 0; qq < 4; ++qq) bs[qq] = (lane == ol && q == qq) ? -1e30f : bs[qq];
      sel_i[j] = q * 64 + ol;
      sel_s[j] = s;
      ssum += s;
    }
    const float inv = 2.5f / ssum;
    int my_e = 0;
    float my_g = 0.f;
#pragma unroll
    for (int j = 0; j < 8; ++j)
      if (lane == j) { my_e = sel_i[j]; my_g = sel_s[j] * inv; }
    if (lane < 8) {
      const int pos = atomicAdd(&P.cnt[my_e], 1);
      P.lid[(size_t)my_e * L + pos] = tok * NSLOT + lane;
      P.lgate[(size_t)my_e * L + pos] = my_g;
    }
  }
}

DI int moe_prefix(const Params& P, int* pre, int tid) {
  if (tid == 0) {
    int s = 0;
    for (int e = 0; e < 257; ++e) {
      pre[e] = s;
      const int c = (e < 256) ? P.cnt[e] : L;
      s += (c + 255) >> 8;
    }
    pre[257] = s;
  }
  __syncthreads();
  return pre[257];
}
DI int find_expert(const int* pre, int mt) {
  int lo = 0, hi = 256;
  while (lo < hi) {
    const int mid = (lo + hi + 1) >> 1;
    if (pre[mid] <= mt) lo = mid; else hi = mid - 1;
  }
  return lo;
}
DI int row_id(const Params& P, int e, int gi, int cnt) {
  const int g = gi < cnt ? gi : cnt - 1;
  return (e < 256) ? P.lid[(size_t)e * L + g] : g * NSLOT + 8;
}

struct UnitM { int e, mt, nt, cnt; };
template <int NN, int NEXP, int KD>
struct SchedMoe {
  static constexpr int PF_LINES = 0;
  const Params* P; const int* pre; int total, G, c;
  const bf16_t* A; const bf16_t* Bt;
  DI bool compute(int i, UnitM& u) const {
    const int U = total * NN, CH = (U + 7) >> 3;
    const int k = (c >> 3) + (G >> 3) * i;
    if (k >= CH) return false;
    const long Lx = (long)(c & 7) * CH + k; if (Lx >= U) return false;
    const int mtg = (int)(Lx / NN); u.nt = (int)(Lx % NN);
    u.e = find_expert(pre, mtg);
    u.mt = mtg - pre[u.e];
    u.cnt = pre[260 + u.e];
    return true;
  }
  DI void tabulate(int tid) const {
    if (tid < 16) {
      UnitM u; u.e = -1; u.mt = 0; u.nt = 0; u.cnt = 0;
      (void)compute(tid, u);
      int* tb = const_cast<int*>(pre) + 800 + tid * 4;
      tb[0] = u.e; tb[1] = u.mt; tb[2] = u.nt; tb[3] = u.cnt;
    }
    __syncthreads();
  }
  DI bool next(int i, UnitM& u) const {
    if (i >= 16) return false;
    const int* tb = pre + 800 + i * 4;
    u.e = __builtin_amdgcn_readfirstlane(tb[0]);
    if (u.e < 0) return false;
    u.mt = __builtin_amdgcn_readfirstlane(tb[1]);
    u.nt = __builtin_amdgcn_readfirstlane(tb[2]);
    u.cnt = __builtin_amdgcn_readfirstlane(tb[3]);
    return true;
  }
  static constexpr int IDS_OFF = 144384;
  DI void pf(const UnitM& u, LAS unsigned char* lds, int buf) const {
    const int tid = fresh_tid(), wid = __builtin_amdgcn_readfirstlane(tid >> 6);
    if (tid < 256) {
      const int gi = u.mt * 256 + tid, gc = gi < u.cnt ? gi : u.cnt - 1;
      const int* src = (u.e < 256) ? P->lid + (size_t)u.e * L + gc : P->ident + gc;
      __builtin_amdgcn_global_load_lds((const unsigned*)src, (LAS unsigned*)(lds + IDS_OFF + buf * 2048 + wid * 256), 4, 0, 0);
      if (KD != D) {
        const float* gs = (u.e < 256) ? P->lgate + (size_t)u.e * L + gc : P->ones;
        __builtin_amdgcn_global_load_lds((const unsigned*)gs, (LAS unsigned*)(lds + IDS_OFF + buf * 2048 + 1024 + wid * 256), 4, 0, 0);
      }
    }
  }
  DI void aoffs_late(const UnitM& u, LAS unsigned char* lds, int buf, int R0, int R1, int C0, int C1, unsigned (&o)[2][2]) const {
    const LAS int* ids = (const LAS int*)(lds + IDS_OFF + buf * 2048);
#pragma unroll
    for (int h = 0; h < 2; ++h) {
      const int i0 = ids[h * 128 + R0], i1 = ids[h * 128 + R1];
      o[h][0] = (unsigned)((KD == D) ? (i0 / NSLOT) : i0) * (unsigned)(KD * 2) + C0 * 2;
      o[h][1] = (unsigned)((KD == D) ? (i1 / NSLOT) : i1) * (unsigned)(KD * 2) + C1 * 2;
    }
  }
  DI const char* abase() const { return (const char*)A; }
  DI const char* bbase(const UnitM& u) const { return (const char*)(Bt + ((size_t)u.e * NN + u.nt) * 256 * KD); }
  DI unsigned arow(const UnitM& u, int r) const {
    const int id = row_id(*P, u.e, u.mt * 256 + r, u.cnt);
    return (unsigned)((KD == D) ? (id / NSLOT) : id) * (unsigned)(KD * 2);
  }
  DI void aoffs(const UnitM& u, int R0, int R1, int C0, int C1, unsigned (&o)[2][2]) const {
#pragma unroll
    for (int h = 0; h < 2; ++h) { o[h][0] = arow(u, h * 128 + R0) + C0 * 2; o[h][1] = arow(u, h * 128 + R1) + C1 * 2; }
  }
};
DI int moe_prefix_n(const Params& P, int* pre, int tid, int nexp) {
  int* tl = pre + 520;
  if (tid < 258) {
    const int c = (tid < 256) ? P.cnt[tid] : L;
    pre[260 + tid] = c;
    tl[tid] = (tid < nexp) ? ((c + 255) >> 8) : 0;
  }
  __syncthreads();
  if (tid < 258) {
    int sacc = 0;
    for (int e = 0; e < tid; ++e) sacc += tl[e];
    pre[tid] = sacc;
  }
  __syncthreads();
  return __builtin_amdgcn_readfirstlane(pre[257]);
}
DI void phase10(const Params& P, char* smem) {
  int* pre = (int*)(smem + 137216);
  SchedMoe<2, 256, D> S;
  S.total = moe_prefix_n(P, pre, fresh_tid(), 256);
  S.P = &P; S.pre = pre; S.G = gridDim.x; S.c = blockIdx.x; S.A = P.h2; S.Bt = P.w13T;
  S.tabulate(fresh_tid());
  g8::gemm<UnitM>((LAS unsigned char*)smem, S,
      [&](const g8::Acc& acc, const UnitM& u, int wr, int wc, int fr, int fq, int buf) {
        const int* IDS = (const int*)(smem + 144384 + buf * 2048);
#pragma unroll
        for (int ai = 0; ai < 2; ++ai)
#pragma unroll
          for (int m = 0; m < 4; ++m) {
            const int gi = u.mt * 256 + ai * 128 + wr * 64 + m * 16 + fr;
            if (gi < u.cnt) {
              bf16_t* ap = P.act + (size_t)IDS[ai * 128 + wr * 64 + m * 16 + fr] * DE + u.nt * 128 + 4 * fq;
#pragma unroll
              for (int bj = 0; bj < 2; ++bj) {
                const f32x4 a = acc[ai][bj][m][0], bb = acc[ai][bj][m][1];
                u32x2 w;
                w[0] = pack2(siluf(a[0]) * bb[0], siluf(a[1]) * bb[1]);
                w[1] = pack2(siluf(a[2]) * bb[2], siluf(a[3]) * bb[3]);
                *(u32x2*)(ap + 16 * (4 * bj + wc)) = w;
              }
            }
          }
      }, D);
}

DI void phase11(const Params& P, char* smem) {
  int* pre = (int*)(smem + 137216);
  SchedMoe<4, 257, DE> S;
  S.total = moe_prefix_n(P, pre, fresh_tid(), 257);
  S.P = &P; S.pre = pre; S.G = gridDim.x; S.c = blockIdx.x; S.A = P.act; S.Bt = P.w2T;
  S.tabulate(fresh_tid());
  g8::gemm<UnitM>((LAS unsigned char*)smem, S,
      [&](const g8::Acc& acc, const UnitM& u, int wr, int wc, int fr, int fq, int buf) {
        const int* IDS = (const int*)(smem + 144384 + buf * 2048);
        const float* GTS = (const float*)(smem + 144384 + buf * 2048 + 1024);
#pragma unroll
        for (int ai = 0; ai < 2; ++ai)
#pragma unroll
          for (int m = 0; m < 4; ++m) {
            const int gi = u.mt * 256 + ai * 128 + wr * 64 + m * 16 + fr;
            if (gi < u.cnt) {
              const int row = ai * 128 + wr * 64 + m * 16 + fr;
              const float gate = GTS[row] * SLAB_SCALE;
              unsigned char* sp = P.slab + (size_t)IDS[row] * D + u.nt * 256 + wc * 64 + 16 * fq;
              u32x4 w;
#pragma unroll
              for (int bj = 0; bj < 2; ++bj)
#pragma unroll
                for (int n = 0; n < 2; ++n) {
                  const f32x4 v = acc[ai][bj][m][n];
                  int q = 0;
                  q = __builtin_amdgcn_cvt_pk_fp8_f32(__builtin_amdgcn_fmed3f(gate * v[0], -440.f, 440.f), __builtin_amdgcn_fmed3f(gate * v[1], -440.f, 440.f), q, false);
                  q = __builtin_amdgcn_cvt_pk_fp8_f32(__builtin_amdgcn_fmed3f(gate * v[2], -440.f, 440.f), __builtin_amdgcn_fmed3f(gate * v[3], -440.f, 440.f), q, true);
                  w[2 * bj + n] = (unsigned)q;
                }
              *(u32x4*)sp = w;
            }
          }
      }, DE);
}

DI void phase12(const Params& P) {
  const int tid_ = fresh_tid();
  const int wid = tid_ >> 6, lane = tid_ & 63;
  const float* g2 = P.mod + 5120;
  for (int row = blockIdx.x * 8 + wid; row < L; row += gridDim.x * 8) {
    float v[2][8];
    float ss = 0.f;
#pragma unroll
    for (int i = 0; i < 2; ++i) {
      const int c = i * 512 + lane * 8;
      float sacc[8];
#pragma unroll
      for (int j = 0; j < 8; ++j) sacc[j] = 0.f;
#pragma unroll
      for (int j = 0; j < NSLOT; ++j) {
        const u32x2 w = __builtin_nontemporal_load((const u32x2*)(P.slab + ((size_t)row * NSLOT + j) * D + c));
#pragma unroll
        for (int e = 0; e < 2; ++e) {
          const f32x2v lo = __builtin_amdgcn_cvt_pk_f32_fp8((int)w[e], false), hi = __builtin_amdgcn_cvt_pk_f32_fp8((int)w[e], true);
          sacc[4 * e] += lo[0]; sacc[4 * e + 1] += lo[1]; sacc[4 * e + 2] += hi[0]; sacc[4 * e + 3] += hi[1];
        }
      }
      const f32x4 x0 = *(const f32x4*)(P.x1 + (size_t)row * D + c), x1v = *(const f32x4*)(P.x1 + (size_t)row * D + c + 4);
      const f32x4 g0 = *(const f32x4*)(g2 + c), g1v = *(const f32x4*)(g2 + c + 4);
#pragma unroll
      for (int j = 0; j < 4; ++j) {
        v[i][j] = x0[j] + g0[j] * (sacc[j] * (1.f / SLAB_SCALE));
        v[i][4 + j] = x1v[j] + g1v[j] * (sacc[4 + j] * (1.f / SLAB_SCALE));
        ss += v[i][j] * v[i][j] + v[i][4 + j] * v[i][4 + j];
      }
    }
    ss = wave_sum(ss);
    const float rs = __builtin_amdgcn_rsqf(ss * (1.f / 1024.f) + 1e-6f);
#pragma unroll
    for (int i = 0; i < 2; ++i) {
      const int c = i * 512 + lane * 8;
      const f32x4 f0 = *(const f32x4*)(P.final_g + c), f1 = *(const f32x4*)(P.final_g + c + 4);
      f32x4 o0, o1;
#pragma unroll
      for (int j = 0; j < 4; ++j) { o0[j] = v[i][j] * rs * f0[j]; o1[j] = v[i][4 + j] * rs * f1[j]; }
      __builtin_nontemporal_store(o0, (f32x4*)(P.out + (size_t)row * D + c));
      __builtin_nontemporal_store(o1, (f32x4*)(P.out + (size_t)row * D + c + 4));
    }
  }
}

__global__ void __launch_bounds__(NTHR) mega(Params P) {
  cg::grid_group grid = cg::this_grid();
  extern __shared__ __attribute__((aligned(16))) char smem[];
  volatile LAS unsigned* xst = (volatile LAS unsigned*)(smem + kDynLds - 16);
  if (threadIdx.x < 4) xst[threadIdx.x] = 0u;
  __syncthreads();
  XcdBarrier xb = xcd_barrier_post(P.bar, xst);
  prep_dense(P, smem);
  phase0(P, smem);
  if (P.coop_probe) grid.sync();
  xcd_barrier(xb);
  phase1(P);
  xcd_barrier(xb);
  phase2(P, smem);
  xcd_barrier(xb);
  phase34(P, smem);
  xcd_barrier(xb);
  phase5(P, smem);
  xcd_barrier(xb);
  phase6(P, smem);
  xcd_barrier(xb);
  phase7(P);
  xcd_barrier(xb);
  phase8(P, smem);
  xcd_barrier(xb);
  phase9(P);
  xcd_barrier(xb);
  phase10(P, smem);
  xcd_barrier(xb);
  phase11(P, smem);
  xcd_barrier(xb);
  phase12(P);
}

extern "C" void kernel_launch(void* const* d_in, const int* in_sizes, int n_in, void* d_out, int out_size, void* d_ws,
                              size_t ws_size, hipStream_t stream) {
  static int grid_blocks = 0;
  if (!grid_blocks) {
    int dev = 0, cus = 0, per_cu = 0;
    (void)hipGetDevice(&dev);
    (void)hipDeviceGetAttribute(&cus, hipDeviceAttributeMultiprocessorCount, dev);
    (void)hipFuncSetAttribute((const void*)mega, hipFuncAttributeMaxDynamicSharedMemorySize, (int)kDynLds);
    (void)hipOccupancyMaxActiveBlocksPerMultiprocessor(&per_cu, mega, NTHR, kDynLds);
    if (per_cu > 1) per_cu = 1;
    grid_blocks = cus * per_cu;
  }
  Params P{};
  const float* const* in = (const float* const*)d_in;
  P.x = in[0]; P.c = in[1]; P.ctx = in[2]; P.c_ctx = in[3]; P.ada_w = in[4]; P.ada_b = in[5]; P.norm1_g = in[6]; P.norm2_g = in[7];
  P.w_in = in[8]; P.conv_w = in[9]; P.shift_mu = in[10]; P.decay_w0 = in[11]; P.decay_up = in[12]; P.iclr_a0 = in[13];
  P.iclr_up = in[14]; P.key_xi = in[15]; P.key_alpha = in[16]; P.bonus_rho = in[17]; P.gate_up = in[18]; P.gn_w = in[19];
  P.gn_b = in[20]; P.w_out = in[21]; P.router_w = in[22]; P.router_bias = in[23]; P.exp_w1 = in[24]; P.exp_w3 = in[25];
  P.exp_w2 = in[26]; P.sh_w1 = in[27]; P.sh_w3 = in[28]; P.sh_w2 = in[29]; P.final_g = in[30];
  P.out = (float*)d_out;
  char* w = (char*)d_ws;
  size_t off = 0;
  auto take = [&](size_t bytes) { char* r = w + off; off += (bytes + 255) & ~(size_t)255; return r; };
  P.mod = (float*)take(6144 * 4);
  P.modc = (float*)take(6144 * 4);
  P.cnt = (int*)take(272 * 4);
  P.bar = (unsigned*)take((XCD_BAR_WORDS + 64 + 16 * FSTR) * 4);
  P.qh = P.bar + XCD_BAR_WORDS;
  P.flags = P.qh + 64;
  P.ident = (int*)take((size_t)L * 4);
  P.ones = (float*)take(1024);
  P.winT = (bf16_t*)take((size_t)PIN * D * 2);
  P.woutT = (bf16_t*)take((size_t)D * D * 2);
  P.rsT = (bf16_t*)take((size_t)768 * D * 2);
  P.gateT = (bf16_t*)take((size_t)512 * 128 * 2);
  P.bon = (float*)take((size_t)2 * L * 8 * 4);
  P.mixin = (bf16_t*)take((size_t)L * D * 2);
  P.w2T = (bf16_t*)take((size_t)257 * D * DE * 2);
  {
    const size_t r1 = off;
    P.hx = (bf16_t*)take((size_t)LT * D * 2);
    P.p = (bf16_t*)take((size_t)LT * PIN * 2 + 65536);
    const size_t r1_end = off;
    off = r1;
    P.x1 = (float*)take((size_t)L * D * 4);
    if (off < r1_end) off = r1_end;
  }
  {
    const size_t r2 = off;
    P.rpp = (bf16_t*)take((size_t)NTASK * 4096 * 2);
    P.yl = (float*)take((size_t)NTASK * 4096 * 4);
    P.gt = (bf16_t*)take((size_t)NTASK * 4096 * 2);
    P.ht = (bf16_t*)take((size_t)NTASK * 4096 * 2);
    P.s0 = (bf16_t*)take((size_t)NTASK * 4096 * 2);
    const size_t r2_end = off;
    off = r2;
    P.h2 = (bf16_t*)take((size_t)L * D * 2);
    P.logits = (float*)take((size_t)L * NE * 4);
    P.lid = (int*)take((size_t)NE * L * 4);
    P.lgate = (float*)take((size_t)NE * L * 4);
    P.act = (bf16_t*)take((size_t)L * NSLOT * DE * 2);
    if (off < r2_end) off = r2_end;
  }
  {
    const size_t r4 = off;
    P.w13T = (bf16_t*)take((size_t)256 * 512 * D * 2);
    const size_t r4_end = off;
    off = r4;
    P.slab = (unsigned char*)take((size_t)L * NSLOT * D);
    if (off < r4_end) off = r4_end;
  }
  if (off > ws_size) fprintf(stderr, "workspace too small: need %zu have %zu\n", off, ws_size);
  (void)hipMemsetAsync(P.bar, 0, (XCD_BAR_WORDS + 64 + 16 * FSTR) * 4, stream);
  void* args[] = {&P};
  hipError_t e = hipLaunchCooperativeKernel((void*)mega, dim3(grid_blocks), dim3(NTHR), args, kDynLds, stream);
  if (e != hipSuccess) fprintf(stderr, "cooperative launch failed: %s (grid %d)\n", hipGetErrorString(e), grid_blocks);
}
```

```cpp
#include <hip/hip_runtime.h>
#include <hip/hip_cooperative_groups.h>
#include <cstdio>
#include <cstdint>
namespace cg = cooperative_groups;

#define DI __device__ __forceinline__
__device__ __forceinline__ int fresh_tid() { int t = threadIdx.x; asm volatile("" : "+v"(t)); return t; }
typedef unsigned short bf16_t;
typedef short bf16x8 __attribute__((ext_vector_type(8)));
typedef float f32x4 __attribute__((ext_vector_type(4)));
typedef float f32x16 __attribute__((ext_vector_type(16)));
typedef unsigned u32x4 __attribute__((ext_vector_type(4)));
typedef unsigned u32x2 __attribute__((ext_vector_type(2)));

constexpr int D = 1024, L = 16384, LC = 256, LT = L + LC;
constexpr int PINW = 3456;
constexpr int PIN = 3584, PRW0 = 1536;
constexpr int NE = 256, TOPK = 8, DE = 256;
constexpr int NCH = LT / 64;
constexpr int NTASK = NCH * 16;
constexpr int NSLOT = 9;
constexpr int NTHR = 512;
constexpr size_t kDynLds = 152 * 1024;
constexpr float SLAB_SCALE = 8.f;
constexpr float H2_SCALE = 8.f, W13_SCALE = 64.f, ACT_SCALE = 8.f, W2_SCALE = 32.f, MIX_SCALE = 8.f;


struct Params {
  const float *x, *c, *ctx, *c_ctx, *ada_w, *ada_b, *norm1_g, *norm2_g, *w_in, *conv_w, *shift_mu, *decay_w0, *decay_up,
      *iclr_a0, *iclr_up, *key_xi, *key_alpha, *bonus_rho, *gate_up, *gn_w, *gn_b, *w_out, *router_w, *router_bias, *exp_w1,
      *exp_w3, *exp_w2, *sh_w1, *sh_w3, *sh_w2, *final_g;
  float* out;
  float *mod, *modc;
  int* cnt;
  int coop_probe, pad0;
  int* ident; float* ones;
  unsigned* bar;
  unsigned* qh;
  unsigned* flags;
  unsigned char* hx;
  bf16_t *winT, *woutT, *rsT, *w13T, *w2T, *gateT;
  bf16_t* p;
  bf16_t* rpp;
  bf16_t* yl;
  bf16_t* gt;
  bf16_t* ht;
  bf16_t* s0;
  float* bon;
  unsigned char* mixin;
  bf16_t* x1;
  bf16_t* h2;
  float* logits;
  int* lid;
  float* lgate;
  unsigned char* act8;
  unsigned char* h2q;
  unsigned char* slab;
};

DI float bf2f(bf16_t h) { return __uint_as_float(((unsigned)h) << 16); }
typedef float f32x2v __attribute__((ext_vector_type(2)));
typedef __bf16 bf16x2v __attribute__((ext_vector_type(2)));
DI bf16_t f2bf(float f) { return __builtin_bit_cast(unsigned short, (__bf16)f); }
DI unsigned pack2(float lo, float hi) {
  f32x2v v = {lo, hi};
  return __builtin_bit_cast(unsigned, __builtin_convertvector(v, bf16x2v));
}
DI float sigm(float x) { return __builtin_amdgcn_rcpf(1.f + __expf(-x)); }
DI float siluf(float x) { return x * sigm(x); }
DI unsigned pk4_fp8(float a, float b, float c, float d) {
  int q = 0;
  q = __builtin_amdgcn_cvt_pk_fp8_f32(__builtin_amdgcn_fmed3f(a, -440.f, 440.f), __builtin_amdgcn_fmed3f(b, -440.f, 440.f), q, false);
  q = __builtin_amdgcn_cvt_pk_fp8_f32(__builtin_amdgcn_fmed3f(c, -440.f, 440.f), __builtin_amdgcn_fmed3f(d, -440.f, 440.f), q, true);
  return (unsigned)q;
}
DI float tanh_(float x) { return 1.f - 2.f * __builtin_amdgcn_rcpf(1.f + __expf(2.f * x)); }
template <int CTRL> DI float dpp_add(float v) { return v + __int_as_float(__builtin_amdgcn_update_dpp(0, __float_as_int(v), CTRL, 0xf, 0xf, true)); }
DI float wave_sum(float v) {
  v = dpp_add<0xB1>(v);
  v = dpp_add<0x4E>(v);
  v = dpp_add<0x141>(v);
  v = dpp_add<0x140>(v);
  const int b = __float_as_int(v);
  return __int_as_float(__builtin_amdgcn_readlane(b, 0)) + __int_as_float(__builtin_amdgcn_readlane(b, 16)) +
         (__int_as_float(__builtin_amdgcn_readlane(b, 32)) + __int_as_float(__builtin_amdgcn_readlane(b, 48)));
}
template <int CTRL> DI float dpp_mov(float v) { return __int_as_float(__builtin_amdgcn_update_dpp(0, __float_as_int(v), CTRL, 0xf, 0xf, true)); }
DI float wave_max(float v) {
  v = fmaxf(v, dpp_mov<0xB1>(v));
  v = fmaxf(v, dpp_mov<0x4E>(v));
  v = fmaxf(v, dpp_mov<0x141>(v));
  v = fmaxf(v, dpp_mov<0x140>(v));
  const int b = __float_as_int(v);
  return fmaxf(fmaxf(__int_as_float(__builtin_amdgcn_readlane(b, 0)), __int_as_float(__builtin_amdgcn_readlane(b, 16))),
               fmaxf(__int_as_float(__builtin_amdgcn_readlane(b, 32)), __int_as_float(__builtin_amdgcn_readlane(b, 48))));
}


#define XB_TMO      128
#define XB_XCNT(j)  (256  + 64 * (j))
#define XB_XSUB(j)  (1280 + 64 * (j))
#define XB_XGEN(j)  (2304 + 64 * (j))
#define XB_TOP      3328
#define XB_TOPGEN   3392
#define XCD_BAR_WORDS 3456
#define XB_SPIN_CAP (1u << 22)
#define LAS __attribute__((address_space(3)))
#define GAS __attribute__((address_space(1)))
DI unsigned xb_ld(unsigned* p) { return __hip_atomic_load(p, __ATOMIC_RELAXED, __HIP_MEMORY_SCOPE_AGENT); }
DI unsigned xb_add(unsigned* p, unsigned v) { return __hip_atomic_fetch_add(p, v, __ATOMIC_RELAXED, __HIP_MEMORY_SCOPE_AGENT); }
DI unsigned xb_xcc_id() { return (unsigned)__builtin_amdgcn_s_getreg((3 << 11) | 20) & 0xFu; }
#define XB_SPIN(cond, bar) do { unsigned _sp = 0; while (cond) { __builtin_amdgcn_s_sleep(1); \
    if ((++_sp & 255u) == 0u) { if (xb_ld(&(bar)[XB_TMO])) break; if (_sp > XB_SPIN_CAP) { atomicAdd(&(bar)[XB_TMO], 1u); break; } } } } while (0)
struct XcdBarrier { unsigned* bar; unsigned x; volatile LAS unsigned* st; };
DI XcdBarrier xcd_barrier_post(unsigned* bar, volatile LAS unsigned* st) {
  XcdBarrier b; b.bar = bar; b.x = xb_xcc_id(); b.st = st;
  if (threadIdx.x == 0) (void)xb_add(&bar[XB_XCNT(b.x)], 1u);
  return b;
}
DI void xcd_barrier_complete(unsigned* bar, unsigned x, unsigned& nloc, unsigned& nx) {
  const unsigned G = gridDim.x * gridDim.y * gridDim.z;
  unsigned sum, cnt, mine, sp = 0u;
  for (;;) {
    sum = 0u; cnt = 0u; mine = 0u;
#pragma unroll
    for (unsigned j = 0; j < 16; ++j) { const unsigned c = xb_ld(&bar[XB_XCNT(j)]); sum += c; cnt += (c > 0u) ? 1u : 0u; mine = (j == x) ? c : mine; }
    if (sum == G) break;
    __builtin_amdgcn_s_sleep(1);
    if ((++sp & 255u) == 0u) { if (xb_ld(&bar[XB_TMO])) break; if (sp > XB_SPIN_CAP) { atomicAdd(&bar[XB_TMO], 1u); break; } }
  }
  nloc = mine > 0u ? mine : 1u; nx = cnt > 0u ? cnt : 1u;
}
DI void xcd_barrier(const XcdBarrier& b) {
  asm volatile("s_waitcnt vmcnt(0)" ::: "memory");
  __syncthreads();
  if (threadIdx.x == 0) {
    unsigned* bar = b.bar;
    __builtin_amdgcn_s_waitcnt(0);
    unsigned nloc = b.st[0], nx = b.st[1];
    if (nloc == 0u) { xcd_barrier_complete(bar, b.x, nloc, nx); b.st[0] = nloc; b.st[1] = nx; }
    const unsigned old = xb_add(&bar[XB_XSUB(b.x)], 1u);
    const unsigned gen = old / nloc;
    if (old + 1u == (gen + 1u) * nloc) {
      __builtin_amdgcn_fence(__ATOMIC_RELEASE, "agent");
      asm volatile("s_waitcnt vmcnt(0)" ::: "memory");
      const unsigned og = xb_add(&bar[XB_TOP], 1u);
      const unsigned tg = og / nx;
      if (og + 1u == (tg + 1u) * nx) xb_add(&bar[XB_TOPGEN], 1u);
      else XB_SPIN(xb_ld(&bar[XB_TOPGEN]) == tg, bar);
      __builtin_amdgcn_fence(__ATOMIC_ACQUIRE, "agent");
      xb_add(&bar[XB_XGEN(b.x)], 1u);
      asm volatile("s_waitcnt vmcnt(0)" ::: "memory");
    } else {
      XB_SPIN(xb_ld(&bar[XB_XGEN(b.x)]) == gen, bar);
      __builtin_amdgcn_fence(__ATOMIC_ACQUIRE, "agent");
      asm volatile("s_waitcnt vmcnt(0)" ::: "memory");
    }
  }
  __syncthreads();
}

struct GemmAcc { f32x4 a[4][4]; };

struct GStage { u32x4 a0, a1; f32x4 b0, b1; };
DI void g_load(GStage& S, const bf16_t* ap0, const bf16_t* ap1, const float* bp, int ldb, int t, int nt) {
  if (t < nt) {
    S.a0 = *(const u32x4*)(ap0 + t * 32);
    S.a1 = *(const u32x4*)(ap1 + t * 32);
    const float* bn = bp + (size_t)t * 32 * ldb;
    S.b0 = *(const f32x4*)(bn);
    S.b1 = *(const f32x4*)(bn + ldb);
  }
}
DI int swz4(int row) { return (0x78 >> (((row >> 2) & 3) * 2)) & 3; }
DI void g_write(const GStage& S, char* st, int tid, int kq, int ng) {
  {
    const int row = tid >> 2, ch = (tid & 3) ^ swz4(row);
    *(u32x4*)(st + row * 64 + ch * 16) = S.a0;
    *(u32x4*)(st + 8192 + row * 64 + ch * 16) = S.a1;
  }
  const int pc = ((kq >> 2) ^ swz4(4 * ng)) * 4 + (kq & 3);
  unsigned* dst = (unsigned*)(st + 16384) + (4 * ng) * 16 + pc;
  dst[0] = pack2(S.b0[0], S.b1[0]);
  dst[16] = pack2(S.b0[1], S.b1[1]);
  dst[32] = pack2(S.b0[2], S.b1[2]);
  dst[48] = pack2(S.b0[3], S.b1[3]);
}
DI void g_compute(GemmAcc& acc, const char* st, int wr, int wc, int fr, int fq) {
  bf16x8 At[4], Bt[4];
  const int pch = (fq ^ swz4(fr)) * 16;
#pragma unroll
  for (int m = 0; m < 4; ++m) At[m] = *(const bf16x8*)(st + (wr * 64 + m * 16 + fr) * 64 + pch);
#pragma unroll
  for (int n = 0; n < 4; ++n) Bt[n] = *(const bf16x8*)(st + 16384 + (wc * 64 + n * 16 + fr) * 64 + pch);
#pragma unroll
  for (int m = 0; m < 4; ++m)
#pragma unroll
    for (int n = 0; n < 4; ++n) acc.a[m][n] = __builtin_amdgcn_mfma_f32_16x16x32_bf16(At[m], Bt[n], acc.a[m][n], 0, 0, 0);
}
template <class ARow, class BCol, class Epi>
DI void gemm_tile(char* smem, const ARow& arow, const BCol& bcol, int ldb, int K, const Epi& epi) {
  const int tid = fresh_tid(), wid = tid >> 6, lane = tid & 63, wr = wid >> 1, wc = wid & 1, fr = lane & 15, fq = lane >> 4;
  const int ar0 = tid >> 2, ac0 = (tid & 3) * 8;
  const bf16_t* ap0 = arow(ar0) + ac0;
  const bf16_t* ap1 = arow(ar0 + 128) + ac0;
  const int kq = tid & 15, ng = tid >> 4;
  const float* bp = bcol(ng) + (size_t)(2 * kq) * ldb;
  GemmAcc acc;
#pragma unroll
  for (int m = 0; m < 4; ++m)
#pragma unroll
    for (int n = 0; n < 4; ++n) acc.a[m][n] = (f32x4){0.f, 0.f, 0.f, 0.f};
  const int nt = K / 32;
  char* st0 = smem;
  char* st1 = smem + 24576;
  GStage S0, S1, S2;
  g_load(S0, ap0, ap1, bp, ldb, 0, nt);
  g_load(S1, ap0, ap1, bp, ldb, 1, nt);
  g_load(S2, ap0, ap1, bp, ldb, 2, nt);
  g_write(S0, st0, tid, kq, ng);
  g_load(S0, ap0, ap1, bp, ldb, 3, nt);
  __syncthreads();
  for (int t = 0; t < nt; t += 3) {
    {
      char* cur = (t & 1) ? st1 : st0; char* nxt = (t & 1) ? st0 : st1;
      g_compute(acc, cur, wr, wc, fr, fq);
      if (t + 1 < nt) g_write(S1, nxt, tid, kq, ng);
      g_load(S1, ap0, ap1, bp, ldb, t + 4, nt);
      __syncthreads();
    }
    if (t + 1 < nt) {
      char* cur = ((t + 1) & 1) ? st1 : st0; char* nxt = ((t + 1) & 1) ? st0 : st1;
      g_compute(acc, cur, wr, wc, fr, fq);
      if (t + 2 < nt) g_write(S2, nxt, tid, kq, ng);
      g_load(S2, ap0, ap1, bp, ldb, t + 5, nt);
      __syncthreads();
    }
    if (t + 2 < nt) {
      char* cur = ((t + 2) & 1) ? st1 : st0; char* nxt = ((t + 2) & 1) ? st0 : st1;
      g_compute(acc, cur, wr, wc, fr, fq);
      if (t + 3 < nt) g_write(S0, nxt, tid, kq, ng);
      g_load(S0, ap0, ap1, bp, ldb, t + 6, nt);
      __syncthreads();
    }
  }
  epi(acc, wr, wc, fr, fq);
}


template <int NC, class Val, class RowPtr>
DI void epi_bf16_lds(char* smem, int wr, int wc, int fr, int fq, const Val& val, const RowPtr& rowptr) {
  constexpr int LDC = NC + 8;
  bf16_t* T = (bf16_t*)smem;
#pragma unroll
  for (int m = 0; m < 4; ++m)
#pragma unroll
    for (int n = 0; n < NC / 32; ++n)
#pragma unroll
      for (int j = 0; j < 4; ++j) T[(wr * 64 + m * 16 + fq * 4 + j) * LDC + wc * (NC / 2) + n * 16 + fr] = f2bf(val(m, n, j));
  __syncthreads();
  constexpr int CPR = NC / 8;
  constexpr int RPI = NTHR / CPR;
  const int tid = fresh_tid(), ch = tid % CPR, r0 = tid / CPR;
#pragma unroll 4
  for (int it = 0; it < 256 / RPI; ++it) {
    const int r = it * RPI + r0;
    bf16_t* dst = rowptr(r);
    if (dst) *(u32x4*)(dst + ch * 8) = *(const u32x4*)(T + r * LDC + ch * 8);
  }
  __syncthreads();
}


struct Acc256 { f32x4 a[8][4]; };
struct GStage2 { u32x4 a0, a1; f32x4 b00, b01, b10, b11; };
template <class BP>
DI void g2_load(GStage2& S, const bf16_t* ap0, const bf16_t* ap1, const BP& bp0, const BP& bp1, int ldb, int t, int nt) {
  if (t < nt) {
    S.a0 = *(const u32x4*)(ap0 + t * 32);
    S.a1 = *(const u32x4*)(ap1 + t * 32);
    const size_t o = (size_t)t * 32 * ldb;
    S.b00 = *(const f32x4*)(bp0 + o);
    S.b01 = *(const f32x4*)(bp0 + o + ldb);
    S.b10 = *(const f32x4*)(bp1 + o);
    S.b11 = *(const f32x4*)(bp1 + o + ldb);
  }
}
DI void g2_write(const GStage2& S, char* st, int tid, int kq, int ng) {
  {
    const int row = tid >> 2, ch = (tid & 3) ^ swz4(row);
    *(u32x4*)(st + row * 64 + ch * 16) = S.a0;
    *(u32x4*)(st + 8192 + row * 64 + ch * 16) = S.a1;
  }
  const int pc = ((kq >> 2) ^ swz4(4 * ng)) * 4 + (kq & 3);
  unsigned* dst = (unsigned*)(st + 16384) + (4 * ng) * 16 + pc;
  dst[0] = pack2(S.b00[0], S.b01[0]);
  dst[16] = pack2(S.b00[1], S.b01[1]);
  dst[32] = pack2(S.b00[2], S.b01[2]);
  dst[48] = pack2(S.b00[3], S.b01[3]);
  dst[2048 + 0] = pack2(S.b10[0], S.b11[0]);
  dst[2048 + 16] = pack2(S.b10[1], S.b11[1]);
  dst[2048 + 32] = pack2(S.b10[2], S.b11[2]);
  dst[2048 + 48] = pack2(S.b10[3], S.b11[3]);
}
DI void g2_compute(Acc256& acc, const char* st, int wr, int wc, int fr, int fq) {
  bf16x8 Bt[4];
  const int pch = (fq ^ swz4(fr)) * 16;
#pragma unroll
  for (int n = 0; n < 4; ++n) Bt[n] = *(const bf16x8*)(st + 16384 + (wc * 64 + n * 16 + fr) * 64 + pch);
#pragma unroll
  for (int m = 0; m < 8; ++m) {
    const bf16x8 At = *(const bf16x8*)(st + (wr * 128 + m * 16 + fr) * 64 + pch);
#pragma unroll
    for (int n = 0; n < 4; ++n) acc.a[m][n] = __builtin_amdgcn_mfma_f32_16x16x32_bf16(At, Bt[n], acc.a[m][n], 0, 0, 0);
  }
}
template <class ARow, class BCol, class Epi>
DI void gemm256(char* smem, const ARow& arow, const BCol& bcol, int ldb, int K, const Epi& epi) {
  const int tid = fresh_tid(), wid = tid >> 6, lane = tid & 63, wr = wid >> 2, wc = wid & 3, fr = lane & 15, fq = lane >> 4;
  const int ar0 = tid >> 2, ac0 = (tid & 3) * 8;
  const bf16_t* ap0 = arow(ar0) + ac0;
  const bf16_t* ap1 = arow(ar0 + 128) + ac0;
  const int kq = tid & 15, ng = tid >> 4;
  const float* bp0 = bcol(ng) + (size_t)(2 * kq) * ldb;
  const float* bp1 = bcol(ng + 32) + (size_t)(2 * kq) * ldb;
  Acc256 acc;
#pragma unroll
  for (int m = 0; m < 8; ++m)
#pragma unroll
    for (int n = 0; n < 4; ++n) acc.a[m][n] = (f32x4){0.f, 0.f, 0.f, 0.f};
  const int nt = K / 32;
  char* st0 = smem;
  char* st1 = smem + 32768;
  GStage2 S0, S1;
  g2_load(S0, ap0, ap1, bp0, bp1, ldb, 0, nt);
  g2_load(S1, ap0, ap1, bp0, bp1, ldb, 1, nt);
  g2_write(S0, st0, tid, kq, ng);
  g2_load(S0, ap0, ap1, bp0, bp1, ldb, 2, nt);
  __syncthreads();
  for (int t = 0; t < nt; t += 2) {
    g2_compute(acc, st0, wr, wc, fr, fq);
    g2_write(S1, st1, tid, kq, ng);
    g2_load(S1, ap0, ap1, bp0, bp1, ldb, t + 3, nt);
    __syncthreads();
    g2_compute(acc, st1, wr, wc, fr, fq);
    if (t + 2 < nt) g2_write(S0, st0, tid, kq, ng);
    g2_load(S0, ap0, ap1, bp0, bp1, ldb, t + 4, nt);
    __syncthreads();
  }
  epi(acc, wr, wc, fr, fq);
}
template <int NC, class Val, class RowPtr>
DI void epi256_bf16(char* smem, int wr, int wc, int fr, int fq, const Val& val, const RowPtr& rowptr, int ncv = 1 << 30) {
  constexpr int LDC = NC + 8;
  bf16_t* T = (bf16_t*)smem;
#pragma unroll
  for (int m = 0; m < 8; ++m)
#pragma unroll
    for (int n = 0; n < NC / 64; ++n)
#pragma unroll
      for (int j = 0; j < 4; ++j) T[(wr * 128 + m * 16 + fq * 4 + j) * LDC + wc * (NC / 4) + n * 16 + fr] = f2bf(val(m, n, j));
  __syncthreads();
  constexpr int CPR = NC / 8, RPI = NTHR / CPR;
  const int tid = fresh_tid(), ch = tid % CPR, r0 = tid / CPR;
#pragma unroll 4
  for (int it = 0; it < 256 / RPI; ++it) {
    const int r = it * RPI + r0;
    bf16_t* dst = rowptr(r);
    if (dst && ch * 8 < ncv) *(u32x4*)(dst + ch * 8) = *(const u32x4*)(T + r * LDC + ch * 8);
  }
  __syncthreads();
}


namespace g8 {
constexpr int BK = 64, HALF = 128, HTB = HALF * BK * 2;
DI int lds_byte(int r, int c) { const int st = (r >> 4) * 2 + (c >> 5), rr = r & 15, cc = c & 31, ob = rr * 64 + cc * 2; return st * 1024 + (ob ^ (((ob >> 9) & 1) << 5)); }
DI void stage_rc(int b, int& R, int& C) { const int st = b / 1024, sb = b % 1024, swz = sb ^ (((sb >> 9) & 1) << 5); R = (st >> 1) * 16 + swz / 64; C = (st & 1) * 32 + (swz % 64) / 2; }
typedef f32x4 Acc[2][2][4][2];
typedef int i32x4 __attribute__((ext_vector_type(4)));
typedef int i32x8 __attribute__((ext_vector_type(8)));
template <class Unit, class Sched, class Epi>
DI void gemm(LAS unsigned char* lds, const Sched& S, const Epi& E, int K) {
  asm volatile("" : "+s"(K));
  const int tid = fresh_tid(), wid = __builtin_amdgcn_readfirstlane(tid >> 6), lane = tid & 63, wr = wid >> 2, wc = wid & 3, fr = lane & 15, fq = lane >> 4;
  const int nt = K / BK;
  int R[2], C[2];
  unsigned voffB[2];
#pragma unroll
  for (int i = 0; i < 2; ++i) { stage_rc(tid * 16 + i * 8192, R[i], C[i]); voffB[i] = (unsigned)(R[i] * (Sched::TILED_B ? BK : K) + C[i]) * 2u; }
  const size_t kstep = (size_t)(BK * 2);
  const size_t kstepB = Sched::TILED_B ? (size_t)(2 * HALF * BK * 2) : kstep;
  const size_t hstep = Sched::TILED_B ? (size_t)(HALF * BK * 2) : (size_t)HALF * K * 2;
  const unsigned ldsw = (unsigned)wid * 1024u;
  const int aoff = lds_byte(wr * 64 + fr, fq * 8), boff = lds_byte(wc * 32 + fr, fq * 8);
#define G8_SA(b, h) (((b) * 2 + (h)) * HTB)
#define G8_SB(b, h) ((4 + (b) * 2 + (h)) * HTB)
#define G8_STAGEB(bufoff, gbase) do { _Pragma("unroll") for (int _i = 0; _i < 2; ++_i) \
    __builtin_amdgcn_global_load_lds((const unsigned*)((const char*)(gbase) + voffB[_i]), (LAS unsigned*)(lds + (bufoff) + ldsw + _i * 8192), 16, 0, 0); } while (0)
#define G8_STAGEA(bufoff, offs, h, kb) do { _Pragma("unroll") for (int _i = 0; _i < 2; ++_i) \
    __builtin_amdgcn_global_load_lds((const unsigned*)(abase + (size_t)(offs)[h][_i] + (kb)), (LAS unsigned*)(lds + (bufoff) + ldsw + _i * 8192), 16, 0, 0); } while (0)
#define G8_LDA(dst, b, h) do { _Pragma("unroll") for (int m = 0; m < 4; ++m) _Pragma("unroll") for (int k = 0; k < 2; ++k) dst[m][k] = *(const LAS bf16x8*)(lds + G8_SA(b, h) + aoff + m * 2048 + k * 1024); } while (0)
#define G8_LDB(dst, b, h) do { _Pragma("unroll") for (int n = 0; n < 2; ++n) _Pragma("unroll") for (int k = 0; k < 2; ++k) dst[n][k] = *(const LAS bf16x8*)(lds + G8_SB(b, h) + boff + n * 2048 + k * 1024); } while (0)
#define G8_MMA(ai, bj, At, Bt) do { __builtin_amdgcn_s_setprio(1); _Pragma("unroll") for (int m = 0; m < 4; ++m) _Pragma("unroll") for (int n = 0; n < 2; ++n) { \
    if constexpr (Sched::FP8) { \
      const i32x8 _b = __builtin_shufflevector(__builtin_bit_cast(i32x4, Bt[n][0]), __builtin_bit_cast(i32x4, Bt[n][1]), 0, 1, 2, 3, 4, 5, 6, 7); \
      const i32x8 _a = __builtin_shufflevector(__builtin_bit_cast(i32x4, At[m][0]), __builtin_bit_cast(i32x4, At[m][1]), 0, 1, 2, 3, 4, 5, 6, 7); \
      acc[ai][bj][m][n] = __builtin_amdgcn_mfma_scale_f32_16x16x128_f8f6f4(_b, _a, acc[ai][bj][m][n], 0, 0, 0, 0, 0, 0); \
    } else { _Pragma("unroll") for (int k = 0; k < 2; ++k) \
      acc[ai][bj][m][n] = __builtin_amdgcn_mfma_f32_16x16x32_bf16(Bt[n][k], At[m][k], acc[ai][bj][m][n], 0, 0, 0); } } __builtin_amdgcn_s_setprio(0); } while (0)
#define G8_WAIT_V(n) asm volatile("s_waitcnt vmcnt(" #n ")" ::: "memory")
#define G8_WAIT_L(n) asm volatile("s_waitcnt lgkmcnt(" #n ")" ::: "memory")
#define G8_BAR __builtin_amdgcn_s_barrier()
#define G8_SCHED __builtin_amdgcn_sched_barrier(0)
  Unit cur, nxt; int ui = 0;
  if (!S.next(0, cur)) return;
  const char* abase = S.abase();
  Acc acc;
#pragma unroll
  for (int a = 0; a < 2; ++a)
#pragma unroll
    for (int b = 0; b < 2; ++b)
#pragma unroll
      for (int m = 0; m < 4; ++m)
#pragma unroll
        for (int n = 0; n < 2; ++n) acc[a][b][m][n] = (f32x4){0.f, 0.f, 0.f, 0.f};
  bf16x8 At[4][2], B0[2][2], B1[2][2];
  unsigned co[2][2], no[2][2];
  S.pf(cur, lds, 0);
  { Unit u1; if (S.next(1, u1)) S.pf(u1, lds, 1); }
  S.aoffs(cur, R[0], R[1], C[0], C[1], co);
  const char* cB = S.bbase(cur);
  G8_STAGEB(G8_SB(0, 0), cB); G8_STAGEA(G8_SA(0, 0), co, 0, 0); G8_STAGEB(G8_SB(0, 1), cB + hstep); G8_STAGEA(G8_SA(0, 1), co, 1, 0);
  if (wr == 1) G8_BAR;
  G8_WAIT_V(4); G8_BAR;
  G8_STAGEB(G8_SB(1, 0), cB + kstepB); G8_STAGEA(G8_SA(1, 0), co, 0, kstep); G8_STAGEB(G8_SB(1, 1), cB + hstep + kstepB);
  G8_WAIT_V(6); G8_BAR;
  for (;;) {
    const bool has_next = S.next(ui + 1, nxt);
    const char* nB = cB;
    if (has_next) nB = S.bbase(nxt);
    { Unit u2; if (S.next(ui + 2, u2)) S.pf(u2, lds, (ui + 2) & 3); }
    for (int t = 0; t < nt; t += 2) {
      const bool last = (t == nt - 2);
      const size_t k1 = (size_t)(t + 1) * kstep;
      const size_t k2 = last ? 0 : (size_t)(t + 2) * kstep;
      const size_t k3 = k2 + kstep;
      const char* b2 = (last ? nB : cB) + (last ? 0 : (size_t)(t + 2) * kstepB);
      const char* b3 = b2 + kstepB;
      if (last) {
        if (has_next) S.aoffs_late(nxt, lds, (ui + 1) & 3, R[0], R[1], C[0], C[1], no);
        else {
#pragma unroll
          for (int h = 0; h < 2; ++h)
#pragma unroll
            for (int i = 0; i < 2; ++i) no[h][i] = co[h][i];
        }
      }
      G8_LDB(B0, 0, 0); G8_SCHED; G8_LDA(At, 0, 0); G8_STAGEA(G8_SA(1, 1), co, 1, k1);
      G8_WAIT_L(8); G8_BAR; G8_WAIT_L(0); G8_MMA(0, 0, At, B0); G8_BAR; G8_SCHED;
      G8_LDB(B1, 0, 1); G8_STAGEB(G8_SB(0, 0), b2);
      G8_BAR; G8_WAIT_L(0); G8_MMA(0, 1, At, B1); G8_BAR;
      G8_LDA(At, 0, 1);
      if (last) { G8_STAGEA(G8_SA(0, 0), no, 0, k2); } else { G8_STAGEA(G8_SA(0, 0), co, 0, k2); }
      G8_BAR; G8_WAIT_L(0); G8_MMA(1, 0, At, B0); G8_BAR; G8_SCHED;
      G8_STAGEB(G8_SB(0, 1), b2 + hstep);
      G8_WAIT_V(6); G8_BAR; G8_MMA(1, 1, At, B1); G8_BAR;
      G8_LDB(B0, 1, 0); G8_SCHED; G8_LDA(At, 1, 0);
      if (last) { G8_STAGEA(G8_SA(0, 1), no, 1, k2); } else { G8_STAGEA(G8_SA(0, 1), co, 1, k2); }
      G8_WAIT_L(8); G8_BAR; G8_WAIT_L(0); G8_MMA(0, 0, At, B0); G8_BAR; G8_SCHED;
      G8_LDB(B1, 1, 1); G8_STAGEB(G8_SB(1, 0), b3);
      G8_BAR; G8_WAIT_L(0); G8_MMA(0, 1, At, B1); G8_BAR;
      G8_LDA(At, 1, 1);
      if (last) { G8_STAGEA(G8_SA(1, 0), no, 0, k3); } else { G8_STAGEA(G8_SA(1, 0), co, 0, k3); }
      G8_BAR; G8_WAIT_L(0); G8_MMA(1, 0, At, B0); G8_BAR; G8_SCHED;
      G8_STAGEB(G8_SB(1, 1), b3 + hstep);
      G8_WAIT_V(6); G8_BAR; G8_MMA(1, 1, At, B1); G8_BAR;
    }
    E(acc, cur, wr, wc, fr, fq, ui & 3);
    if (!has_next) break;
#pragma unroll
    for (int a = 0; a < 2; ++a)
#pragma unroll
      for (int b = 0; b < 2; ++b)
#pragma unroll
        for (int m = 0; m < 4; ++m)
#pragma unroll
          for (int n = 0; n < 2; ++n) acc[a][b][m][n] = (f32x4){0.f, 0.f, 0.f, 0.f};
    cur = nxt; cB = nB; ++ui;
#pragma unroll
    for (int h = 0; h < 2; ++h)
#pragma unroll
      for (int i = 0; i < 2; ++i) co[h][i] = no[h][i];
  }
  G8_WAIT_V(0);
  if (wr == 0) G8_BAR;
  G8_BAR;
#undef G8_SA
#undef G8_SB
#undef G8_STAGEA
#undef G8_STAGEB
#undef G8_LDA
#undef G8_LDB
#undef G8_MMA
#undef G8_WAIT_V
#undef G8_WAIT_L
#undef G8_BAR
#undef G8_SCHED
}
struct Unit2 { int pm, pn; };
struct DenseOrder {
  int nM, nN, nwg, G, c;
  DI void init(int nM_, int nN_, int G_, int c_) { nM = nM_; nN = nN_; nwg = nM * nN; G = G_; c = c_; }
  DI bool next(int i, Unit2& u) const {
    const long Lx = (long)i * G + c; if (Lx >= nwg) return false;
    int wgid = (int)Lx; { const int q = nwg / 8, r = nwg % 8, xcd = wgid % 8, off = wgid / 8; wgid = (xcd < r ? xcd * (q + 1) : r * (q + 1) + (xcd - r) * q) + off; }
    const int nig = 8 * nN, gid = wgid / nig, fm = gid * 8, gsz = (nM - fm) < 8 ? (nM - fm) : 8;
    u.pm = fm + ((wgid % nig) % gsz); u.pn = (wgid % nig) / gsz; return true;
  }
};
}

DI int swiglu_col(int rho, int& z);
struct PrepTile { const float* src[4]; const float* src2[4]; unsigned char* dst; int ld, Kdim, perm; };
DI int w2_row(int c) { const int wc = c >> 6, fq = (c >> 4) & 3, bj = (c >> 3) & 1, n = (c >> 2) & 1, e = c & 3; return 128 * bj + 32 * wc + 16 * n + 4 * fq + e; }
DI int perm32(int rho) { const int n = rho >> 4, i = rho & 15; return 8 * (i >> 2) + 4 * n + (i & 3); }
DI void prep_tile_desc(const Params& P, int u, int ch, int r, PrepTile& t) {
  constexpr int PER_E = 32 + 16;
  const int e = u / PER_E, v = u % PER_E;
  if (e < 256 && v < 32) {
    const int pn = v >> 4, kt = v & 15;
    const float* W1 = P.exp_w1 + (size_t)e * D * DE;
    const float* W3 = P.exp_w3 + (size_t)e * D * DE;
    t.ld = DE; t.Kdim = D; t.perm = 0;
    t.dst = (unsigned char*)P.w13T + ((size_t)e * 512 + pn * 256) * D + (size_t)(kt >> 1) * (256 * 128) + (kt & 1) * 64;
#pragma unroll
    for (int sb = 0; sb < 4; ++sb) {
      int z; const int col = swiglu_col(pn * 256 + sb * 64 + ch * 4, z);
      t.src[sb] = (z ? W3 : W1) + col + (size_t)(kt * 64 + 2 * r) * DE;
      t.src2[sb] = t.src[sb] + DE;
    }
  } else {
    const int w = (e < 256) ? v - 32 : v;
    const int pn = w >> 2, kt = w & 3;
    const float* W2 = (e < 256) ? P.exp_w2 + (size_t)e * DE * D : P.sh_w2;
    t.ld = D; t.Kdim = DE;
    t.dst = (unsigned char*)P.w2T + ((size_t)e * D + pn * 256) * DE + (size_t)(kt >> 1) * (256 * 128) + (kt & 1) * 64;
    t.perm = 1;
#pragma unroll
    for (int sb = 0; sb < 4; ++sb) {
      t.src[sb] = W2 + pn * 256 + sb * 64 + ch * 4 + (size_t)(kt * 64 + 2 * r) * D;
      t.src2[sb] = t.src[sb] + D;
    }
  }
}
constexpr int PREP_TOTAL = 256 * 48 + 16;
constexpr int NPREPB = 80;
constexpr int NW2 = 104, B2 = 44;
constexpr int B8 = 20;
constexpr int PREP_Q0 = NW2 * B2 + 64 * B8;
constexpr int NSCAN = 8;
constexpr int TASK_Q0 = (256 - NSCAN - NPREPB) * 2;
constexpr int FSTR = 384;
struct PrepSet { f32x4 v[4][2]; unsigned char* dst; int Kdim, perm; };
DI void prep_issue(const Params& P, PrepSet& S, int u, int ch, int r2) {
  const bool ok = u < PREP_TOTAL;
  PrepTile t;
  prep_tile_desc(P, ok ? u : 0, ch, r2, t);
#pragma unroll
  for (int sb = 0; sb < 4; ++sb) {
    S.v[sb][0] = __builtin_nontemporal_load((const f32x4*)(ok ? t.src[sb] : P.ones));
    S.v[sb][1] = __builtin_nontemporal_load((const f32x4*)(ok ? t.src2[sb] : P.ones));
  }
  S.dst = t.dst; S.Kdim = t.Kdim; S.perm = t.perm;
}
#define PREP_BODY(S)                                                                                                   \
  {                                                                                                                    \
    unsigned* T = (unsigned*)(smem + par * 33792);                                                                     \
    par ^= 1;                                                                                                          \
    _Pragma("unroll") for (int sb = 0; sb < 4; ++sb)                                                                   \
      _Pragma("unroll") for (int j = 0; j < 4; ++j) {                                                                  \
        const int c = sb * 64 + ch * 4 + j;                                                                            \
        const float wsc = S.perm ? W2_SCALE : W13_SCALE;                                                               \
        ((unsigned short*)T)[(S.perm ? w2_row(c) : c) * 66 + r2] = (unsigned short)__builtin_amdgcn_cvt_pk_fp8_f32(    \
            __builtin_amdgcn_fmed3f(S.v[sb][0][j] * wsc, -440.f, 440.f), __builtin_amdgcn_fmed3f(S.v[sb][1][j] * wsc, -440.f, 440.f), 0, false); \
      }                                                                                                                \
    unsigned char* dst = S.dst;                                                                                        \
    prep_issue(P, S, (k + 3 < n) ? base + k + 3 : PREP_TOTAL, ch, r2);                                                 \
    __syncthreads();                                                                                                   \
    _Pragma("unroll") for (int it = 0; it < 2; ++it) {                                                                 \
      const int ro = it * 128 + (tid >> 2), co = tid & 3;                                                              \
      const unsigned* tp = T + ro * 33 + co * 4;                                                                       \
      u32x4 o; o[0] = tp[0]; o[1] = tp[1]; o[2] = tp[2]; o[3] = tp[3];                                                 \
      __builtin_nontemporal_store(o, (u32x4*)(dst + (size_t)ro * 128 + co * 16));                                      \
    }                                                                                                                  \
    if (++k >= n) break;                                                                                               \
  }
DI void prep_range(const Params& P, char* smem, int base, int n) {
  const int tid = fresh_tid();
  const int ch = tid & 15, r2 = tid >> 4;
  int par = 0;
  if (n <= 0) return;
  PrepSet R0, R1, R2;
  prep_issue(P, R0, base, ch, r2);
  prep_issue(P, R1, (1 < n) ? base + 1 : PREP_TOTAL, ch, r2);
  prep_issue(P, R2, (2 < n) ? base + 2 : PREP_TOTAL, ch, r2);
  int k = 0;
  do {
    PREP_BODY(R0)
    for (;;) {
      PREP_BODY(R1) PREP_BODY(R2) PREP_BODY(R0)
      PREP_BODY(R1) PREP_BODY(R2) PREP_BODY(R0)
      PREP_BODY(R1) PREP_BODY(R2) PREP_BODY(R0)
      PREP_BODY(R1) PREP_BODY(R2) PREP_BODY(R0)
    }
  } while (0);
  __syncthreads();
}
constexpr int PB = 24, PBS = 6, PREP_TAIL = 1920;
constexpr int PREP_NBIG = (PREP_TOTAL - PREP_Q0 - PREP_TAIL) / PB;
constexpr int PREP_QS = PREP_Q0 + PREP_NBIG * PB;
DI void prep_ticket(unsigned t, int& base, int& n) {
  if ((int)t < PREP_NBIG) { base = PREP_Q0 + (int)t * PB; n = PB; }
  else { base = PREP_QS + ((int)t - PREP_NBIG) * PBS; n = PBS; }
  if (base > PREP_TOTAL) base = PREP_TOTAL;
  if (n > PREP_TOTAL - base) n = PREP_TOTAL - base;
}
DI void prep_queue(const Params& P, char* smem) {
  LAS unsigned* qw = (LAS unsigned*)(smem + 69632);
  unsigned* qp = P.qh + 32;
  const int tid = fresh_tid();
  unsigned nb = 0;
  if (tid == 0) nb = __builtin_amdgcn_atomic_inc32(qp, 0xFFFFFFFFu, __ATOMIC_RELAXED, "agent");
  for (;;) {
    if (tid == 0) qw[0] = nb;
    __syncthreads();
    int base, n;
    prep_ticket(__builtin_amdgcn_readfirstlane(qw[0]), base, n);
    if (n <= 0) break;
    if (tid == 0) nb = __builtin_amdgcn_atomic_inc32(qp, 0xFFFFFFFFu, __ATOMIC_RELAXED, "agent");
    prep_range(P, smem, base, n);
  }
}

DI int swiglu_col(int rho, int& z) { const int kap = rho & 255, pn = rho >> 8; z = (kap >> 4) & 1; return pn * 128 + (kap >> 5) * 16 + (kap & 15); }

constexpr int LD = 72;
constexpr int SLOT = 64 * LD * 2;
DI f32x16 mfma32(bf16x8 a, bf16x8 b, f32x16 c) { return __builtin_amdgcn_mfma_f32_32x32x16_bf16(a, b, c, 0, 0, 0); }
DI f32x16 zero16() {
  f32x16 z;
#pragma unroll
  for (int i = 0; i < 16; ++i) z[i] = 0.f;
  return z;
}
DI bf16x8 frag_c(const bf16_t* M, int row, int k, int ld = LD) { return *(const bf16x8*)(M + row * ld + k); }
DI bf16x8 frag_s(const bf16_t* M, int k, int col, int ld = LD) {
  bf16x8 v;
#pragma unroll
  for (int j = 0; j < 8; ++j) v[j] = (short)M[(k + j) * ld + col];
  return v;
}
DI int crow(int reg, int half) { return (reg & 3) + 8 * (reg >> 2) + 4 * half; }
template <bool AC, bool BC>
DI f32x16 mm_tile(const bf16_t* A, const bf16_t* B, int ti, int tj, int lane, f32x16 acc) {
  const int r = lane & 31, h = lane >> 5;
#pragma unroll
  for (int ks = 0; ks < 4; ++ks) {
    const int k = ks * 16 + 8 * h;
    bf16x8 a = AC ? frag_c(A, ti * 32 + r, k) : frag_s(A, k, ti * 32 + r);
    bf16x8 b = BC ? frag_c(B, tj * 32 + r, k) : frag_s(B, k, tj * 32 + r);
    acc = mfma32(a, b, acc);
    __builtin_amdgcn_sched_barrier(0);
  }
  return acc;
}
DI void store_rm_bf16(bf16_t* M, const f32x16& acc, int ti, int tj, int lane) {
  const int c = tj * 32 + (lane & 31), h = lane >> 5;
#pragma unroll
  for (int g = 0; g < 16; ++g) M[(ti * 32 + crow(g, h)) * LD + c] = f2bf(acc[g]);
}
DI void store_tr_bf16(bf16_t* Mt, const f32x16& acc, int ti, int tj, int lane, int ld = LD) {
  const int c = tj * 32 + (lane & 31), h = lane >> 5;
#pragma unroll
  for (int g = 0; g < 4; ++g) {
    u32x2 v;
    v[0] = pack2(acc[4 * g], acc[4 * g + 1]);
    v[1] = pack2(acc[4 * g + 2], acc[4 * g + 3]);
    *(u32x2*)(Mt + c * ld + ti * 32 + 8 * g + 4 * h) = v;
  }
}

DI void phase0(const Params& P, char* smem) {
  const int tid = fresh_tid();
  if (blockIdx.x == 0 && tid < 272) P.cnt[tid] = 0;
  if (blockIdx.x == 1 && tid < 256) P.ones[tid] = 1.f;
  for (int i = blockIdx.x * NTHR + tid; i < L; i += gridDim.x * NTHR) P.ident[i] = i * NSLOT + 8;
  float* red = (float*)smem;
  float* sc = (float*)(smem + 8192);
  for (int i = tid; i < 2048; i += NTHR) sc[i] = siluf(i < 1024 ? P.c[i] : P.c_ctx[i - 1024]);
  __syncthreads();
  for (int cb = blockIdx.x; cb < 6144 / 24; cb += gridDim.x) {
    const int n0 = cb * 24;
    if (tid < 504) {
      const int col = tid % 24, ks = tid / 24;
      const int k0 = ks * 49;
      float w[49];
#pragma unroll
      for (int i = 0; i < 49; ++i) { const int k = (k0 + i < 1024) ? k0 + i : 1023; w[i] = P.ada_w[(size_t)k * 6144 + n0 + col]; }
      float s0 = 0.f, s1 = 0.f;
#pragma unroll
      for (int i = 0; i < 49; ++i) {
        const int k = k0 + i;
        const float wv = (k < 1024) ? w[i] : 0.f;
        const int kc = (k < 1024) ? k : 1023;
        s0 += sc[kc] * wv;
        s1 += sc[1024 + kc] * wv;
      }
      red[(ks * 24 + col) * 2] = s0;
      red[(ks * 24 + col) * 2 + 1] = s1;
    }
    __syncthreads();
    if (tid < 48) {
      const int col = tid >> 1, z = tid & 1;
      float s = 0.f;
      for (int ks = 0; ks < 21; ++ks) s += red[(ks * 24 + col) * 2 + z];
      s += P.ada_b[n0 + col];
      (z ? P.modc : P.mod)[n0 + col] = s;
    }
    __syncthreads();
  }
}

template <int Q = 0>
DI void norm_mod_finish(const f32x4 (&v)[4], const float* g, const float* shift, const float* scale, bf16_t* dst, int lane, unsigned char* dq = nullptr) {
  float ss = 0.f;
#pragma unroll
  for (int i = 0; i < 4; ++i) ss += v[i][0] * v[i][0] + v[i][1] * v[i][1] + v[i][2] * v[i][2] + v[i][3] * v[i][3];
  ss = wave_sum(ss);
  const float rs = __builtin_amdgcn_rsqf(ss * (1.f / 1024.f) + 1e-6f);
#pragma unroll
  for (int i = 0; i < 4; ++i) {
    const int c = i * 256 + lane * 4;
    const f32x4 gg = *(const f32x4*)(g + c), sh = *(const f32x4*)(shift + c), sc = *(const f32x4*)(scale + c);
    float o[4];
#pragma unroll
    for (int j = 0; j < 4; ++j) o[j] = v[i][j] * rs * gg[j] * (1.f + sc[j]) + sh[j];
    if constexpr (Q != 2) {
      u32x2 w;
      w[0] = pack2(o[0], o[1]);
      w[1] = pack2(o[2], o[3]);
      *(u32x2*)(dst + c) = w;
    }
    if constexpr (Q != 0) *(unsigned*)(dq + c) = pk4_fp8(o[0] * H2_SCALE, o[1] * H2_SCALE, o[2] * H2_SCALE, o[3] * H2_SCALE);
  }
}
DI void norm_load(f32x4 (&v)[4], const float* src, int lane) {
#pragma unroll
  for (int i = 0; i < 4; ++i) v[i] = *(const f32x4*)(src + i * 256 + lane * 4);
}
DI void norm_load_raw(u32x2 (&v)[4], const bf16_t* src, int lane) {
#pragma unroll
  for (int i = 0; i < 4; ++i) v[i] = *(const u32x2*)(src + i * 256 + lane * 4);
}
DI void norm_unpack(f32x4 (&v)[4], const u32x2 (&r)[4]) {
#pragma unroll
  for (int i = 0; i < 4; ++i) {
    v[i][0] = __uint_as_float(r[i][0] << 16); v[i][1] = __uint_as_float(r[i][0] & 0xFFFF0000u);
    v[i][2] = __uint_as_float(r[i][1] << 16); v[i][3] = __uint_as_float(r[i][1] & 0xFFFF0000u);
  }
}
DI void phase1(const Params& P) {
  const int tid_ = fresh_tid();
  const int wid = tid_ >> 6, lane = tid_ & 63;
  const int stride = gridDim.x * 8;
  int row = blockIdx.x * 8 + wid;
  if (row >= LT) return;
  auto src = [&](int r) { const int q = r < LT ? r : row; return q < L ? P.x + (size_t)q * D : P.ctx + (size_t)(q - L) * D; };
  f32x4 v[4], v1[4], v2[4], nv[4];
  norm_load(v, src(row), lane);
  norm_load(v1, src(row + stride), lane);
  norm_load(v2, src(row + 2 * stride), lane);
  for (;;) {
    const int nrow = row + stride;
    norm_load(nv, src(row + 3 * stride), lane);
    if (row < L) norm_mod_finish<2>(v, P.norm1_g, P.mod, P.mod + 1024, nullptr, lane, P.hx + (size_t)row * D);
    else norm_mod_finish<2>(v, P.norm1_g, P.modc, P.modc + 1024, nullptr, lane, P.hx + (size_t)row * D);
    if (nrow >= LT) break;
#pragma unroll
    for (int i = 0; i < 4; ++i) { v[i] = v1[i]; v1[i] = v2[i]; v2[i] = nv[i]; }
    row = nrow;
  }
}
DI void phase7(const Params& P) {
  const int tid_ = fresh_tid();
  const int wid = tid_ >> 6, lane = tid_ & 63;
  const int stride = gridDim.x * 8;
  int row = blockIdx.x * 8 + wid;
  if (row >= L) return;
  auto src = [&](int r) { return P.x1 + (size_t)(r < L ? r : row) * D; };
  u32x2 rv[4], rv1[4], rv2[4], rv3[4], nrv[4];
  norm_load_raw(rv, src(row), lane);
  norm_load_raw(rv1, src(row + stride), lane);
  norm_load_raw(rv2, src(row + 2 * stride), lane);
  norm_load_raw(rv3, src(row + 3 * stride), lane);
  for (;;) {
    const int nrow = row + stride;
    norm_load_raw(nrv, src(row + 4 * stride), lane);
    f32x4 v[4];
    norm_unpack(v, rv);
    norm_mod_finish<1>(v, P.norm2_g, P.mod + 3072, P.mod + 4096, P.h2 + (size_t)row * D, lane, P.h2q + (size_t)row * D);
    if (nrow >= L) break;
#pragma unroll
    for (int i = 0; i < 4; ++i) { rv[i] = rv1[i]; rv1[i] = rv2[i]; rv2[i] = rv3[i]; rv3[i] = nrv[i]; }
    row = nrow;
  }
}


struct DenseTile { const float* p0; const float* p1; bf16_t* dst; int Kdim, q8; };
DI void dense_tile_desc(const Params& P, int u, int kk, int g, DenseTile& t) {
  constexpr int T_WIN = (PIN / 64) * 16, T_WOUT = 16 * 16, T_RS = 12 * 16;
  int rho0, k0, ld;
  const float* c0; const float* c1;
  if (u < T_WIN) {
    const int rt = u >> 4, kt = u & 15;
    rho0 = rt * 64; k0 = kt * 64; ld = PINW; t.dst = P.winT; t.Kdim = D;
    const int rho = rho0 + g * 8;
    c0 = rho < PINW ? P.w_in + (rho & ~31) + perm32(rho & 31) : nullptr;
    c1 = rho + 4 < PINW ? P.w_in + ((rho + 4) & ~31) + perm32((rho + 4) & 31) : nullptr;
  } else if (u < T_WIN + T_WOUT) {
    const int v = u - T_WIN, rt = v >> 4, kt = v & 15;
    rho0 = rt * 64; k0 = kt * 64; ld = D; t.dst = P.woutT; t.Kdim = D;
    c0 = P.w_out + rho0 + g * 8; c1 = c0 + 4;
  } else if (u >= T_WIN + T_WOUT + T_RS) {
    const int v = u - T_WIN - T_WOUT - T_RS, rt = v >> 1, kt = v & 1;
    rho0 = rt * 64; k0 = kt * 64; ld = 512; t.dst = P.gateT; t.Kdim = 128;
    c0 = P.gate_up + rho0 + g * 8; c1 = c0 + 4;
  } else {
    const int v = u - T_WIN - T_WOUT, rt = v >> 4, kt = v & 15;
    rho0 = rt * 64; k0 = kt * 64; ld = 256; t.dst = P.rsT; t.Kdim = D;
    const int rho = rho0 + g * 8;
    if (rho < 256) { c0 = P.router_w + rho; c1 = c0 + 4; }
    else { int z; const int col = swiglu_col(rho - 256, z); c0 = (z ? P.sh_w3 : P.sh_w1) + col; c1 = c0 + 4; }
  }
  t.p0 = c0 ? c0 + (size_t)(k0 + kk) * ld : nullptr;
  t.p1 = c1 ? c1 + (size_t)(k0 + kk) * ld : nullptr;
  t.q8 = (u < T_WIN + T_WOUT) ? 1 : 0;
  if (t.q8) t.dst = (bf16_t*)((unsigned char*)(u < T_WIN ? P.winT : P.woutT) + (size_t)rho0 * D + k0);
  else t.dst += (size_t)rho0 * t.Kdim + k0;
}
DI void prep_dense(const Params& P, char* smem) {
  constexpr int T_ALL = (PIN / 64) * 16 + 16 * 16 + 12 * 16 + 16;
  constexpr int NB = 6;
  const int tid = fresh_tid();
  const int kk = tid >> 3, g = tid & 7;
  const f32x4 z4 = (f32x4){0.f, 0.f, 0.f, 0.f};
  int par = 0;
  for (int base = blockIdx.x; base < T_ALL; base += NB * gridDim.x) {
    DenseTile t[NB];
    f32x4 v0[NB], v1[NB];
#pragma unroll
    for (int i = 0; i < NB; ++i) {
      const int u = base + i * gridDim.x;
      if (u < T_ALL) {
        dense_tile_desc(P, u, kk, g, t[i]);
        v0[i] = t[i].p0 ? *(const f32x4*)t[i].p0 : z4; v1[i] = t[i].p1 ? *(const f32x4*)t[i].p1 : z4;
      }
    }
#pragma unroll
    for (int i = 0; i < NB; ++i) {
      const int u = base + i * gridDim.x;
      if (u < T_ALL) {
        bf16_t* T = (bf16_t*)(smem + par * 9216);
        par ^= 1;
        const int q8 = __builtin_amdgcn_readfirstlane(t[i].q8);
        if (q8) {
          unsigned char* T8 = (unsigned char*)T;
#pragma unroll
          for (int j = 0; j < 4; ++j) {
            const float a = __builtin_amdgcn_fmed3f(v0[i][j] * W13_SCALE, -440.f, 440.f), b = __builtin_amdgcn_fmed3f(v1[i][j] * W13_SCALE, -440.f, 440.f);
            const int q = __builtin_amdgcn_cvt_pk_fp8_f32(a, b, 0, false);
            T8[(g * 8 + j) * 80 + kk] = (unsigned char)(q & 0xFF);
            T8[(g * 8 + 4 + j) * 80 + kk] = (unsigned char)((q >> 8) & 0xFF);
          }
        } else {
#pragma unroll
          for (int j = 0; j < 4; ++j) { T[(g * 8 + j) * 72 + kk] = f2bf(v0[i][j]); T[(g * 8 + 4 + j) * 72 + kk] = f2bf(v1[i][j]); }
        }
        __syncthreads();
        if (q8) {
          if (tid < 256) {
            const int r = tid >> 2, ch = tid & 3;
            *(u32x4*)((unsigned char*)t[i].dst + (size_t)r * D + ch * 16) = *(const u32x4*)((const unsigned char*)T + r * 80 + ch * 16);
          }
        } else {
          const int r = tid >> 3, ch = tid & 7;
          *(u32x4*)(t[i].dst + (size_t)r * t[i].Kdim + ch * 8) = *(const u32x4*)(T + r * 72 + ch * 8);
        }
      }
    }
  }
  __syncthreads();
}

struct SchedP2 : g8::DenseOrder {
  static constexpr int PF_LINES = 0;
  static constexpr bool TILED_B = false, FP8 = true;
  DI void pf(const g8::Unit2&, LAS unsigned char*, int) const {}
  DI void aoffs_late(const g8::Unit2& u, LAS unsigned char*, int, int R0, int R1, int C0, int C1, unsigned (&o)[2][2]) const { aoffs(u, R0, R1, C0, C1, o); }
  const Params* P;
  DI const char* abase() const { return (const char*)P->hx; }
  DI const char* bbase(const g8::Unit2& u) const { return (const char*)P->winT + (size_t)u.pn * 256 * D; }
  DI void aoffs(const g8::Unit2& u, int R0, int R1, int C0, int C1, unsigned (&o)[2][2]) const {
#pragma unroll
    for (int h = 0; h < 2; ++h) {
      o[h][0] = (unsigned)((u.pm * 256 + h * 128 + R0) * D + C0 * 2);
      o[h][1] = (unsigned)((u.pm * 256 + h * 128 + R1) * D + C1 * 2);
    }
  }
};
DI void phase2(const Params& P, char* smem) {
  if ((int)blockIdx.x >= (int)gridDim.x - NW2) { prep_range(P, smem, ((int)blockIdx.x - ((int)gridDim.x - NW2)) * B2, B2); return; }
  SchedP2 S; S.init(LT / 256, PIN / 256, gridDim.x - NW2, blockIdx.x); S.P = &P;
  g8::gemm<g8::Unit2>((LAS unsigned char*)smem, S,
      [&](const g8::Acc& acc, const g8::Unit2& u, int wr, int wc, int fr, int fq, int) {
#pragma unroll
        for (int ai = 0; ai < 2; ++ai)
#pragma unroll
          for (int m = 0; m < 4; ++m) {
            bf16_t* rowp = P.p + (size_t)(u.pm * 256 + ai * 128 + wr * 64 + m * 16 + fr) * PIN + u.pn * 256 + wc * 32 + 8 * fq;
#pragma unroll
            for (int bj = 0; bj < 2; ++bj) {
              constexpr float isc = 1.f / (H2_SCALE * W13_SCALE);
              const f32x4 v0 = acc[ai][bj][m][0] * isc, v1 = acc[ai][bj][m][1] * isc;
              u32x4 w;
              w[0] = pack2(v0[0], v0[1]); w[1] = pack2(v0[2], v0[3]); w[2] = pack2(v1[0], v1[1]); w[3] = pack2(v1[2], v1[3]);
              *(u32x4*)(rowp + bj * 128) = w;
            }
          }
      }, D / 2);
}

DI void st16_bf16(bf16_t* dst, const float* v) {
  u32x4 a, b;
#pragma unroll
  for (int i = 0; i < 4; ++i) { a[i] = pack2(v[2 * i], v[2 * i + 1]); b[i] = pack2(v[8 + 2 * i], v[8 + 2 * i + 1]); }
  *(u32x4*)dst = a;
  *(u32x4*)(dst + 8) = b;
}

struct ShiftRaw { u32x4 c0, c1, p0, p1, n0, n1; };
DI void shift_raw(const Params& P, int t, int lo, int hi, int col, ShiftRaw& R) {
  const bf16_t* pc = P.p + (size_t)t * PIN + col;
  R.c0 = *(const u32x4*)pc; R.c1 = *(const u32x4*)(pc + 8);
  R.p0 = (u32x4){0, 0, 0, 0}; R.p1 = R.p0; R.n0 = R.p0; R.n1 = R.p0;
  if (t - 1 >= lo) { R.p0 = *(const u32x4*)(pc - PIN); R.p1 = *(const u32x4*)(pc - PIN + 8); }
  if (t + 1 < hi) { R.n0 = *(const u32x4*)(pc + PIN); R.n1 = *(const u32x4*)(pc + PIN + 8); }
}
template <class M0, class M1>
DI void shift_apply(const ShiftRaw& R, const M0& mu0, const M1& mu1, float* o) {
#pragma unroll
  for (int i = 0; i < 16; ++i) {
    const unsigned cw = (i < 8) ? R.c0[(i & 7) >> 1] : R.c1[(i & 7) >> 1];
    const unsigned pw = (i < 8) ? R.p0[(i & 7) >> 1] : R.p1[(i & 7) >> 1];
    const unsigned nw = (i < 8) ? R.n0[(i & 7) >> 1] : R.n1[(i & 7) >> 1];
    const float cv = (i & 1) ? __uint_as_float(cw & 0xFFFF0000u) : __uint_as_float(cw << 16);
    const float pv = (i & 1) ? __uint_as_float(pw & 0xFFFF0000u) : __uint_as_float(pw << 16);
    const float nv = (i & 1) ? __uint_as_float(nw & 0xFFFF0000u) : __uint_as_float(nw << 16);
    o[i] = cv + mu0[i] * (pv - cv) + mu1[i] * (nv - cv);
  }
}


constexpr int HSZ = 8 * SLOT + 256 + 2304;
DI void half_barrier(LAS unsigned* ctr, unsigned& gen, int lt) {
  ++gen;
  asm volatile("s_waitcnt lgkmcnt(0)" ::: "memory");
  if ((lt & 63) == 0) (void)__hip_atomic_fetch_add(ctr, 1u, __ATOMIC_RELAXED, __HIP_MEMORY_SCOPE_WORKGROUP);
  const unsigned want = 4u * gen;
  while (__hip_atomic_load(ctr, __ATOMIC_RELAXED, __HIP_MEMORY_SCOPE_WORKGROUP) < want) __builtin_amdgcn_s_sleep(1);
  asm volatile("" ::: "memory");
}
DI void phase3_task(const Params& P, char* hs, int task, int lt, LAS unsigned* hctr, unsigned& hgen, LAS unsigned* hq, int pfidx) {
#define HALF_BARRIER() half_barrier(hctr, hgen, lt)
  asm volatile("" : "+v"(lt));
  const int lw = lt >> 6, lane = lt & 63;
  const int cc = task >> 4, dir = (task >> 3) & 1, hd = task & 7;
  const int rb = cc * 64;
  const int lo = (rb < L) ? 0 : L, hi = (rb < L) ? L : LT;
  const int sr = lt >> 2, q4 = lt & 3, cseg = q4 * 16;
  const int trow = rb + (dir ? 63 - sr : sr);
  const int ti = lw >> 1, tj = lw & 1;
  bf16_t* slot[8];
#pragma unroll
  for (int i = 0; i < 8; ++i) slot[i] = (bf16_t*)(hs + i * SLOT);
  float* gC = (float*)(hs + 8 * SLOT);
  float* Dout = (float*)(hs + 4 * SLOT);
  float* Aout = (float*)(hs + 6 * SLOT);
  float* Wl = (float*)(hs);

  float* TB = (float*)(hs + 8 * SLOT + 256);
  {
    ShiftRaw rw, ra;
    shift_raw(P, trow, lo, hi, 3072 + 64 * dir + cseg, rw);
    shift_raw(P, trow, lo, hi, 3200 + 64 * dir + cseg, ra);
    const float* du = P.decay_up + ((size_t)(dir * 64 + sr)) * 512 + 64 * hd + cseg;
    const float* iu = P.iclr_up + ((size_t)(dir * 64 + sr)) * 512 + 64 * hd + cseg;
    f32x4 dq[4], iq[4], mw0[4], mw1[4], ma0[4], ma1[4];
#pragma unroll
    for (int i = 0; i < 4; ++i) { dq[i] = *(const f32x4*)(du + 4 * i); iq[i] = *(const f32x4*)(iu + 4 * i); }
    {
      const float* m = P.shift_mu + (3072 + 64 * dir + cseg - PRW0);
#pragma unroll
      for (int i = 0; i < 4; ++i) {
        mw0[i] = *(const f32x4*)(m + 4 * i); mw1[i] = *(const f32x4*)(m + 1920 + 4 * i);
        ma0[i] = *(const f32x4*)(m + 128 + 4 * i); ma1[i] = *(const f32x4*)(m + 128 + 1920 + 4 * i);
      }
    }
    f32x4 tbv = (f32x4){0.f, 0.f, 0.f, 0.f};
    const int tsel = lt >> 4, tj4 = (lt & 15) * 4;
    if (lt < 144) {
      const float* tp = (tsel < 6) ? P.shift_mu + ((tsel >> 1) == 0 ? 512 : (tsel >> 1) == 1 ? 0 : 1024) + (tsel & 1) * 1920 + 64 * hd
                      : (tsel == 6) ? P.key_xi + dir * 512 + 64 * hd : (tsel == 7) ? P.key_alpha + dir * 512 + 64 * hd : P.bonus_rho + 64 * hd;
      tbv = *(const f32x4*)(tp + tj4);
    }
    __builtin_amdgcn_sched_barrier(0);
    float tmp[16], mu0[16], mu1[16];
#pragma unroll
    for (int i = 0; i < 16; ++i) { mu0[i] = mw0[i >> 2][i & 3]; mu1[i] = mw1[i >> 2][i & 3]; }
    shift_apply(rw, mu0, mu1, tmp);
#pragma unroll
    for (int i = 0; i < 16; ++i) tmp[i] = tanh_(tmp[i]);
    st16_bf16(slot[0] + sr * LD + cseg, tmp);
#pragma unroll
    for (int i = 0; i < 16; ++i) { mu0[i] = ma0[i >> 2][i & 3]; mu1[i] = ma1[i >> 2][i & 3]; }
    shift_apply(ra, mu0, mu1, tmp);
    st16_bf16(slot[1] + sr * LD + cseg, tmp);
#pragma unroll
    for (int i = 0; i < 4; ++i) { tmp[4 * i] = dq[i][0]; tmp[4 * i + 1] = dq[i][1]; tmp[4 * i + 2] = dq[i][2]; tmp[4 * i + 3] = dq[i][3]; }
    st16_bf16(slot[2] + sr * LD + cseg, tmp);
#pragma unroll
    for (int i = 0; i < 4; ++i) { tmp[4 * i] = iq[i][0]; tmp[4 * i + 1] = iq[i][1]; tmp[4 * i + 2] = iq[i][2]; tmp[4 * i + 3] = iq[i][3]; }
    st16_bf16(slot[3] + sr * LD + cseg, tmp);
    if (lt < 144) *(f32x4*)(TB + tsel * 64 + tj4) = tbv;
    asm volatile("s_waitcnt vmcnt(0)" ::: "memory");
  }
  HALF_BARRIER();
  if (lt == 0 && pfidx >= 0) __hip_atomic_store((GAS unsigned*)(P.flags + pfidx), 1u, __ATOMIC_RELAXED, __HIP_MEMORY_SCOPE_AGENT);
  {
    f32x16 a1 = mm_tile<true, false>(slot[0], slot[2], ti, tj, lane, zero16());
    f32x16 a2 = mm_tile<true, false>(slot[1], slot[3], ti, tj, lane, zero16());
    const int c = tj * 32 + (lane & 31), h = lane >> 5;
#pragma unroll
    for (int g = 0; g < 16; ++g) {
      Dout[(ti * 32 + crow(g, h)) * 65 + c] = a1[g];
      Aout[(ti * 32 + crow(g, h)) * 65 + c] = a2[g];
    }
  }
  HALF_BARRIER();
  float aa[16];
#pragma unroll
  for (int i = 0; i < 16; ++i) {
    const int ch = dir * 512 + 64 * hd + cseg + i;
    const float d = P.decay_w0[ch] + Dout[sr * 65 + cseg + i];
    Wl[sr * 65 + cseg + i] = __expf(-0.6065306597126334f * sigm(d));
    aa[i] = sigm(P.iclr_a0[ch] + Aout[sr * 65 + cseg + i]);
  }
  HALF_BARRIER();
  ShiftRaw rk, rr_, rv;
  shift_raw(P, trow, lo, hi, PRW0 + 512 + 64 * hd + cseg, rk);
  shift_raw(P, trow, lo, hi, PRW0 + 64 * hd + cseg, rr_);
  shift_raw(P, trow, lo, hi, PRW0 + 1024 + 64 * hd + cseg, rv);
  {
    const int c = lt >> 2, seg = lt & 3;
    float w[16];
#pragma unroll
    for (int i = 0; i < 16; ++i) w[i] = Wl[(seg * 16 + i) * 65 + c];
#pragma unroll
    for (int i = 1; i < 16; ++i) w[i] *= w[i - 1];
    const float tot = w[15];
    const float t0 = dpp_mov<0x00>(tot), t1 = dpp_mov<0x55>(tot), t2 = dpp_mov<0xAA>(tot);
    const float pre = (seg == 0) ? 1.f : (seg == 1) ? t0 : (seg == 2) ? t0 * t1 : t0 * t1 * t2;
    HALF_BARRIER();
#pragma unroll
    for (int i = 0; i < 16; ++i) Wl[(seg * 16 + i) * 65 + c] = w[i] * pre;
  }
  HALF_BARRIER();
  {
    float rr[16], kk[16], vv[16];
    shift_apply(rk, TB + cseg, TB + 64 + cseg, kk);
    shift_apply(rr_, TB + 128 + cseg, TB + 192 + cseg, rr);
    shift_apply(rv, TB + 256 + cseg, TB + 320 + cseg, vv);
    float nrm = 0.f, bsum = 0.f;
#pragma unroll
    for (int i = 0; i < 16; ++i) {
      const float kap = kk[i] * TB[384 + cseg + i];
      nrm += kap * kap;
    }
    nrm = dpp_add<0xB1>(nrm);
    nrm = dpp_add<0x4E>(nrm);
    const float rn = __builtin_amdgcn_rsqf(nrm + 1e-12f);
    {
      const int o = sr * LD + cseg;
#pragma unroll
      for (int h8 = 0; h8 < 2; ++h8) {
        float xi[8], al[8], rho[8];
#pragma unroll
        for (int i = 0; i < 2; ++i) {
          const f32x4 a = *(const f32x4*)(TB + 384 + cseg + 8 * h8 + 4 * i);
          const f32x4 b = *(const f32x4*)(TB + 448 + cseg + 8 * h8 + 4 * i);
          const f32x4 c = *(const f32x4*)(TB + 512 + cseg + 8 * h8 + 4 * i);
#pragma unroll
          for (int j = 0; j < 4; ++j) { xi[4 * i + j] = a[j]; al[4 * i + j] = b[j]; rho[4 * i + j] = c[j]; }
        }
        u32x4 wKp, wBp, wKt, wRp, wV;
#pragma unroll
        for (int p2 = 0; p2 < 4; ++p2) {
          float vKp[2], vBp[2], vKt[2], vRp[2];
#pragma unroll
          for (int e2 = 0; e2 < 2; ++e2) {
            const int i8 = 2 * p2 + e2, i = 8 * h8 + i8;
            const float gsv = Wl[sr * 65 + cseg + i];
            const float gpv = (sr > 0) ? Wl[(sr - 1) * 65 + cseg + i] : 1.f;
            const float kh = kk[i] * xi[i8] * rn;
            const float kt = kk[i] * (1.f + (aa[i] - 1.f) * al[i8]);
            const float bq = aa[i] * kh;
            const float ig = __builtin_amdgcn_rcpf(gsv);
            bsum += rr[i] * rho[i8] * kt;
            vKp[e2] = gpv * kh; vBp[e2] = bq * ig; vKt[e2] = kt * ig; vRp[e2] = gsv * rr[i];
            if (sr == 63) gC[cseg + i] = gsv;
          }
          wKp[p2] = pack2(vKp[0], vKp[1]); wBp[p2] = pack2(vBp[0], vBp[1]); wKt[p2] = pack2(vKt[0], vKt[1]); wRp[p2] = pack2(vRp[0], vRp[1]);
          wV[p2] = pack2(vv[8 * h8 + 2 * p2], vv[8 * h8 + 2 * p2 + 1]);
        }
        *(u32x4*)(slot[2] + o + 8 * h8) = wKp;
        *(u32x4*)(slot[3] + o + 8 * h8) = wBp;
        *(u32x4*)(slot[4] + o + 8 * h8) = wKt;
        *(u32x4*)(slot[5] + o + 8 * h8) = wRp;
        *(u32x4*)(slot[6] + o + 8 * h8) = wV;
      }
    }
    bsum = dpp_add<0xB1>(bsum);
    bsum = dpp_add<0x4E>(bsum);
    if (q4 == 0 && cc < 256) P.bon[((size_t)dir * L + trow) * 8 + hd] = bsum;
  }
  HALF_BARRIER();
  {
    f32x16 m2 = mm_tile<true, true>(slot[2], slot[3], ti, tj, lane, zero16());
    f32x16 m1 = mm_tile<true, true>(slot[2], slot[4], ti, tj, lane, zero16());
    const int c = tj * 32 + (lane & 31), h = lane >> 5;
#pragma unroll
    for (int g = 0; g < 16; ++g) {
      const int r = ti * 32 + crow(g, h);
      m2[g] = (r > c) ? m2[g] : 0.f;
      m1[g] = (r > c) ? m1[g] : 0.f;
    }
    store_rm_bf16(slot[0], m2, ti, tj, lane);
    store_rm_bf16(slot[7], m1, ti, tj, lane);
  }
  HALF_BARRIER();
  f32x16 x1 = mm_tile<true, false>(slot[7], slot[6], ti, tj, lane, zero16());
  HALF_BARRIER();
  store_tr_bf16(slot[7], x1, ti, tj, lane);
  if (lw == 0) {
    const bf16_t* M2b = slot[0];
    bf16_t* Tb = slot[1];
    {
      const int blk = lane >> 4, j = lane & 15, o = blk * 16;
      float t[16];
#pragma unroll
      for (int s = 0; s < 16; ++s) {
        float a = (s == j) ? 1.f : 0.f;
#pragma unroll
        for (int i = 0; i < s; ++i) a -= bf2f(M2b[(o + s) * LD + o + i]) * t[i];
        t[s] = a;
      }
#pragma unroll
      for (int s = 0; s < 16; ++s) Tb[(o + s) * LD + o + j] = f2bf(t[s]);
      if (!(blk & 1)) {
#pragma unroll
        for (int s = 0; s < 16; ++s) Tb[(o + s) * LD + o + 16 + j] = 0;
      }
    }
    {
      const int r = lane & 31, h = lane >> 5;
#pragma unroll
      for (int b32 = 0; b32 < 2; ++b32) {
        const int o = 32 * b32;
        bf16x8 a1 = frag_c(M2b, o + r, o + 8 * h);
        bf16x8 b1 = frag_s(Tb, o + 8 * h, o + (r & 15));
#pragma unroll
        for (int q = 0; q < 8; ++q) { a1[q] = (r >= 16) ? a1[q] : (short)0; b1[q] = (r < 16) ? b1[q] : (short)0; }
        const f32x16 p1 = mfma32(a1, b1, zero16());
        const u32x2 dlo = *(const u32x2*)(Tb + (o + r) * LD + o + 16 + 4 * h), dhi = *(const u32x2*)(Tb + (o + r) * LD + o + 24 + 4 * h);
        u32x4 aw; aw[0] = dlo[0]; aw[1] = dlo[1]; aw[2] = dhi[0]; aw[3] = dhi[1];
        bf16x8 a2 = __builtin_bit_cast(bf16x8, aw);
        u32x4 bw;
#pragma unroll
        for (int q = 0; q < 4; ++q) bw[q] = pack2(p1[8 + 2 * q], p1[8 + 2 * q + 1]);
        bf16x8 b2 = __builtin_bit_cast(bf16x8, bw);
#pragma unroll
        for (int q = 0; q < 8; ++q) a2[q] = (r >= 16) ? a2[q] : (short)0;
        const f32x16 p2 = mfma32(a2, b2, zero16());
        if (r < 16) {
#pragma unroll
          for (int g = 8; g < 16; ++g) Tb[(o + crow(g, h)) * LD + o + r] = f2bf(-p2[g]);
        }
      }
    }
    f32x16 xx = zero16();
    {
      const int r = lane & 31, h = lane >> 5;
#pragma unroll
      for (int ks = 0; ks < 2; ++ks) {
        const int k = ks * 16 + 8 * h;
        xx = mfma32(frag_c(M2b, 32 + r, k), frag_s(Tb, k, r), xx);
      }
#pragma unroll
      for (int g = 0; g < 4; ++g) {
        u32x2 v;
        v[0] = pack2(xx[4 * g], xx[4 * g + 1]);
        v[1] = pack2(xx[4 * g + 2], xx[4 * g + 3]);
        *(u32x2*)(Tb + r * LD + 32 + 8 * g + 4 * h) = v;
      }
      f32x16 t21 = zero16();
#pragma unroll
      for (int ks = 0; ks < 2; ++ks) {
        const int k = ks * 16 + 8 * h;
        t21 = mfma32(frag_c(Tb, 32 + r, 32 + k), frag_c(Tb, r, 32 + k), t21);
      }
#pragma unroll
      for (int g = 0; g < 16; ++g) Tb[(32 + crow(g, h)) * LD + r] = f2bf(-t21[g]);
#pragma unroll
      for (int g = 0; g < 16; ++g) Tb[(g + 16 * h) * LD + 32 + r] = 0;
    }
  }
  HALF_BARRIER();
  f32x16 wm = mm_tile<true, false>(slot[1], slot[2], ti, tj, lane, zero16());
  f32x16 uu = mm_tile<true, true>(slot[1], slot[7], ti, tj, lane, zero16());
  HALF_BARRIER();
  {
    store_tr_bf16(slot[2], wm, ti, tj, lane);
    store_tr_bf16(slot[7], uu, ti, tj, lane);
    f32x16 q1 = mm_tile<true, true>(slot[5], slot[4], ti, tj, lane, zero16());
    f32x16 q2 = mm_tile<true, true>(slot[5], slot[3], ti, tj, lane, zero16());
    const int c = tj * 32 + (lane & 31), h = lane >> 5;
#pragma unroll
    for (int g = 0; g < 16; ++g) {
      const int r = ti * 32 + crow(g, h);
      q1[g] = (r >= c) ? q1[g] : 0.f;
      q2[g] = (r >= c) ? q2[g] : 0.f;
    }
    store_rm_bf16(slot[0], q1, ti, tj, lane);
    store_rm_bf16(slot[1], q2, ti, tj, lane);
  }
  HALF_BARRIER();
  {
    unsigned nxt = 0;
    if (lt == 0) nxt = (unsigned)TASK_Q0 + __hip_atomic_fetch_add((GAS unsigned*)P.qh, 1u, __ATOMIC_RELAXED, __HIP_MEMORY_SCOPE_AGENT);
    const int c = tj * 32 + (lane & 31), h = lane >> 5;
    {
      f32x16 gacc = mm_tile<true, false>(slot[2], slot[3], ti, tj, lane, zero16());
      const float gk = gC[c];
      u32x4 w0, w1;
#pragma unroll
      for (int i = 0; i < 4; ++i) {
        const int ga = 2 * i, gb = 2 * i + 1;
        w0[i] = pack2(gk * (((ti * 32 + crow(ga, h) == c) ? 1.f : 0.f) - gacc[ga]), gk * (((ti * 32 + crow(gb, h) == c) ? 1.f : 0.f) - gacc[gb]));
        w1[i] = pack2(gk * (((ti * 32 + crow(8 + ga, h) == c) ? 1.f : 0.f) - gacc[8 + ga]), gk * (((ti * 32 + crow(8 + gb, h) == c) ? 1.f : 0.f) - gacc[8 + gb]));
      }
      const __amdgpu_buffer_rsrc_t gr = __builtin_amdgcn_make_buffer_rsrc((void*)P.gt, 0, NTASK * 8192, 0x00020000);
      const unsigned o = (unsigned)task * 8192u + (unsigned)(((tj * 4 + 2 * ti) * 64 + lane) * 16);
      __builtin_amdgcn_raw_buffer_store_b128(w0, gr, (int)o, 0, 16);
      __builtin_amdgcn_raw_buffer_store_b128(w1, gr, (int)(o + 1024u), 0, 16);
    }
    __builtin_amdgcn_sched_barrier(0);
    {
      f32x16 h1 = mm_tile<false, false>(slot[4], slot[6], ti, tj, lane, zero16());
      f32x16 h2 = mm_tile<false, true>(slot[3], slot[7], ti, tj, lane, zero16());
      const __amdgpu_buffer_rsrc_t hr = __builtin_amdgcn_make_buffer_rsrc((void*)P.ht, 0, NTASK * 8192, 0x00020000);
      const unsigned o = (unsigned)task * 8192u + (unsigned)((((ti * 2 + tj) * 2) * 64 + lane) * 16);
#pragma unroll
      for (int q = 0; q < 2; ++q) {
        u32x4 w;
#pragma unroll
        for (int e = 0; e < 4; ++e) {
          const int ga = 8 * q + 2 * e, gb = ga + 1;
          w[e] = pack2(gC[ti * 32 + crow(ga, h)] * (h1[ga] - h2[ga]), gC[ti * 32 + crow(gb, h)] * (h1[gb] - h2[gb]));
        }
        __builtin_amdgcn_raw_buffer_store_b128(w, hr, (int)(o + 1024u * q), 0, 16);
      }
    }
    __builtin_amdgcn_sched_barrier(0);
    f32x16 acc = mm_tile<true, true>(slot[1], slot[2], ti, tj, lane, zero16());
    bf16_t* rpp = P.rpp + (size_t)task * 4096;
#pragma unroll
    for (int g = 0; g < 16; ++g) {
      const int r = ti * 32 + crow(g, h);
      const int tt = dir ? 63 - r : r;
      rpp[tt * 64 + c] = f2bf(bf2f(slot[5][r * LD + c]) - acc[g]);
    }
    __builtin_amdgcn_sched_barrier(0);
    f32x16 y1 = mm_tile<true, false>(slot[0], slot[6], ti, tj, lane, zero16());
    f32x16 y2 = mm_tile<true, true>(slot[1], slot[7], ti, tj, lane, zero16());
    bf16_t* yl = P.yl + (size_t)task * 4096;
#pragma unroll
    for (int g = 0; g < 16; ++g) {
      const int r = ti * 32 + crow(g, h);
      const int tt = dir ? 63 - r : r;
      yl[tt * 64 + c] = f2bf(y1[g] - y2[g]);
    }
    if (lt == 0) *hq = nxt;
  }
  HALF_BARRIER();
}

#undef HALF_BARRIER
DI int p4_task(int n, int dir, int hd) {
  int cc;
  if (dir == 0) cc = (n < 4) ? 256 + n : n - 4;
  else cc = 259 - n;
  return cc * 16 + dir * 8 + hd;
}
DI void p3_dyn(const Params& P, char* smem, int first_q) {
  const int half = __builtin_amdgcn_readfirstlane(fresh_tid() >> 8);
  char* hs = smem + half * HSZ;
  LAS unsigned* hctr = (LAS unsigned*)(smem + 2 * HSZ + 64 * half);
  LAS unsigned* hq = hctr + 4;
  if ((fresh_tid() & 255) == 0) {
    *hctr = 0u;
    *hq = (first_q >= 0) ? (unsigned)(first_q + half) : (unsigned)TASK_Q0 + __hip_atomic_fetch_add((GAS unsigned*)P.qh, 1u, __ATOMIC_RELAXED, __HIP_MEMORY_SCOPE_AGENT);
  }
  unsigned hgen = 0;
  __syncthreads();
  unsigned cur = __builtin_amdgcn_readfirstlane(*hq);
  int pf = -1;
  while (cur < (unsigned)NTASK) {
    const int n = (int)(cur >> 4), combo = (int)(cur & 15u);
    phase3_task(P, hs, p4_task(n, combo >> 3, combo & 7), fresh_tid() & 255, hctr, hgen, hq, pf);
    pf = combo * FSTR + n;
    cur = __builtin_amdgcn_readfirstlane(*hq);
  }
  asm volatile("s_waitcnt vmcnt(0)" ::: "memory");
  __syncthreads();
  if ((fresh_tid() & 255) == 0 && pf >= 0) __hip_atomic_store((GAS unsigned*)(P.flags + pf), 1u, __ATOMIC_RELAXED, __HIP_MEMORY_SCOPE_AGENT);
}

struct P4Buf { bf16x8 g[4]; u32x4 hp[2]; unsigned pend; int pbase; };
struct P4Poll { int ready; unsigned spins; };
DI void p4_poll_take(P4Poll& Q, unsigned pend, int pbase, int lane) {
  const unsigned long long m = __ballot(pend != 0u && pbase + lane < NCH);
  const int cnt = (~m == 0ull) ? 64 : (__ffsll((long long)~m) - 1);
  const int r = __builtin_amdgcn_readfirstlane(pbase + cnt);
  if (r > Q.ready) Q.ready = r;
}
DI void p4_load(const Params& P, P4Buf& B, P4Poll& Q, int n, int chain, int ti, int tj, int lane) {
  B.pend = 0u; B.pbase = 0;
  if (n >= NCH) return;
  const int task = p4_task(n, chain >> 3, chain & 7);
  const GAS unsigned* fl = (const GAS unsigned*)(P.flags + chain * FSTR) + lane;
  while (Q.ready <= n) {
    const int pb = Q.ready;
    const unsigned pend = __hip_atomic_load(fl + pb, __ATOMIC_RELAXED, __HIP_MEMORY_SCOPE_AGENT);
    p4_poll_take(Q, pend, pb, lane);
    if (Q.ready > n) break;
    if (++Q.spins > (1u << 21)) break;
    __builtin_amdgcn_s_sleep(2);
  }
  asm volatile("" ::: "memory");
  B.pbase = Q.ready;
  B.pend = __hip_atomic_load(fl + Q.ready, __ATOMIC_RELAXED, __HIP_MEMORY_SCOPE_AGENT);
  const __amdgpu_buffer_rsrc_t gr = __builtin_amdgcn_make_buffer_rsrc((void*)P.gt, 0, NTASK * 8192, 0x00020000);
  const __amdgpu_buffer_rsrc_t hr = __builtin_amdgcn_make_buffer_rsrc((void*)P.ht, 0, NTASK * 8192, 0x00020000);
  const unsigned og = (unsigned)task * 8192u + (unsigned)(((ti * 4) * 64 + lane) * 16);
  const unsigned oh = (unsigned)task * 8192u + (unsigned)((((ti * 2 + tj) * 2) * 64 + lane) * 16);
#pragma unroll
  for (int ks = 0; ks < 4; ++ks) B.g[ks] = __builtin_bit_cast(bf16x8, __builtin_amdgcn_raw_buffer_load_b128(gr, (int)(og + 1024u * ks), 0, 16));
#pragma unroll
  for (int q = 0; q < 2; ++q) B.hp[q] = __builtin_amdgcn_raw_buffer_load_b128(hr, (int)(oh + 1024u * q), 0, 16);
}
DI void p4_step(const Params& P, const P4Buf& B, P4Poll& Q, bf16_t* Scur, bf16_t* Snext, int n, int dir, int hd, int tid, int ti, int tj, int lane) {
  const int task = p4_task(n, dir, hd);
  const int r = lane & 31, h = lane >> 5;
  {
    const int v = tid >> 2, sg = (tid & 3) * 16;
    u32x4 a = *(const u32x4*)(Scur + v * LD + sg), b = *(const u32x4*)(Scur + v * LD + sg + 8);
    bf16_t* dst = P.s0 + (size_t)task * 4096 + v * 64 + sg;
    *(u32x4*)dst = a;
    *(u32x4*)(dst + 8) = b;
  }
  f32x16 acc;
#pragma unroll
  for (int q = 0; q < 2; ++q)
#pragma unroll
    for (int e = 0; e < 4; ++e) { acc[8 * q + 2 * e] = __uint_as_float(B.hp[q][e] << 16); acc[8 * q + 2 * e + 1] = __uint_as_float(B.hp[q][e] & 0xFFFF0000u); }
#pragma unroll
  for (int ks = 0; ks < 4; ++ks) {
    const bf16_t* sp = Scur + (tj * 32 + r) * LD + 16 * ks + 4 * h;
    const u32x2 lo = *(const u32x2*)sp, hi = *(const u32x2*)(sp + 8);
    u32x4 bb; bb[0] = lo[0]; bb[1] = lo[1]; bb[2] = hi[0]; bb[3] = hi[1];
    acc = mfma32(B.g[ks], __builtin_bit_cast(bf16x8, bb), acc);
  }
  store_tr_bf16(Snext, acc, ti, tj, lane);
  p4_poll_take(Q, B.pend, B.pbase, lane);
}
DI void scan_chains(const Params& P, char* smem) {
  const int tid_ = fresh_tid();
  const int half = __builtin_amdgcn_readfirstlane(tid_ >> 8), tid = tid_ & 255;
  const int chain = blockIdx.x * 2 + half, dir = chain >> 3, hd = chain & 7;
  bf16_t* S0b = (bf16_t*)(smem + half * 2 * SLOT);
  bf16_t* S1b = (bf16_t*)(smem + half * 2 * SLOT + SLOT);
  const int lw = tid >> 6, lane = tid & 63, ti = lw >> 1, tj = lw & 1;
  const bool work = true;
  P4Poll Q; Q.ready = 0; Q.spins = 0u;
  if (work) {
    for (int i = tid; i < 64 * LD; i += 256) S0b[i] = 0;
  }
  P4Buf B0, B1, B2, B3;
  if (work) {
    p4_load(P, B0, Q, 0, chain, ti, tj, lane);
    p4_load(P, B1, Q, 1, chain, ti, tj, lane);
    p4_load(P, B2, Q, 2, chain, ti, tj, lane);
    p4_load(P, B3, Q, 3, chain, ti, tj, lane);
  }
  __syncthreads();
  for (int n = 0; n < NCH; n += 4) {
    if (work) { p4_step(P, B0, Q, S0b, S1b, n, dir, hd, tid, ti, tj, lane); p4_load(P, B0, Q, n + 4, chain, ti, tj, lane); }
    __syncthreads();
    if (work) { p4_step(P, B1, Q, S1b, S0b, n + 1, dir, hd, tid, ti, tj, lane); p4_load(P, B1, Q, n + 5, chain, ti, tj, lane); }
    __syncthreads();
    if (work) { p4_step(P, B2, Q, S0b, S1b, n + 2, dir, hd, tid, ti, tj, lane); p4_load(P, B2, Q, n + 6, chain, ti, tj, lane); }
    __syncthreads();
    if (work) { p4_step(P, B3, Q, S1b, S0b, n + 3, dir, hd, tid, ti, tj, lane); p4_load(P, B3, Q, n + 7, chain, ti, tj, lane); }
    __syncthreads();
  }
}

DI void phase34(const Params& P, char* smem) {
  const int b = blockIdx.x;
  if (b < NSCAN) {
    scan_chains(P, smem);
    prep_queue(P, smem);
  } else if (b < NSCAN + NPREPB) {
    prep_queue(P, smem);
    p3_dyn(P, smem, -1);
  } else {
    p3_dyn(P, smem, (b - NSCAN - NPREPB) * 2);
    prep_queue(P, smem);
  }
}

DI void unpack8(const u32x4& w, float* o) {
#pragma unroll
  for (int i = 0; i < 4; ++i) { o[2 * i] = __uint_as_float(w[i] << 16); o[2 * i + 1] = __uint_as_float(w[i] & 0xFFFF0000u); }
}
DI void phase5(const Params& P, char* smem) {
  bf16_t* SG = (bf16_t*)smem;
  bf16_t* VS = (bf16_t*)(smem + 17408);
  float* BON = (float*)(smem + 17408 + 66560);
  constexpr int LG = 136, LV = 520;
  float* GNW = (float*)(smem + 17408 + 66560 + 2048);
  float* MUT = GNW + 1024;
  for (int i = fresh_tid(); i < 1024; i += NTHR) GNW[i] = (i < 512) ? P.gn_w[i] : P.gn_b[i - 512];
  for (int i = fresh_tid(); i < 1280; i += NTHR)
    MUT[i] = (i < 256) ? P.shift_mu[(3328 - PRW0) + (i & 127) + (i >> 7) * 1920] : P.shift_mu[1024 + ((i - 256) & 511) + ((i - 256) >> 9) * 1920];
  __syncthreads();
  for (int cc = blockIdx.x; cc < 256; cc += gridDim.x) {
    const int tid = fresh_tid();
    const int wid = __builtin_amdgcn_readfirstlane(tid >> 6);
    const int rb = cc * 64;
    {
      const int c = (tid & 63) * 8, t0 = (tid >> 6) * 8;
      float z[10][8];
#pragma unroll
      for (int i = 0; i < 10; ++i) {
        const int t = t0 - 1 + i;
        if (t >= 0 && t < 64) {
          const bf16_t* pr = P.p + (size_t)(rb + t) * PIN + c;
          float cg[8], vv[8];
          unpack8(*(const u32x4*)(pr + 512), cg);
          unpack8(*(const u32x4*)(pr + 1024), vv);
#pragma unroll
          for (int j = 0; j < 8; ++j) z[i][j] = cg[j] * vv[j];
        } else {
#pragma unroll
          for (int j = 0; j < 8; ++j) z[i][j] = 0.f;
        }
      }
      float w0[8], w1[8], w2[8];
#pragma unroll
      for (int j = 0; j < 8; ++j) { w0[j] = P.conv_w[c + j]; w1[j] = P.conv_w[512 + c + j]; w2[j] = P.conv_w[1024 + c + j]; }
#pragma unroll
      for (int i = 0; i < 8; ++i) {
        float bg[8];
        unpack8(*(const u32x4*)(P.p + (size_t)(rb + t0 + i) * PIN + c), bg);
        float yy[8];
#pragma unroll
        for (int j = 0; j < 8; ++j) yy[j] = MIX_SCALE * bg[j] * (w0[j] * z[i][j] + w1[j] * z[i + 1][j] + w2[j] * z[i + 2][j]);
        u32x2 o;
        o[0] = pk4_fp8(yy[0], yy[1], yy[2], yy[3]); o[1] = pk4_fp8(yy[4], yy[5], yy[6], yy[7]);
        *(u32x2*)(P.mixin + (size_t)(rb + t0 + i) * D + c) = o;
      }
    }
    {
      float tmp[16];
      const int row = tid >> 3, cs = (tid & 7) * 16;
      ShiftRaw rg, rq[4];
      shift_raw(P, rb + row, 0, L, 3328 + cs, rg);
#pragma unroll
      for (int q = 0; q < 4; ++q) shift_raw(P, rb + row, 0, L, PRW0 + 1024 + (tid & 7) * 64 + q * 16, rq[q]);
      shift_apply(rg, MUT + cs, MUT + 128 + cs, tmp);
#pragma unroll
      for (int i = 0; i < 16; ++i) tmp[i] = sigm(tmp[i]);
      st16_bf16(SG + row * LG + cs, tmp);
#pragma unroll
      for (int q = 0; q < 4; ++q) {
        const int vc = (tid & 7) * 64 + q * 16;
        shift_apply(rq[q], MUT + 256 + vc, MUT + 768 + vc, tmp);
        st16_bf16(VS + row * LV + vc, tmp);
      }
      const int t = tid >> 3, hd = tid & 7;
      BON[t * 8 + hd] = P.bon[(size_t)(rb + t) * 8 + hd] + P.bon[((size_t)L + rb + t) * 8 + hd];
    }
    __syncthreads();
    const int hd = wid;
#pragma unroll 1
    for (int ti = 0; ti < 2; ++ti) {
      int lane = tid & 63;
      asm volatile("" : "+v"(lane));
      const int r = lane & 31, h = lane >> 5;
      const int tl = ti * 32 + r;
      const bf16_t* rp0 = P.rpp + ((size_t)cc * 16 + hd) * 4096 + (ti * 32 + r) * 64 + 8 * h;
      const bf16_t* rp1 = rp0 + (size_t)8 * 4096;
      const bf16_t* s00 = P.s0 + ((size_t)cc * 16 + hd) * 4096 + r * 64 + 8 * h;
      const bf16_t* s01 = s00 + (size_t)8 * 4096;
      const bf16_t* yl0 = P.yl + (size_t)(cc * 16 + hd) * 4096 + tl * 64 + 4 * h;
      const bf16_t* yl1 = yl0 + (size_t)8 * 4096;
      const bf16_t* gtp = P.gateT + (size_t)(64 * hd + r) * 128 + 8 * h;
      u32x2 ya[2][4], yb[2][4];
      bf16x8 fr[2][4], fs[2][4];
#pragma unroll
      for (int tj = 0; tj < 2; ++tj)
#pragma unroll
        for (int q = 0; q < 4; ++q) { ya[tj][q] = *(const u32x2*)(yl0 + tj * 32 + 8 * q); yb[tj][q] = *(const u32x2*)(yl1 + tj * 32 + 8 * q); }
#pragma unroll
      for (int ks = 0; ks < 4; ++ks) { fr[0][ks] = *(const bf16x8*)(rp0 + ks * 16); fr[1][ks] = *(const bf16x8*)(rp1 + ks * 16); }
#pragma unroll
      for (int ks = 0; ks < 4; ++ks) { fs[0][ks] = *(const bf16x8*)(s00 + ks * 16); fs[1][ks] = *(const bf16x8*)(s01 + ks * 16); }
      __builtin_amdgcn_sched_barrier(0);
      f32x16 y[2], gg[2];
#pragma unroll
      for (int tj = 0; tj < 2; ++tj)
#pragma unroll
        for (int q = 0; q < 4; ++q)
#pragma unroll
          for (int e = 0; e < 4; ++e)
            y[tj][4 * q + e] = ((e & 1) ? __uint_as_float(ya[tj][q][e >> 1] & 0xFFFF0000u) : __uint_as_float(ya[tj][q][e >> 1] << 16)) +
                               ((e & 1) ? __uint_as_float(yb[tj][q][e >> 1] & 0xFFFF0000u) : __uint_as_float(yb[tj][q][e >> 1] << 16));
      bf16x8 fs1[2][4], fg0[8];
#pragma unroll
      for (int ks = 0; ks < 4; ++ks) { fs1[0][ks] = *(const bf16x8*)(s00 + 32 * 64 + ks * 16); fs1[1][ks] = *(const bf16x8*)(s01 + 32 * 64 + ks * 16); }
#pragma unroll
      for (int ks = 0; ks < 8; ++ks) fg0[ks] = *(const bf16x8*)(gtp + ks * 16);
      __builtin_amdgcn_sched_barrier(0);
#pragma unroll
      for (int d = 0; d < 2; ++d)
#pragma unroll
        for (int ks = 0; ks < 4; ++ks) y[0] = mfma32(fs[d][ks], fr[d][ks], y[0]);
      bf16x8 fg1[8];
#pragma unroll
      for (int ks = 0; ks < 8; ++ks) fg1[ks] = *(const bf16x8*)(gtp + (size_t)32 * 128 + ks * 16);
      __builtin_amdgcn_sched_barrier(0);
#pragma unroll
      for (int d = 0; d < 2; ++d)
#pragma unroll
        for (int ks = 0; ks < 4; ++ks) y[1] = mfma32(fs1[d][ks], fr[d][ks], y[1]);
      gg[0] = zero16(); gg[1] = zero16();
#pragma unroll
      for (int ks = 0; ks < 8; ++ks) {
        const bf16x8 bsg = frag_c(SG, ti * 32 + r, ks * 16 + 8 * h, LG);
        gg[0] = mfma32(fg0[ks], bsg, gg[0]);
        gg[1] = mfma32(fg1[ks], bsg, gg[1]);
      }
      float part = 0.f;
#pragma unroll
      for (int g = 0; g < 16; ++g) part += y[0][g] + y[1][g];
      const float mean = (part + __shfl_xor(part, 32)) * (1.f / 64.f);
      float vpart = 0.f;
#pragma unroll
      for (int g = 0; g < 16; ++g) {
        y[0][g] -= mean; y[1][g] -= mean;
        vpart += y[0][g] * y[0][g] + y[1][g] * y[1][g];
      }
      const float rstd = __builtin_amdgcn_rsqf((vpart + __shfl_xor(vpart, 32)) * (1.f / 64.f) + 64e-5f);
      const float bonus = BON[tl * 8 + hd];
#pragma unroll
      for (int tj = 0; tj < 2; ++tj)
#pragma unroll
        for (int q = 0; q < 4; ++q) {
          const int ch = 64 * hd + tj * 32 + 8 * q + 4 * h;
          const f32x4 gw = *(const f32x4*)(GNW + ch), gb = *(const f32x4*)(GNW + 512 + ch);
          const u32x2 vw = *(const u32x2*)(VS + tl * LV + ch);
          float o[4];
#pragma unroll
          for (int e = 0; e < 4; ++e) {
            const float vs = (e & 1) ? __uint_as_float(vw[e >> 1] & 0xFFFF0000u) : __uint_as_float(vw[e >> 1] << 16);
            const float dn = y[tj][4 * q + e] * rstd * gw[e] + gb[e];
            o[e] = (dn + bonus * vs) * gg[tj][4 * q + e];
          }
          *(unsigned*)(P.mixin + (size_t)(rb + tl) * D + 512 + ch) = pk4_fp8(o[0] * MIX_SCALE, o[1] * MIX_SCALE, o[2] * MIX_SCALE, o[3] * MIX_SCALE);
        }
    }
    __syncthreads();
  }
}

template <bool F8>
struct SchedRows : g8::DenseOrder {
  static constexpr int PF_LINES = 0;
  static constexpr bool TILED_B = false, FP8 = F8;
  static constexpr int RB = F8 ? D : 2 * D;
  DI void pf(const g8::Unit2&, LAS unsigned char*, int) const {}
  DI void aoffs_late(const g8::Unit2& u, LAS unsigned char*, int, int R0, int R1, int C0, int C1, unsigned (&o)[2][2]) const { aoffs(u, R0, R1, C0, C1, o); }
  const bf16_t* A; const bf16_t* Bt;
  DI const char* abase() const { return (const char*)A; }
  DI const char* bbase(const g8::Unit2& u) const { return (const char*)Bt + (size_t)u.pn * 256 * RB; }
  DI void aoffs(const g8::Unit2& u, int R0, int R1, int C0, int C1, unsigned (&o)[2][2]) const {
#pragma unroll
    for (int h = 0; h < 2; ++h) {
      o[h][0] = (unsigned)((u.pm * 256 + h * 128 + R0) * RB + C0 * 2);
      o[h][1] = (unsigned)((u.pm * 256 + h * 128 + R1) * RB + C1 * 2);
    }
  }
};
DI void phase6(const Params& P, char* smem) {
  SchedRows<true> S; S.init(L / 256, D / 256, gridDim.x, blockIdx.x); S.A = (const bf16_t*)P.mixin; S.Bt = P.woutT;
  g8::gemm<g8::Unit2>((LAS unsigned char*)smem, S,
      [&](const g8::Acc& acc, const g8::Unit2& u, int wr, int wc, int fr, int fq, int) {
        const float* g1 = P.mod + 2048 + u.pn * 256 + wc * 32 + 4 * fq;
#pragma unroll
        for (int ai = 0; ai < 2; ++ai)
#pragma unroll
          for (int m = 0; m < 4; ++m) {
            const size_t ro = (size_t)(u.pm * 256 + ai * 128 + wr * 64 + m * 16 + fr) * D + u.pn * 256 + wc * 32 + 4 * fq;
#pragma unroll
            for (int bj = 0; bj < 2; ++bj)
#pragma unroll
              for (int n = 0; n < 2; ++n) {
                const f32x4 gv = *(const f32x4*)(g1 + bj * 128 + n * 16);
                const f32x4 xv = *(const f32x4*)(P.x + ro + bj * 128 + n * 16);
                const f32x4 r = xv + gv * (acc[ai][bj][m][n] * (1.f / (MIX_SCALE * W13_SCALE)));
                u32x2 w; w[0] = pack2(r[0], r[1]); w[1] = pack2(r[2], r[3]);
                *(u32x2*)(P.x1 + ro + bj * 128 + n * 16) = w;
              }
          }
      }, D / 2);
}

DI void phase8(const Params& P, char* smem) {
  if (blockIdx.x >= 192) { prep_range(P, smem, NW2 * B2 + ((int)blockIdx.x - 192) * B8, B8); return; }
  SchedRows<false> S; S.init(L / 256, 3, gridDim.x, blockIdx.x); S.A = P.h2; S.Bt = P.rsT;
  g8::gemm<g8::Unit2>((LAS unsigned char*)smem, S,
      [&](const g8::Acc& acc, const g8::Unit2& u, int wr, int wc, int fr, int fq, int) {
#pragma unroll
        for (int ai = 0; ai < 2; ++ai)
#pragma unroll
          for (int m = 0; m < 4; ++m) {
            const int row = u.pm * 256 + ai * 128 + wr * 64 + m * 16 + fr;
            if (u.pn == 0) {
              float* rp = P.logits + (size_t)row * NE + wc * 32 + 4 * fq;
#pragma unroll
              for (int bj = 0; bj < 2; ++bj)
#pragma unroll
                for (int n = 0; n < 2; ++n) *(f32x4*)(rp + bj * 128 + n * 16) = acc[ai][bj][m][n];
            } else {
              unsigned char* ap = P.act8 + ((size_t)row * NSLOT + 8) * DE + (u.pn - 1) * 128 + 4 * fq;
#pragma unroll
              for (int bj = 0; bj < 2; ++bj) {
                const f32x4 a = acc[ai][bj][m][0], bb = acc[ai][bj][m][1] * ACT_SCALE;
                *(unsigned*)(ap + 16 * (4 * bj + wc)) = pk4_fp8(siluf(a[0]) * bb[0], siluf(a[1]) * bb[1], siluf(a[2]) * bb[2], siluf(a[3]) * bb[3]);
              }
            }
          }
      }, D);
}

DI void phase9(const Params& P) {
  const int tid_ = fresh_tid();
  const int wid = tid_ >> 6, lane = tid_ & 63;
  const int tstride = gridDim.x * 8;
  float lg[4];
  {
    const int tok0 = blockIdx.x * 8 + wid;
#pragma unroll
    for (int q = 0; q < 4; ++q) lg[q] = (tok0 < L) ? P.logits[(size_t)tok0 * NE + q * 64 + lane] : 0.f;
  }
  int p_e = 0, p_tok = -1;
  float p_g = 0.f;
  float rbias[4];
#pragma unroll
  for (int q = 0; q < 4; ++q) rbias[q] = P.router_bias[q * 64 + lane];
  for (int tok = blockIdx.x * 8 + wid; tok < L; tok += tstride) {
    float sc[4], bs[4];
#pragma unroll
    for (int q = 0; q < 4; ++q) {
      sc[q] = sigm(lg[q]);
      bs[q] = sc[q] + rbias[q];
    }
    asm volatile("" :: "v"(bs[0]), "v"(bs[1]), "v"(bs[2]), "v"(bs[3]));
    __builtin_amdgcn_sched_barrier(0);
    unsigned p_pos;
    if (p_tok >= 0 && lane < 8) p_pos = (unsigned)atomicAdd(&P.cnt[p_e], 1);
    {
      const int ntok = (tok + tstride < L) ? tok + tstride : tok;
#pragma unroll
      for (int q = 0; q < 4; ++q) lg[q] = P.logits[(size_t)ntok * NE + q * 64 + lane];
    }
    int sel_i[8];
    float sel_s[8], ssum = 0.f;
#pragma unroll
    for (int j = 0; j < 8; ++j) {
      float best = bs[0];
      int bq = 0;
#pragma unroll
      for (int q = 1; q < 4; ++q)
        if (bs[q] > best) { best = bs[q]; bq = q; }
      const float m = wave_max(best);
      const unsigned long long msk = __ballot(best == m);
      const int ol = __builtin_amdgcn_readfirstlane(__ffsll((long long)msk) - 1);
      const int q = __builtin_amdgcn_readlane(bq, ol);
      const float cand = (q == 0) ? sc[0] : (q == 1) ? sc[1] : (q == 2) ? sc[2] : sc[3];
      const float s = __int_as_float(__builtin_amdgcn_readlane(__float_as_int(cand), ol));
#pragma unroll
      for (int qq = 0; qq < 4; ++qq) bs[qq] = (lane == ol && q == qq) ? -1e30f : bs[qq];
      sel_i[j] = q * 64 + ol;
      sel_s[j] = s;
      ssum += s;
    }
    const float inv = 2.5f / ssum;
    int my_e = 0;
    float my_g = 0.f;
#pragma unroll
    for (int j = 0; j < 8; ++j)
      if (lane == j) { my_e = sel_i[j]; my_g = sel_s[j] * inv; }
    if (p_tok >= 0 && lane < 8) {
      P.lid[(size_t)p_e * L + p_pos] = p_tok * NSLOT + lane;
      P.lgate[(size_t)p_e * L + p_pos] = p_g;
    }
    p_e = my_e; p_g = my_g; p_tok = tok;
  }
  if (p_tok >= 0 && lane < 8) {
    const int pos = atomicAdd(&P.cnt[p_e], 1);
    P.lid[(size_t)p_e * L + pos] = p_tok * NSLOT + lane;
    P.lgate[(size_t)p_e * L + pos] = p_g;
  }
}

DI int moe_prefix(const Params& P, int* pre, int tid) {
  if (tid == 0) {
    int s = 0;
    for (int e = 0; e < 257; ++e) {
      pre[e] = s;
      const int c = (e < 256) ? P.cnt[e] : L;
      s += (c + 255) >> 8;
    }
    pre[257] = s;
  }
  __syncthreads();
  return pre[257];
}
DI int find_expert(const int* pre, int mt) {
  int lo = 0, hi = 256;
  while (lo < hi) {
    const int mid = (lo + hi + 1) >> 1;
    if (pre[mid] <= mt) lo = mid; else hi = mid - 1;
  }
  return lo;
}
DI int row_id(const Params& P, int e, int gi, int cnt) {
  const int g = gi < cnt ? gi : cnt - 1;
  return (e < 256) ? P.lid[(size_t)e * L + g] : g * NSLOT + 8;
}

struct UnitM { int e, mt, nt, cnt; };
template <int NN, int NEXP, int KD, bool TOK>
struct SchedMoe {
  static constexpr int PF_LINES = 0;
  static constexpr bool TILED_B = true;
  static constexpr bool FP8 = true;
  const Params* P; const int* pre; int total, G, c;
  const bf16_t* A; const bf16_t* Bt;
  DI bool compute(int i, UnitM& u) const {
    const int U = total * NN, CH = (U + 7) >> 3;
    const int k = (c >> 3) + (G >> 3) * i;
    if (k >= CH) return false;
    const long Lx = (long)(c & 7) * CH + k; if (Lx >= U) return false;
    const int mtg = (int)(Lx / NN); u.nt = (int)(Lx % NN);
    u.e = find_expert(pre, mtg);
    u.mt = mtg - pre[u.e];
    u.cnt = pre[260 + u.e];
    return true;
  }
  DI void tabulate(int tid) const {
    if (tid < 16) {
      UnitM u; u.e = -1; u.mt = 0; u.nt = 0; u.cnt = 0;
      (void)compute(tid, u);
      int* tb = const_cast<int*>(pre) + 800 + tid * 4;
      tb[0] = u.e; tb[1] = u.mt; tb[2] = u.nt; tb[3] = u.cnt;
    }
    __syncthreads();
  }
  DI bool next(int i, UnitM& u) const {
    if (i >= 16) return false;
    const int* tb = pre + 800 + i * 4;
    u.e = __builtin_amdgcn_readfirstlane(tb[0]);
    if (u.e < 0) return false;
    u.mt = __builtin_amdgcn_readfirstlane(tb[1]);
    u.nt = __builtin_amdgcn_readfirstlane(tb[2]);
    u.cnt = __builtin_amdgcn_readfirstlane(tb[3]);
    return true;
  }
  static constexpr int IDS_OFF = 144384;
  DI void pf(const UnitM& u, LAS unsigned char* lds, int buf) const {
    const int tid = fresh_tid(), wid = __builtin_amdgcn_readfirstlane(tid >> 6);
    if (tid < 256) {
      const int gi = u.mt * 256 + tid, gc = gi < u.cnt ? gi : u.cnt - 1;
      const int* src = (u.e < 256) ? P->lid + (size_t)u.e * L + gc : P->ident + gc;
      __builtin_amdgcn_global_load_lds((const unsigned*)src, (LAS unsigned*)(lds + IDS_OFF + buf * 2048 + wid * 256), 4, 0, 0);
      if (!TOK) {
        const float* gs = (u.e < 256) ? P->lgate + (size_t)u.e * L + gc : P->ones;
        __builtin_amdgcn_global_load_lds((const unsigned*)gs, (LAS unsigned*)(lds + IDS_OFF + buf * 2048 + 1024 + wid * 256), 4, 0, 0);
      }
    }
  }
  DI void aoffs_late(const UnitM& u, LAS unsigned char* lds, int buf, int R0, int R1, int C0, int C1, unsigned (&o)[2][2]) const {
    const LAS int* ids = (const LAS int*)(lds + IDS_OFF + buf * 2048);
#pragma unroll
    for (int h = 0; h < 2; ++h) {
      const int i0 = ids[h * 128 + R0], i1 = ids[h * 128 + R1];
      o[h][0] = (unsigned)(TOK ? (i0 / NSLOT) : i0) * (unsigned)(KD * 2) + C0 * 2;
      o[h][1] = (unsigned)(TOK ? (i1 / NSLOT) : i1) * (unsigned)(KD * 2) + C1 * 2;
    }
  }
  DI const char* abase() const { return (const char*)A; }
  DI const char* bbase(const UnitM& u) const { return (const char*)(Bt + ((size_t)u.e * NN + u.nt) * 256 * KD); }
  DI unsigned arow(const UnitM& u, int r) const {
    const int id = row_id(*P, u.e, u.mt * 256 + r, u.cnt);
    return (unsigned)(TOK ? (id / NSLOT) : id) * (unsigned)(KD * 2);
  }
  DI void aoffs(const UnitM& u, int R0, int R1, int C0, int C1, unsigned (&o)[2][2]) const {
#pragma unroll
    for (int h = 0; h < 2; ++h) { o[h][0] = arow(u, h * 128 + R0) + C0 * 2; o[h][1] = arow(u, h * 128 + R1) + C1 * 2; }
  }
};
DI int moe_prefix_n(const Params& P, int* pre, int tid, int nexp) {
  int* tl = pre + 520;
  if (tid < 258) {
    const int c = (tid < 256) ? P.cnt[tid] : L;
    pre[260 + tid] = c;
    tl[tid] = (tid < nexp) ? ((c + 255) >> 8) : 0;
  }
  __syncthreads();
  if (tid < 258) {
    int sacc = 0;
    for (int e = 0; e < tid; ++e) sacc += tl[e];
    pre[tid] = sacc;
  }
  __syncthreads();
  return __builtin_amdgcn_readfirstlane(pre[257]);
}
DI void phase10(const Params& P, char* smem) {
  int* pre = (int*)(smem + 137216);
  SchedMoe<2, 256, D / 2, true> S;
  S.total = moe_prefix_n(P, pre, fresh_tid(), 256);
  S.P = &P; S.pre = pre; S.G = gridDim.x; S.c = blockIdx.x; S.A = (const bf16_t*)P.h2q; S.Bt = P.w13T;
  S.tabulate(fresh_tid());
  g8::gemm<UnitM>((LAS unsigned char*)smem, S,
      [&](const g8::Acc& acc, const UnitM& u, int wr, int wc, int fr, int fq, int buf) {
        const int* IDS = (const int*)(smem + 144384 + buf * 2048);
#pragma unroll
        for (int ai = 0; ai < 2; ++ai)
#pragma unroll
          for (int m = 0; m < 4; ++m) {
            const int gi = u.mt * 256 + ai * 128 + wr * 64 + m * 16 + fr;
            if (gi < u.cnt) {
              unsigned char* ap = P.act8 + (size_t)IDS[ai * 128 + wr * 64 + m * 16 + fr] * DE + u.nt * 128 + 4 * fq;
              constexpr float ia = 1.f / (H2_SCALE * W13_SCALE), ib = ACT_SCALE / (H2_SCALE * W13_SCALE);
#pragma unroll
              for (int bj = 0; bj < 2; ++bj) {
                const f32x4 a = acc[ai][bj][m][0] * ia, bb = acc[ai][bj][m][1] * ib;
                *(unsigned*)(ap + 16 * (4 * bj + wc)) = pk4_fp8(siluf(a[0]) * bb[0], siluf(a[1]) * bb[1], siluf(a[2]) * bb[2], siluf(a[3]) * bb[3]);
              }
            }
          }
      }, D / 2);
}

DI void phase11(const Params& P, char* smem) {
  int* pre = (int*)(smem + 137216);
  SchedMoe<4, 257, DE / 2, false> S;
  S.total = moe_prefix_n(P, pre, fresh_tid(), 257);
  S.P = &P; S.pre = pre; S.G = gridDim.x; S.c = blockIdx.x; S.A = (const bf16_t*)P.act8; S.Bt = P.w2T;
  S.tabulate(fresh_tid());
  g8::gemm<UnitM>((LAS unsigned char*)smem, S,
      [&](const g8::Acc& acc, const UnitM& u, int wr, int wc, int fr, int fq, int buf) {
        const int* IDS = (const int*)(smem + 144384 + buf * 2048);
        const float* GTS = (const float*)(smem + 144384 + buf * 2048 + 1024);
#pragma unroll
        for (int ai = 0; ai < 2; ++ai)
#pragma unroll
          for (int m = 0; m < 4; ++m) {
            const int gi = u.mt * 256 + ai * 128 + wr * 64 + m * 16 + fr;
            if (gi < u.cnt) {
              const int row = ai * 128 + wr * 64 + m * 16 + fr;
              const float gate = GTS[row] * (SLAB_SCALE / (ACT_SCALE * W2_SCALE));
              unsigned char* sp = P.slab + (size_t)IDS[row] * D + u.nt * 256 + wc * 64 + 16 * fq;
              u32x4 w;
#pragma unroll
              for (int bj = 0; bj < 2; ++bj)
#pragma unroll
                for (int n = 0; n < 2; ++n) {
                  const f32x4 v = acc[ai][bj][m][n];
                  int q = 0;
                  q = __builtin_amdgcn_cvt_pk_fp8_f32(__builtin_amdgcn_fmed3f(gate * v[0], -440.f, 440.f), __builtin_amdgcn_fmed3f(gate * v[1], -440.f, 440.f), q, false);
                  q = __builtin_amdgcn_cvt_pk_fp8_f32(__builtin_amdgcn_fmed3f(gate * v[2], -440.f, 440.f), __builtin_amdgcn_fmed3f(gate * v[3], -440.f, 440.f), q, true);
                  w[2 * bj + n] = (unsigned)q;
                }
              *(u32x4*)sp = w;
            }
          }
      }, DE / 2);
}

DI void phase12(const Params& P) {
  const int tid_ = fresh_tid();
  const int wid = tid_ >> 6, lane = tid_ & 63;
  const float* g2 = P.mod + 5120;
  for (int row = blockIdx.x * 8 + wid; row < L; row += gridDim.x * 8) {
    float v[2][8];
    float ss = 0.f;
#pragma unroll
    for (int i = 0; i < 2; ++i) {
      const int c = i * 512 + lane * 8;
      float sacc[8];
#pragma unroll
      for (int j = 0; j < 8; ++j) sacc[j] = 0.f;
#pragma unroll
      for (int j = 0; j < NSLOT; ++j) {
        const u32x2 w = __builtin_nontemporal_load((const u32x2*)(P.slab + ((size_t)row * NSLOT + j) * D + c));
#pragma unroll
        for (int e = 0; e < 2; ++e) {
          const f32x2v lo = __builtin_amdgcn_cvt_pk_f32_fp8((int)w[e], false), hi = __builtin_amdgcn_cvt_pk_f32_fp8((int)w[e], true);
          sacc[4 * e] += lo[0]; sacc[4 * e + 1] += lo[1]; sacc[4 * e + 2] += hi[0]; sacc[4 * e + 3] += hi[1];
        }
      }
      float xr[8];
      unpack8(*(const u32x4*)(P.x1 + (size_t)row * D + c), xr);
      const f32x4 g0 = *(const f32x4*)(g2 + c), g1v = *(const f32x4*)(g2 + c + 4);
#pragma unroll
      for (int j = 0; j < 4; ++j) {
        v[i][j] = xr[j] + g0[j] * (sacc[j] * (1.f / SLAB_SCALE));
        v[i][4 + j] = xr[4 + j] + g1v[j] * (sacc[4 + j] * (1.f / SLAB_SCALE));
        ss += v[i][j] * v[i][j] + v[i][4 + j] * v[i][4 + j];
      }
    }
    ss = wave_sum(ss);
    const float rs = __builtin_amdgcn_rsqf(ss * (1.f / 1024.f) + 1e-6f);
#pragma unroll
    for (int i = 0; i < 2; ++i) {
      const int c = i * 512 + lane * 8;
      const f32x4 f0 = *(const f32x4*)(P.final_g + c), f1 = *(const f32x4*)(P.final_g + c + 4);
      f32x4 o0, o1;
#pragma unroll
      for (int j = 0; j < 4; ++j) { o0[j] = v[i][j] * rs * f0[j]; o1[j] = v[i][4 + j] * rs * f1[j]; }
      __builtin_nontemporal_store(o0, (f32x4*)(P.out + (size_t)row * D + c));
      __builtin_nontemporal_store(o1, (f32x4*)(P.out + (size_t)row * D + c + 4));
    }
  }
}

__global__ void __launch_bounds__(NTHR) mega(Params P) {
  cg::grid_group grid = cg::this_grid();
  extern __shared__ __attribute__((aligned(16))) char smem[];
  volatile LAS unsigned* xst = (volatile LAS unsigned*)(smem + kDynLds - 16);
  if (threadIdx.x < 4) xst[threadIdx.x] = 0u;
  __syncthreads();
  XcdBarrier xb = xcd_barrier_post(P.bar, xst);
  prep_dense(P, smem);
  phase0(P, smem);
  if (P.coop_probe) grid.sync();
  xcd_barrier(xb);
  phase1(P);
  xcd_barrier(xb);
  phase2(P, smem);
  xcd_barrier(xb);
  phase34(P, smem);
  xcd_barrier(xb);
  phase5(P, smem);
  xcd_barrier(xb);
  phase6(P, smem);
  xcd_barrier(xb);
  phase7(P);
  xcd_barrier(xb);
  phase8(P, smem);
  xcd_barrier(xb);
  phase9(P);
  xcd_barrier(xb);
  phase10(P, smem);
  xcd_barrier(xb);
  phase11(P, smem);
  xcd_barrier(xb);
  phase12(P);
}

extern "C" void kernel_launch(void* const* d_in, const int* in_sizes, int n_in, void* d_out, int out_size, void* d_ws,
                              size_t ws_size, hipStream_t stream) {
  static int grid_blocks = 0;
  if (!grid_blocks) {
    int dev = 0, cus = 0, per_cu = 0;
    (void)hipGetDevice(&dev);
    (void)hipDeviceGetAttribute(&cus, hipDeviceAttributeMultiprocessorCount, dev);
    (void)hipFuncSetAttribute((const void*)mega, hipFuncAttributeMaxDynamicSharedMemorySize, (int)kDynLds);
    (void)hipOccupancyMaxActiveBlocksPerMultiprocessor(&per_cu, mega, NTHR, kDynLds);
    if (per_cu > 1) per_cu = 1;
    grid_blocks = cus * per_cu;
  }
  Params P{};
  const float* const* in = (const float* const*)d_in;
  P.x = in[0]; P.c = in[1]; P.ctx = in[2]; P.c_ctx = in[3]; P.ada_w = in[4]; P.ada_b = in[5]; P.norm1_g = in[6]; P.norm2_g = in[7];
  P.w_in = in[8]; P.conv_w = in[9]; P.shift_mu = in[10]; P.decay_w0 = in[11]; P.decay_up = in[12]; P.iclr_a0 = in[13];
  P.iclr_up = in[14]; P.key_xi = in[15]; P.key_alpha = in[16]; P.bonus_rho = in[17]; P.gate_up = in[18]; P.gn_w = in[19];
  P.gn_b = in[20]; P.w_out = in[21]; P.router_w = in[22]; P.router_bias = in[23]; P.exp_w1 = in[24]; P.exp_w3 = in[25];
  P.exp_w2 = in[26]; P.sh_w1 = in[27]; P.sh_w3 = in[28]; P.sh_w2 = in[29]; P.final_g = in[30];
  P.out = (float*)d_out;
  char* w = (char*)d_ws;
  size_t off = 0;
  auto take = [&](size_t bytes) { char* r = w + off; off += (bytes + 255) & ~(size_t)255; return r; };
  P.mod = (float*)take(6144 * 4);
  P.modc = (float*)take(6144 * 4);
  P.cnt = (int*)take(272 * 4);
  P.bar = (unsigned*)take((XCD_BAR_WORDS + 64 + 16 * FSTR) * 4);
  P.qh = P.bar + XCD_BAR_WORDS;
  P.flags = P.qh + 64;
  P.ident = (int*)take((size_t)L * 4);
  P.ones = (float*)take(1024);
  P.winT = (bf16_t*)take((size_t)PIN * D * 2);
  P.woutT = (bf16_t*)take((size_t)D * D * 2);
  P.rsT = (bf16_t*)take((size_t)768 * D * 2);
  P.gateT = (bf16_t*)take((size_t)512 * 128 * 2);
  P.bon = (float*)take((size_t)2 * L * 8 * 4);
  P.mixin = (unsigned char*)take((size_t)L * D);
  P.w2T = (bf16_t*)take((size_t)257 * D * DE * 2);
  {
    const size_t r1 = off;
    P.hx = (unsigned char*)take((size_t)LT * D);
    P.p = (bf16_t*)take((size_t)LT * PIN * 2 + 65536);
    const size_t r1_end = off;
    off = r1;
    P.x1 = (bf16_t*)take((size_t)L * D * 2);
    if (off < r1_end) off = r1_end;
  }
  {
    const size_t r2 = off;
    P.rpp = (bf16_t*)take((size_t)NTASK * 4096 * 2);
    P.yl = (bf16_t*)take((size_t)NTASK * 4096 * 2);
    P.gt = (bf16_t*)take((size_t)NTASK * 4096 * 2);
    P.ht = (bf16_t*)take((size_t)NTASK * 4096 * 2);
    P.s0 = (bf16_t*)take((size_t)NTASK * 4096 * 2);
    const size_t r2_end = off;
    off = r2;
    P.h2 = (bf16_t*)take((size_t)L * D * 2);
    P.logits = (float*)take((size_t)L * NE * 4);
    P.lid = (int*)take((size_t)NE * L * 4);
    P.lgate = (float*)take((size_t)NE * L * 4);
    P.act8 = (unsigned char*)take((size_t)L * NSLOT * DE);
    P.h2q = (unsigned char*)take((size_t)L * D);
    if (off < r2_end) off = r2_end;
  }
  {
    const size_t r4 = off;
    P.w13T = (bf16_t*)take((size_t)256 * 512 * D * 2);
    const size_t r4_end = off;
    off = r4;
    P.slab = (unsigned char*)take((size_t)L * NSLOT * D);
    if (off < r4_end) off = r4_end;
  }
  if (off > ws_size) fprintf(stderr, "workspace too small: need %zu have %zu\n", off, ws_size);
  (void)hipMemsetAsync(P.bar, 0, (XCD_BAR_WORDS + 64 + 16 * FSTR) * 4, stream);
  void* args[] = {&P};
  hipError_t e = hipLaunchCooperativeKernel((void*)mega, dim3(grid_blocks), dim3(NTHR), args, kDynLds, stream);
  if (e != hipSuccess) fprintf(stderr, "cooperative launch failed: %s (grid %d)\n", hipGetErrorString(e), grid_blocks);
}
```
